# Optimizing an MI355X kernel written in HIP

```python
import jax, jax.numpy as jnp
from jax import lax
import numpy as np

D_MODEL = 1024
BATCH = 8
SEQ = 2048
DEPTH = 4
DEC_BATCH = 128
DEC_SEQ = 4
PAST_LEN = 16384
PAGE_SIZE = 128

D_A = D_MODEL
H_A = 8
G_A = D_A // H_A
CHUNK_A = 128
D_B = D_MODEL
H_B = 8
DK = D_B // H_B
DV = D_B // H_B
CONV_W = 4
CHUNK_B = 64
ALPHA_DN = (2 * DEPTH) ** 0.25
BETA_DN = (8 * DEPTH) ** -0.25
LN_EPS = 1e-5
NORM_EPS = 1e-6
SPLITS = [D_A, 2 * D_A, 3 * D_A, 3 * D_A + 3 * D_B, 3 * D_A + 4 * D_B,
          3 * D_A + 4 * D_B + H_B, 3 * D_A + 4 * D_B + 2 * H_B,
          3 * D_A + 4 * D_B + 2 * H_B + D_MODEL]
P_IN = 3 * D_A + 4 * D_B + 2 * H_B + 2 * D_MODEL

kernel_name = "hybrid_gmlp_gdn_deepnorm_adaln_step"


def _layernorm(x, g=None, b=None):
    xf = x.astype(jnp.float32)
    mu = jnp.mean(xf, axis=-1, keepdims=True)
    var = jnp.mean(jnp.square(xf - mu), axis=-1, keepdims=True)
    y = (xf - mu) * lax.rsqrt(var + LN_EPS)
    if g is not None:
        y = y * g.astype(jnp.float32) + b.astype(jnp.float32)
    return y


def _rmsnorm(x, g):
    xf = x.astype(jnp.float32)
    return xf * lax.rsqrt(jnp.mean(jnp.square(xf), -1, keepdims=True) + NORM_EPS) * g.astype(jnp.float32)


def _l2norm(x):
    xf = x.astype(jnp.float32)
    return xf * lax.rsqrt(jnp.sum(jnp.square(xf), -1, keepdims=True) + NORM_EPS)


def _chunk_gmlp(u, v, z, w_s, b_s, lnv_g, lnv_b):
    B, L, _ = v.shape
    vn = _layernorm(v, lnv_g, lnv_b)
    if L <= CHUNK_A:
        lc, n_chunk = L, 1
    else:
        lc, n_chunk = CHUNK_A, -(-L // CHUNK_A)
    lp = lc * n_chunk
    vp = jnp.pad(vn, ((0, 0), (0, lp - L), (0, 0))).reshape(B, n_chunk, lc, H_A, G_A)
    ws = jnp.tril(w_s[:, :lc, :lc].astype(jnp.float32))
    s = jnp.einsum('hts,bnshc->bnthc', ws, vp) + b_s[:, :lc].astype(jnp.float32).T[None, None, :, :, None]
    s = s.reshape(B, lp, D_A)[:, :L]
    y = u.astype(jnp.float32) * s * jax.nn.silu(z.astype(jnp.float32))
    start = ((L - 1) // CHUNK_A) * CHUNK_A
    return y, vn[:, start:]


def _short_conv(x, buf, w):
    L = x.shape[1]
    xp = jnp.concatenate([buf.astype(x.dtype), x], axis=1)
    y = w[0] * xp[:, 0:L]
    for j in range(1, CONV_W):
        y = y + w[j] * xp[:, j:j + L]
    return jax.nn.silu(y), xp[:, -(CONV_W - 1):]


def _gated_delta(q, k, v, g, beta, s0):
    f32 = jnp.float32
    q, k, v, g, beta = (t.astype(f32) for t in (q, k, v, g, beta))
    B, H, L, dk = q.shape
    dv = v.shape[-1]
    C = min(CHUNK_B, L)
    pad = (-L) % C
    if pad:
        p4 = ((0, 0), (0, 0), (0, pad), (0, 0))
        p3 = ((0, 0), (0, 0), (0, pad))
        q, k, v = jnp.pad(q, p4), jnp.pad(k, p4), jnp.pad(v, p4)
        g, beta = jnp.pad(g, p3), jnp.pad(beta, p3)
    N = (L + pad) // C
    q = q * (dk ** -0.5)
    q = q.reshape(B, H, N, C, dk)
    k = k.reshape(B, H, N, C, dk)
    v = v.reshape(B, H, N, C, dv)
    beta = beta.reshape(B, H, N, C)
    gc = jnp.cumsum(g.reshape(B, H, N, C), axis=-1)
    kb = k * beta[..., None]
    vb = v * beta[..., None]
    tril_incl = jnp.tril(jnp.ones((C, C), dtype=bool))
    strict = jnp.tril(jnp.ones((C, C), dtype=bool), -1)
    decay = jnp.exp(jnp.where(tril_incl, gc[..., :, None] - gc[..., None, :], -jnp.inf))
    a_mat = jnp.where(strict, jnp.einsum('bhnid,bhnjd->bhnij', kb, k) * decay, 0.0)
    lhs = a_mat + jnp.eye(C, dtype=f32)
    u = lax.linalg.triangular_solve(lhs, vb, left_side=True, lower=True, unit_diagonal=True)
    w = lax.linalg.triangular_solve(lhs, kb * jnp.exp(gc)[..., None], left_side=True, lower=True, unit_diagonal=True)
    qk = jnp.where(tril_incl, jnp.einsum('bhnid,bhnjd->bhnij', q, k) * decay, 0.0)

    def step(S, xs):
        q_n, k_n, u_n, w_n, qk_n, gc_n = xs
        v_new = u_n - jnp.einsum('bhck,bhkv->bhcv', w_n, S)
        o = (jnp.einsum('bhck,bhkv->bhcv', q_n * jnp.exp(gc_n)[..., None], S)
             + jnp.einsum('bhcs,bhsv->bhcv', qk_n, v_new))
        g_last = gc_n[..., -1:]
        S = (S * jnp.exp(g_last)[..., None]
             + jnp.einsum('bhck,bhcv->bhkv', k_n * jnp.exp(g_last - gc_n)[..., None], v_new))
        return S, o

    xs = tuple(jnp.moveaxis(t, 2, 0) for t in (q, k, u, w, qk, gc))
    s_fin, o = lax.scan(step, s0.astype(f32), xs)
    o = jnp.moveaxis(o, 0, 2).reshape(B, H, N * C, dv)[:, :, :L]
    return o, s_fin


def _layer(x, c, conv_buf, s0, w_ada, b_ada, w_in, w_s, b_s, lnv_g, lnv_b, conv_w,
           a_log, dt_bias, onorm_g, w_pa, w_pb, w_o, ln_g, ln_b):
    B, L, _ = x.shape
    mod = jax.nn.silu(c) @ w_ada + b_ada
    shift, scale, gate = jnp.split(mod, 3, axis=-1)
    h = _layernorm(x) * (1.0 + scale[:, None].astype(jnp.float32)) + shift[:, None].astype(jnp.float32)
    h = h.astype(x.dtype)
    p = h @ w_in
    u_a, v_a, z_a, qkv, z_b, b_raw, a_raw, ga, gb = jnp.split(p, SPLITS, axis=-1)
    y_a, v_rows = _chunk_gmlp(jax.nn.gelu(u_a), jax.nn.gelu(v_a), z_a, w_s, b_s, lnv_g, lnv_b)
    qkv_c, conv_new = _short_conv(qkv, conv_buf, conv_w)
    q, k, v = jnp.split(qkv_c, 3, axis=-1)
    q = _l2norm(q.reshape(B, L, H_B, DK))
    k = _l2norm(k.reshape(B, L, H_B, DK))
    v = v.reshape(B, L, H_B, DV)
    g = -jnp.exp(a_log.astype(jnp.float32)) * jax.nn.softplus(a_raw.astype(jnp.float32) + dt_bias.astype(jnp.float32))
    beta = jax.nn.sigmoid(b_raw.astype(jnp.float32))
    o, s_new = _gated_delta(q.transpose(0, 2, 1, 3), k.transpose(0, 2, 1, 3), v.transpose(0, 2, 1, 3),
                            g.transpose(0, 2, 1), beta.transpose(0, 2, 1), s0)
    o = _rmsnorm(o.transpose(0, 2, 1, 3), onorm_g).reshape(B, L, D_B)
    y_b = o * jax.nn.silu(z_b.astype(jnp.float32))
    m = (jax.nn.sigmoid(ga.astype(jnp.float32)) * (y_a.astype(x.dtype) @ w_pa)
         + jax.nn.sigmoid(gb.astype(jnp.float32)) * (y_b.astype(x.dtype) @ w_pb))
    out = m.astype(x.dtype) @ w_o
    x_new = _layernorm(ALPHA_DN * x.astype(jnp.float32) + gate[:, None].astype(jnp.float32) * out.astype(jnp.float32),
                       ln_g, ln_b).astype(x.dtype)
    return x_new, conv_new, s_new, v_rows


def setup_inputs(seed: int = 0) -> dict:
    key = jax.random.key(seed)
    ks = jax.random.split(key, 24)
    f32 = jnp.float32

    def nrm(k, shape, s):
        return jax.random.normal(k, shape, f32) * s

    return {
        "x_prompt": nrm(ks[0], (BATCH, SEQ, D_MODEL), 1.0),
        "x_sample": nrm(ks[1], (DEC_BATCH, DEC_SEQ, D_MODEL), 1.0),
        "state_conv": nrm(ks[2], (DEPTH, DEC_BATCH, CONV_W - 1, 3 * D_B), 1.0),
        "state_ssm": nrm(ks[3], (DEPTH, DEC_BATCH, H_B, DK, DV), DK ** -0.5),
        "c_prompt": nrm(ks[4], (BATCH, D_MODEL), 1.0),
        "c_sample": nrm(ks[5], (DEC_BATCH, D_MODEL), 1.0),
        "w_ada": nrm(ks[6], (DEPTH, D_MODEL, 3 * D_MODEL), 0.5 * D_MODEL ** -0.5),
        "b_ada": nrm(ks[7], (DEPTH, 3 * D_MODEL), 0.02),
        "w_in": nrm(ks[8], (DEPTH, D_MODEL, P_IN), D_MODEL ** -0.5),
        "w_s": nrm(ks[9], (DEPTH, H_A, CHUNK_A, CHUNK_A), CHUNK_A ** -0.5),
        "b_s": nrm(ks[10], (DEPTH, H_A, CHUNK_A), 0.02),
        "lnv_g": 1.0 + nrm(ks[11], (DEPTH, D_A), 0.02),
        "lnv_b": nrm(ks[12], (DEPTH, D_A), 0.02),
        "conv_w": nrm(ks[13], (DEPTH, CONV_W, 3 * D_B), CONV_W ** -0.5),
        "a_log": jnp.log(jax.random.uniform(ks[14], (DEPTH, H_B), f32, 1.0, 16.0)),
        "dt_bias": nrm(ks[15], (DEPTH, H_B), 0.1),
        "onorm_g": 1.0 + nrm(ks[16], (DEPTH, DV), 0.02),
        "w_pa": nrm(ks[17], (DEPTH, D_A, D_MODEL), BETA_DN * D_A ** -0.5),
        "w_pb": nrm(ks[18], (DEPTH, D_B, D_MODEL), BETA_DN * D_B ** -0.5),
        "w_o": nrm(ks[19], (DEPTH, D_MODEL, D_MODEL), BETA_DN * D_MODEL ** -0.5),
        "ln_g": 1.0 + nrm(ks[20], (DEPTH, D_MODEL), 0.02),
        "ln_b": nrm(ks[21], (DEPTH, D_MODEL), 0.02),
    }


def reference(x_prompt, x_sample, state_conv, state_ssm, c_prompt, c_sample, w_ada, b_ada, w_in,
              w_s, b_s, lnv_g, lnv_b, conv_w, a_log, dt_bias, onorm_g, w_pa, w_pb, w_o, ln_g, ln_b):
    xp, xs = x_prompt, x_sample
    bp = x_prompt.shape[0]
    conv_p, ssm_p, vrow_p, conv_s, ssm_s, vrow_s = [], [], [], [], [], []
    for l in range(DEPTH):
        wl = (w_ada[l], b_ada[l], w_in[l], w_s[l], b_s[l], lnv_g[l], lnv_b[l], conv_w[l],
              a_log[l], dt_bias[l], onorm_g[l], w_pa[l], w_pb[l], w_o[l], ln_g[l], ln_b[l])
        buf0 = jnp.zeros((bp, CONV_W - 1, 3 * D_B), x_prompt.dtype)
        s_zero = jnp.zeros((bp, H_B, DK, DV), jnp.float32)
        xp, cp, sp, vp = _layer(xp, c_prompt, buf0, s_zero, *wl)
        xs, cs, ss, vs = _layer(xs, c_sample, state_conv[l], state_ssm[l], *wl)
        conv_p.append(cp.astype(state_conv.dtype))
        ssm_p.append(sp.astype(state_ssm.dtype))
        vrow_p.append(vp.astype(x_prompt.dtype))
        conv_s.append(cs.astype(state_conv.dtype))
        ssm_s.append(ss.astype(state_ssm.dtype))
        vrow_s.append(vs.astype(x_sample.dtype))
    return (xp, xs, jnp.stack(conv_p), jnp.stack(ssm_p), jnp.stack(vrow_p),
            jnp.stack(conv_s), jnp.stack(ssm_s), jnp.stack(vrow_s))
```

```cpp
#include <hip/hip_runtime.h>
#include <hip/hip_cooperative_groups.h>
#include <cstdio>
namespace cg = cooperative_groups;

typedef unsigned short bf16_t;
typedef short bf16x8 __attribute__((ext_vector_type(8)));
typedef float f32x4 __attribute__((ext_vector_type(4)));
typedef unsigned u32x4 __attribute__((ext_vector_type(4)));

constexpr int D = 1024;
constexpr int NB = 8, SEQ = 2048, DEPTH = 4, DBT = 128, DSQ = 4;
constexpr int TP = NB * SEQ;
constexpr int TS = DBT * DSQ;
constexpr int T = TP + TS;
constexpr int PIN = 9232;
constexpr int PC = 9216;
constexpr int NPAD = 9344;
constexpr int NROWB = NB + DBT;
constexpr float ALPHA_DN = 1.681792830507429f;
constexpr float LN_EPS = 1e-5f, NORM_EPS = 1e-6f;
constexpr int C_UA = 0, C_VA = 1024, C_ZA = 2048, C_Q = 3072, C_ZB = 6144, C_GA = 7168, C_GB = 8192;

constexpr size_t O_Y_P = 0, O_Y_S = 16777216, O_CONV_P = 17301504, O_SSM_P = 17596416, O_CV_P = 21790720,
                 O_CONV_S = 25985024, O_SSM_S = 30703616, O_CV_S = 97812480;

constexpr size_t SZ_WT_IN = (size_t)DEPTH * NPAD * 1024 * 2;
constexpr size_t SZ_WT_SQ = (size_t)DEPTH * 1024 * 1024 * 2;
constexpr size_t OFF_WT_IN = 0;
constexpr size_t OFF_WT_PA = OFF_WT_IN + SZ_WT_IN;
constexpr size_t OFF_WT_PB = OFF_WT_PA + SZ_WT_SQ;
constexpr size_t OFF_WT_O = OFF_WT_PB + SZ_WT_SQ;
constexpr size_t OFF_MOD = OFF_WT_O + SZ_WT_SQ;
constexpr size_t OFF_X = OFF_MOD + (size_t)DEPTH * NROWB * 3072 * 4;
constexpr size_t OFF_TT = OFF_X + (size_t)T * 1024 * 4;
constexpr size_t OFF_H = OFF_TT + (size_t)T * 1024 * 4;
constexpr size_t OFF_YA = OFF_H + (size_t)T * 1024 * 2;
constexpr size_t OFF_YB = OFF_YA + (size_t)T * 1024 * 2;
constexpr size_t OFF_MM = OFF_YB + (size_t)T * 1024 * 2;
constexpr size_t OFF_P = OFF_MM + (size_t)T * 1024 * 2;
constexpr size_t OFF_BETA = OFF_P + (size_t)T * PC * 2;
constexpr size_t OFF_GLOG = OFF_BETA + (size_t)T * 8 * 4;
constexpr int NCHK = 2048;
constexpr size_t OFF_U = OFF_GLOG + (size_t)T * 8 * 4;
constexpr size_t OFF_WG = OFF_U + (size_t)NCHK * 8192 * 4;
constexpr size_t OFF_QG = OFF_WG + (size_t)NCHK * 8192 * 2;
constexpr size_t OFF_KDT = OFF_QG + (size_t)NCHK * 8192 * 2;
constexpr size_t OFF_QK = OFF_KDT + (size_t)NCHK * 8192 * 2;
constexpr size_t OFF_EG = OFF_QK + (size_t)NCHK * 4096 * 2;
constexpr size_t OFF_SB = OFF_EG + (size_t)NCHK * 4;
constexpr size_t OFF_VN = OFF_SB + (size_t)NCHK * 16384 * 2;
constexpr size_t OFF_PARK = OFF_VN + (size_t)NCHK * 8192 * 2;
constexpr size_t OFF_STATS = OFF_PARK + (size_t)1024 * 32768;
constexpr size_t OFF_BAR = OFF_STATS + (size_t)T * 2 * 4;
constexpr size_t WS_NEED = OFF_BAR + 16384;

constexpr int SMEM_BYTES = 73728;
constexpr int TILE_BYTES = 128 * 128;

struct Params {
    const float *x_prompt, *x_sample, *state_conv, *state_ssm, *c_prompt, *c_sample, *w_ada, *b_ada, *w_in, *w_s, *b_s,
        *lnv_g, *lnv_b, *conv_w, *a_log, *dt_bias, *onorm_g, *w_pa, *w_pb, *w_o, *ln_g, *ln_b;
    float* out;
    char* ws;
};

__device__ __forceinline__ unsigned pack2(float a, float b) {
    unsigned r;
    asm("v_cvt_pk_bf16_f32 %0, %1, %2" : "=v"(r) : "v"(a), "v"(b));
    return r;
}
__device__ __forceinline__ bf16_t f2bf(float f) { return (bf16_t)(pack2(f, 0.f) & 0xffffu); }
__device__ __forceinline__ float bf2f(bf16_t h) { return __uint_as_float(((unsigned)h) << 16); }
__device__ __forceinline__ float lo_bf(unsigned u) { return __uint_as_float(u << 16); }
__device__ __forceinline__ float hi_bf(unsigned u) { return __uint_as_float(u & 0xffff0000u); }
__device__ __forceinline__ float sigmoid_f(float x) { return __builtin_amdgcn_rcpf(1.f + __builtin_amdgcn_exp2f(-1.4426950408889634f * x)); }
__device__ __forceinline__ float silu_f(float x) { return x * sigmoid_f(x); }
__device__ __forceinline__ float gelu_f(float x) {
    const float y2 = x * (1.5957691216057308f + 0.0713548162726f * x * x);
    return x * __builtin_amdgcn_rcpf(1.f + __builtin_amdgcn_exp2f(-1.4426950408889634f * y2));
}
__device__ __forceinline__ float softplus_f(float x) { return fmaxf(x, 0.f) + log1pf(__expf(-fabsf(x))); }
__device__ __forceinline__ float wave_sum(float v) {
#pragma unroll
    for (int o = 32; o >= 1; o >>= 1) v += __shfl_xor(v, o);
    return v;
}
__device__ __forceinline__ f32x4 mfma16(bf16x8 a, bf16x8 b, f32x4 c) { return __builtin_amdgcn_mfma_f32_16x16x32_bf16(a, b, c, 0, 0, 0); }
template <class Tp> __device__ __forceinline__ Tp ldg_b(const void* base, unsigned boff) { return *(const Tp*)((const char*)base + boff); }
template <class Tp> __device__ __forceinline__ void stg_b(void* base, unsigned boff, Tp v) { *(Tp*)((char*)base + boff) = v; }
__host__ __device__ constexpr int perm32(int k) { return (k & ~31) | (((k >> 2) & 3) << 3) | (((k >> 4) & 1) << 2) | (k & 3); }
__device__ __forceinline__ int opaque_tid() { int t = threadIdx.x; asm volatile("" : "+v"(t)); return t; }
__device__ __forceinline__ int opaque_zero() { int z = 0; asm volatile("" : "+v"(z)); return z; }
__device__ __forceinline__ int cond_row(int row) { return row < TP ? (row >> 11) : (NB + ((row - TP) >> 2)); }

template <int WGM = 8>
__device__ __forceinline__ void tile_map(int L, int ntiles, int nM, int nN, int& tm, int& tn) {
    const int q = ntiles / 8, r = ntiles % 8, xcd = L % 8, off = L / 8;
    const int g = (xcd < r ? xcd * (q + 1) : r * (q + 1) + (xcd - r) * q) + off;
    const int nig = WGM * nN, gid = g / nig, fm = gid * WGM, gsz = (nM - fm) < WGM ? (nM - fm) : WGM;
    tm = fm + (g % nig) % gsz;
    tn = (g % nig) / gsz;
}

template <int MT>
__device__ __forceinline__ void gemm_core(const bf16_t* __restrict__ A, const bf16_t* __restrict__ B, const int K,
                                          f32x4 (&acc)[MT][4], char* smem, const int tid) {
    const int lane = tid & 63, wid = tid >> 6, wr = wid >> 1, wc = wid & 1;
    const int srow = tid >> 3, sseg = (tid & 7) ^ ((tid >> 3) & 7);
    const bf16_t* ag = A + (size_t)srow * K + sseg * 8;
    const bf16_t* bg = B + (size_t)srow * K + sseg * 8;
    const int nk = K >> 6;
#define STAGE(BUF, KT) do { char* d_ = smem + (BUF) * 2 * TILE_BYTES + tid * 16; \
        _Pragma("unroll") for (int i = 0; i < MT; ++i) __builtin_amdgcn_global_load_lds((const unsigned*)(ag + (size_t)(32 * i) * K + (KT) * 64), (__attribute__((address_space(3))) unsigned*)(d_ + i * 4096), 16, 0, 0); \
        _Pragma("unroll") for (int i = 0; i < 4; ++i) __builtin_amdgcn_global_load_lds((const unsigned*)(bg + (size_t)(32 * i) * K + (KT) * 64), (__attribute__((address_space(3))) unsigned*)(d_ + TILE_BYTES + i * 4096), 16, 0, 0); } while (0)
#define COMPUTE(BUF) do { const char* cur = smem + (BUF) * 2 * TILE_BYTES; _Pragma("unroll") for (int kk = 0; kk < 2; ++kk) { \
        bf16x8 af[MT], bfr[4]; const int ko = kk ? kx1 : kx0; \
        _Pragma("unroll") for (int m = 0; m < MT; ++m) af[m] = *(const bf16x8*)(cur + aoff + m * 16 * 128 + ko); \
        _Pragma("unroll") for (int n = 0; n < 4; ++n) bfr[n] = *(const bf16x8*)(cur + boff + n * 16 * 128 + ko); \
        _Pragma("unroll") for (int m = 0; m < MT; ++m) _Pragma("unroll") for (int n = 0; n < 4; ++n) acc[m][n] = mfma16(bfr[n], af[m], acc[m][n]); } } while (0)
    const int fr = lane & 15, fq = lane >> 4;
    const int aoff = (wr * 16 * MT + fr) * 128;
    const int boff = TILE_BYTES + (wc * 64 + fr) * 128;
    const int kx0 = (fq ^ (fr & 7)) << 4, kx1 = ((4 + fq) ^ (fr & 7)) << 4;
    __syncthreads();
    STAGE(0, 0);
    asm volatile("s_waitcnt vmcnt(0)" ::: "memory");
    __syncthreads();
    for (int kt = 0; kt < nk; ++kt) {
        if (kt + 1 < nk) STAGE((kt + 1) & 1, kt + 1);
        COMPUTE(kt & 1);
        asm volatile("s_waitcnt vmcnt(0)" ::: "memory");
        __syncthreads();
    }
#undef STAGE
#undef COMPUTE
}

__device__ __forceinline__ int win_src_col(int np) {
    if (np < 7168) return np;
    if (np < 9216) return np + 16;
    if (np < 9232) return np - 9216 + 7168;
    return -1;
}
__device__ __forceinline__ void transpose_item(const float* __restrict__ src, int ld, bool is_win, bf16_t* __restrict__ dst, int kt, int nt, char* smem) {
    smem += opaque_zero();
    float* tile = (float*)smem;
    const int tid = opaque_tid();
    __syncthreads();
    const int nn = tid & 63, kq = tid >> 6;
    const int np = nt * 64 + nn;
    const int oc = is_win ? win_src_col(np) : np;
#pragma unroll
    for (int i = 0; i < 16; ++i) {
        const int kk = kq + 4 * i;
        tile[kk * 65 + nn] = oc >= 0 ? src[(size_t)(kt * 64 + kk) * ld + oc] : 0.f;
    }
    __syncthreads();
    const int r = tid >> 2, seg = tid & 3;
    unsigned pk[8];
#pragma unroll
    for (int j = 0; j < 8; ++j) pk[j] = pack2(tile[(seg * 16 + 2 * j) * 65 + r], tile[(seg * 16 + 2 * j + 1) * 65 + r]);
    uint4* d = (uint4*)(dst + (size_t)(nt * 64 + r) * 1024 + kt * 64 + seg * 16);
    d[0] = make_uint4(pk[0], pk[1], pk[2], pk[3]);
    d[1] = make_uint4(pk[4], pk[5], pk[6], pk[7]);
}

__device__ __forceinline__ void mod_item(const Params& p, int it, char* smem) {
    smem += opaque_zero();
    float* sc = (float*)smem;
    const int tid = opaque_tid();
    const int rg = it & 7, cb = (it >> 3) % 12, l = it / 96;
    __syncthreads();
    for (int idx = tid; idx < 17 * 1024; idx += 256) {
        const int r = idx >> 10, k = idx & 1023, row = rg * 17 + r;
        const float c = row < NB ? p.c_prompt[row * 1024 + k] : p.c_sample[(row - NB) * 1024 + k];
        sc[idx] = silu_f(c);
    }
    __syncthreads();
    const int col = cb * 256 + tid;
    float acc[17];
#pragma unroll
    for (int r = 0; r < 17; ++r) acc[r] = 0.f;
    const float* wp = p.w_ada + (size_t)l * 1024 * 3072 + col;
    for (int k = 0; k < 1024; k += 4) {
        const float w0 = wp[(size_t)(k + 0) * 3072], w1 = wp[(size_t)(k + 1) * 3072], w2 = wp[(size_t)(k + 2) * 3072], w3 = wp[(size_t)(k + 3) * 3072];
#pragma unroll
        for (int r = 0; r < 17; ++r) {
            const float4 s = *(const float4*)&sc[r * 1024 + k];
            acc[r] += s.x * w0 + s.y * w1 + s.z * w2 + s.w * w3;
        }
    }
    float* mod = (float*)(p.ws + OFF_MOD);
    const float bb = p.b_ada[l * 3072 + col];
#pragma unroll
    for (int r = 0; r < 17; ++r) mod[((size_t)l * NROWB + rg * 17 + r) * 3072 + col] = acc[r] + bb;
}

constexpr int N_TR_IN = (NPAD / 64) * 16;
constexpr int N_TR_SQ = 16 * 16;
constexpr int N_TR_LAYER = N_TR_IN + 3 * N_TR_SQ;
constexpr int N_P0_TR = DEPTH * N_TR_LAYER;
constexpr int N_P0_MOD = DEPTH * 12 * 8;

__device__ __forceinline__ void phase0(const Params& p, char* smem) {
    for (int it = blockIdx.x; it < N_P0_TR + N_P0_MOD; it += gridDim.x) {
        if (it < N_P0_TR) {
            const int l = it / N_TR_LAYER;
            int r = it % N_TR_LAYER;
            if (r < N_TR_IN) {
                transpose_item(p.w_in + (size_t)l * 1024 * PIN, PIN, true, (bf16_t*)(p.ws + OFF_WT_IN) + (size_t)l * NPAD * 1024, r & 15, r >> 4, smem);
            } else {
                r -= N_TR_IN;
                const int which = r / N_TR_SQ;
                r %= N_TR_SQ;
                const float* src = (which == 0 ? p.w_pa : which == 1 ? p.w_pb : p.w_o) + (size_t)l * 1024 * 1024;
                bf16_t* dst = (bf16_t*)(p.ws + (which == 0 ? OFF_WT_PA : which == 1 ? OFF_WT_PB : OFF_WT_O)) + (size_t)l * 1024 * 1024;
                transpose_item(src, 1024, false, dst, r & 15, r >> 4, smem);
            }
        } else {
            mod_item(p, it - N_P0_TR, smem);
        }
    }
}

__device__ __forceinline__ void phase_rows(const Params& p, int l) {
    const int tid = opaque_tid();
    const int lane = tid & 63;
    const int gw = blockIdx.x * 4 + (tid >> 6), nw = gridDim.x * 4;
    float* X = (float*)(p.ws + OFF_X);
    const float* TT = (const float*)(p.ws + OFF_TT);
    bf16_t* H = (bf16_t*)(p.ws + OFF_H);
    const float* mod = (const float*)(p.ws + OFF_MOD);
    for (int row = gw; row < T; row += nw) {
        float v[16];
        if (l == 0) {
            const float* src = row < TP ? p.x_prompt + (size_t)row * 1024 : p.x_sample + (size_t)(row - TP) * 1024;
#pragma unroll
            for (int j = 0; j < 4; ++j) {
                const float4 t = *(const float4*)(src + j * 256 + lane * 4);
                v[j * 4 + 0] = t.x; v[j * 4 + 1] = t.y; v[j * 4 + 2] = t.z; v[j * 4 + 3] = t.w;
            }
        } else {
            const float* src = TT + (size_t)row * 1024;
            float s = 0.f;
#pragma unroll
            for (int j = 0; j < 4; ++j) {
                const float4 t = *(const float4*)(src + j * 256 + lane * 4);
                v[j * 4 + 0] = t.x; v[j * 4 + 1] = t.y; v[j * 4 + 2] = t.z; v[j * 4 + 3] = t.w;
                s += t.x + t.y + t.z + t.w;
            }
            const float mean = wave_sum(s) * (1.f / 1024.f);
            float q = 0.f;
#pragma unroll
            for (int e = 0; e < 16; ++e) { v[e] -= mean; q += v[e] * v[e]; }
            const float rstd = rsqrtf(wave_sum(q) * (1.f / 1024.f) + LN_EPS);
            const float* g = p.ln_g + (l - 1) * 1024;
            const float* bb = p.ln_b + (l - 1) * 1024;
#pragma unroll
            for (int j = 0; j < 4; ++j) {
                const float4 gg = *(const float4*)(g + j * 256 + lane * 4);
                const float4 be = *(const float4*)(bb + j * 256 + lane * 4);
                v[j * 4 + 0] = v[j * 4 + 0] * rstd * gg.x + be.x;
                v[j * 4 + 1] = v[j * 4 + 1] * rstd * gg.y + be.y;
                v[j * 4 + 2] = v[j * 4 + 2] * rstd * gg.z + be.z;
                v[j * 4 + 3] = v[j * 4 + 3] * rstd * gg.w + be.w;
            }
        }
        if (l == DEPTH) {
            float* dst = row < TP ? p.out + O_Y_P + (size_t)row * 1024 : p.out + O_Y_S + (size_t)(row - TP) * 1024;
#pragma unroll
            for (int j = 0; j < 4; ++j) *(float4*)(dst + j * 256 + lane * 4) = make_float4(v[j * 4], v[j * 4 + 1], v[j * 4 + 2], v[j * 4 + 3]);
            continue;
        }
        if (lane == 0) *(float2*)((float*)(p.ws + OFF_STATS) + (size_t)row * 2) = make_float2(0.f, 0.f);
        {
            float* dst = X + (size_t)row * 1024;
            float s = 0.f;
#pragma unroll
            for (int j = 0; j < 4; ++j) {
                *(float4*)(dst + j * 256 + lane * 4) = make_float4(v[j * 4], v[j * 4 + 1], v[j * 4 + 2], v[j * 4 + 3]);
                s += v[j * 4] + v[j * 4 + 1] + v[j * 4 + 2] + v[j * 4 + 3];
            }
            const float mean = wave_sum(s) * (1.f / 1024.f);
            float q = 0.f;
#pragma unroll
            for (int e = 0; e < 16; ++e) { v[e] -= mean; q += v[e] * v[e]; }
            const float rstd = rsqrtf(wave_sum(q) * (1.f / 1024.f) + LN_EPS);
            const float* mrow = mod + ((size_t)l * NROWB + cond_row(row)) * 3072;
#pragma unroll
            for (int j = 0; j < 4; ++j) {
                const float4 sh = *(const float4*)(mrow + j * 256 + lane * 4);
                const float4 scl = *(const float4*)(mrow + 1024 + j * 256 + lane * 4);
                const float h0 = v[j * 4 + 0] * rstd * (1.f + scl.x) + sh.x;
                const float h1 = v[j * 4 + 1] * rstd * (1.f + scl.y) + sh.y;
                const float h2 = v[j * 4 + 2] * rstd * (1.f + scl.z) + sh.z;
                const float h3 = v[j * 4 + 3] * rstd * (1.f + scl.w) + sh.w;
                *(uint2*)(H + (size_t)row * 1024 + j * 256 + lane * 4) = make_uint2(pack2(h0, h1), pack2(h2, h3));
            }
        }
    }
}

__device__ __forceinline__ void phase_inproj(const Params& p, int l, char* smem) {
    const bf16_t* H = (const bf16_t*)(p.ws + OFF_H);
    const bf16_t* Wt = (const bf16_t*)(p.ws + OFF_WT_IN) + (size_t)l * NPAD * 1024;
    bf16_t* P = (bf16_t*)(p.ws + OFF_P);
    float* BETA = (float*)(p.ws + OFF_BETA);
    float* GLOG = (float*)(p.ws + OFF_GLOG);
    constexpr int nM = T / 128, nN = NPAD / 128, ntiles = nM * nN;
    for (int L = blockIdx.x; L < ntiles; L += gridDim.x) {
        const int tid = opaque_tid();
        const int lane = tid & 63, wid = tid >> 6, wr = wid >> 1, wc = wid & 1, fr = lane & 15, fq = lane >> 4;
        int tm, tn;
        tile_map(L, ntiles, nM, nN, tm, tn);
        f32x4 acc[4][4];
#pragma unroll
        for (int m = 0; m < 4; ++m)
#pragma unroll
            for (int n = 0; n < 4; ++n) acc[m][n] = (f32x4){0.f, 0.f, 0.f, 0.f};
        gemm_core<4>(H + (size_t)tm * 128 * 1024, Wt + (size_t)tn * 128 * 1024, 1024, acc, smem, tid);
        if (tn == 72) {
            if (wc == 0) {
#pragma unroll
                for (int m = 0; m < 4; ++m) {
                    const int row = tm * 128 + wr * 64 + m * 16 + fr;
#pragma unroll
                    for (int r = 0; r < 4; ++r) {
                        const float a = acc[m][0][r];
                        if (fq < 2) {
                            BETA[(size_t)row * 8 + fq * 4 + r] = sigmoid_f(a);
                        } else {
                            const int h = (fq - 2) * 4 + r;
                            GLOG[(size_t)row * 8 + h] = -__expf(p.a_log[l * 8 + h]) * softplus_f(a + p.dt_bias[l * 8 + h]);
                        }
                    }
                }
            }
        } else {
            const int kind = tn < 16 ? 0 : tn < 24 ? 1 : tn < 48 ? 2 : tn < 56 ? 1 : 3;
            char* st = smem + opaque_zero();
#pragma unroll
            for (int m = 0; m < 4; ++m) {
                const int rl = wr * 64 + m * 16 + fr;
#pragma unroll
                for (int n = 0; n < 4; ++n) {
                    const int cl = wc * 64 + n * 16 + fq * 4;
                    float a[4];
#pragma unroll
                    for (int r = 0; r < 4; ++r) {
                        const float x = acc[m][n][r];
                        a[r] = kind == 0 ? gelu_f(x) : kind == 1 ? silu_f(x) : kind == 2 ? x : sigmoid_f(x);
                    }
                    *(uint2*)(st + rl * 272 + cl * 2) = make_uint2(pack2(a[0], a[1]), pack2(a[2], a[3]));
                }
            }
            __syncthreads();
#pragma unroll
            for (int i = 0; i < 8; ++i) {
                const int rl = (tid >> 4) + 16 * i, sg = tid & 15;
                const u32x4 v = *(const u32x4*)(st + rl * 272 + sg * 16);
                *(u32x4*)(P + (size_t)(tm * 128 + rl) * PC + tn * 128 + sg * 8) = v;
                if (tn >= 8 && tn < 16) {
                    const float a0 = lo_bf(v[0]), a1 = hi_bf(v[0]), a2 = lo_bf(v[1]), a3 = hi_bf(v[1]), a4 = lo_bf(v[2]), a5 = hi_bf(v[2]), a6 = lo_bf(v[3]), a7 = hi_bf(v[3]);
                    float sm = ((a0 + a1) + (a2 + a3)) + ((a4 + a5) + (a6 + a7));
                    float sq = ((a0 * a0 + a1 * a1) + (a2 * a2 + a3 * a3)) + ((a4 * a4 + a5 * a5) + (a6 * a6 + a7 * a7));
#pragma unroll
                    for (int o = 1; o < 16; o <<= 1) { sm += __shfl_xor(sm, o); sq += __shfl_xor(sq, o); }
                    if (sg == 0) {
                        float* stp = (float*)(p.ws + OFF_STATS) + (size_t)(tm * 128 + rl) * 2;
                        atomicAdd(stp, sm);
                        atomicAdd(stp + 1, sq);
                    }
                }
            }
        }
    }
}

constexpr int T2_A = 256 * 64, T2_B = 128 * 64, T2_STAGE = T2_A + T2_B;
__device__ __forceinline__ void gemm_core256(const bf16_t* __restrict__ A, const bf16_t* __restrict__ B, const int K,
                                             f32x4 (&acc)[8][4], char* smem, const int tid) {
    const int lane = tid & 63, wid = tid >> 6, wr = wid >> 1, wc = wid & 1, fr = lane & 15, fq = lane >> 4;
    const int srow = tid >> 2, sseg = (tid & 3) ^ ((tid >> 3) & 3);
    const bf16_t* ag = A + (size_t)srow * K + sseg * 8;
    const bf16_t* bg = B + (size_t)srow * K + sseg * 8;
    const int sw = (fq ^ ((fr >> 1) & 3)) << 4;
    const int aoff = (wr * 128 + fr) * 64 + sw;
    const int boff = T2_A + (wc * 64 + fr) * 64 + sw;
    const int nk = K >> 5;
#define STAGE2(BUF, KT) do { char* d_ = smem + (BUF) * T2_STAGE + tid * 16; \
        _Pragma("unroll") for (int i = 0; i < 4; ++i) __builtin_amdgcn_global_load_lds((const unsigned*)(ag + (size_t)(64 * i) * K + (KT) * 32), (__attribute__((address_space(3))) unsigned*)(d_ + i * 4096), 16, 0, 0); \
        _Pragma("unroll") for (int i = 0; i < 2; ++i) __builtin_amdgcn_global_load_lds((const unsigned*)(bg + (size_t)(64 * i) * K + (KT) * 32), (__attribute__((address_space(3))) unsigned*)(d_ + T2_A + i * 4096), 16, 0, 0); } while (0)
    __syncthreads();
    STAGE2(0, 0);
    STAGE2(1, 1);
    asm volatile("s_waitcnt vmcnt(6)" ::: "memory");
    __builtin_amdgcn_s_barrier();
    asm volatile("" ::: "memory");
    int cb = 0, nb = 2;
    for (int kt = 0; kt < nk; ++kt) {
        const char* cur = smem + cb * T2_STAGE;
        bf16x8 bfr[4], af[8];
#pragma unroll
        for (int n = 0; n < 4; ++n) bfr[n] = *(const bf16x8*)(cur + boff + n * 16 * 64);
#pragma unroll
        for (int m = 0; m < 8; ++m) af[m] = *(const bf16x8*)(cur + aoff + m * 16 * 64);
        __builtin_amdgcn_sched_barrier(0);
#pragma unroll
        for (int m = 0; m < 8; ++m)
#pragma unroll
            for (int n = 0; n < 4; ++n) acc[m][n] = mfma16(bfr[n], af[m], acc[m][n]);
        __builtin_amdgcn_sched_barrier(0);
        if (kt + 2 < nk) STAGE2(nb, kt + 2);
        if (kt + 2 < nk) asm volatile("s_waitcnt vmcnt(6)" ::: "memory");
        else asm volatile("s_waitcnt vmcnt(0)" ::: "memory");
        __builtin_amdgcn_s_barrier();
        asm volatile("" ::: "memory");
        cb = cb == 2 ? 0 : cb + 1;
        nb = nb == 2 ? 0 : nb + 1;
    }
#undef STAGE2
    __syncthreads();
}

__device__ __forceinline__ void phase_inproj256(const Params& p, int l, char* smem) {
    const bf16_t* H = (const bf16_t*)(p.ws + OFF_H);
    const bf16_t* Wt = (const bf16_t*)(p.ws + OFF_WT_IN) + (size_t)l * NPAD * 1024;
    bf16_t* P = (bf16_t*)(p.ws + OFF_P);
    float* BETA = (float*)(p.ws + OFF_BETA);
    float* GLOG = (float*)(p.ws + OFF_GLOG);
    constexpr int nM = T / 256, nN = NPAD / 128, ntiles = nM * nN;
    for (int L = blockIdx.x; L < ntiles; L += gridDim.x) {
        const int tid = opaque_tid();
        const int lane = tid & 63, wid = tid >> 6, wr = wid >> 1, wc = wid & 1, fr = lane & 15, fq = lane >> 4;
        int tm, tn;
        tile_map<4>(L, ntiles, nM, nN, tm, tn);
        f32x4 acc[8][4];
#pragma unroll
        for (int m = 0; m < 8; ++m)
#pragma unroll
            for (int n = 0; n < 4; ++n) acc[m][n] = (f32x4){0.f, 0.f, 0.f, 0.f};
        gemm_core256(H + (size_t)tm * 256 * 1024, Wt + (size_t)tn * 128 * 1024, 1024, acc, smem, tid);
        if (tn == 72) {
            if (wc == 0) {
#pragma unroll
                for (int m = 0; m < 8; ++m) {
                    const int row = tm * 256 + wr * 128 + m * 16 + fr;
#pragma unroll
                    for (int r = 0; r < 4; ++r) {
                        const float a = acc[m][0][r];
                        if (fq < 2) {
                            BETA[(size_t)row * 8 + fq * 4 + r] = sigmoid_f(a);
                        } else {
                            const int h = (fq - 2) * 4 + r;
                            GLOG[(size_t)row * 8 + h] = -__expf(p.a_log[l * 8 + h]) * softplus_f(a + p.dt_bias[l * 8 + h]);
                        }
                    }
                }
            }
        } else {
            const int kind = tn < 16 ? 0 : tn < 24 ? 1 : tn < 48 ? 2 : tn < 56 ? 1 : 3;
            char* st = smem + opaque_zero();
#pragma unroll
            for (int m = 0; m < 8; ++m) {
                const int rl = wr * 128 + m * 16 + fr;
#pragma unroll
                for (int n = 0; n < 4; ++n) {
                    const int cl = wc * 64 + n * 16 + fq * 4;
                    float a[4];
#pragma unroll
                    for (int r = 0; r < 4; ++r) {
                        const float x = acc[m][n][r];
                        a[r] = kind == 0 ? gelu_f(x) : kind == 1 ? silu_f(x) : kind == 2 ? x : sigmoid_f(x);
                    }
                    *(uint2*)(st + rl * 272 + cl * 2) = make_uint2(pack2(a[0], a[1]), pack2(a[2], a[3]));
                }
            }
            __syncthreads();
#pragma unroll 4
            for (int i = 0; i < 16; ++i) {
                const int rl = (tid >> 4) + 16 * i, sg = tid & 15;
                const u32x4 v = *(const u32x4*)(st + rl * 272 + sg * 16);
                *(u32x4*)(P + (size_t)(tm * 256 + rl) * PC + tn * 128 + sg * 8) = v;
                if (tn >= 8 && tn < 16) {
                    const float a0 = lo_bf(v[0]), a1 = hi_bf(v[0]), a2 = lo_bf(v[1]), a3 = hi_bf(v[1]), a4 = lo_bf(v[2]), a5 = hi_bf(v[2]), a6 = lo_bf(v[3]), a7 = hi_bf(v[3]);
                    float sm = ((a0 + a1) + (a2 + a3)) + ((a4 + a5) + (a6 + a7));
                    float sq = ((a0 * a0 + a1 * a1) + (a2 * a2 + a3 * a3)) + ((a4 * a4 + a5 * a5) + (a6 * a6 + a7 * a7));
#pragma unroll
                    for (int o = 1; o < 16; o <<= 1) { sm += __shfl_xor(sm, o); sq += __shfl_xor(sq, o); }
                    if (sg == 0) {
                        float* stp = (float*)(p.ws + OFF_STATS) + (size_t)(tm * 256 + rl) * 2;
                        atomicAdd(stp, sm);
                        atomicAdd(stp + 1, sq);
                    }
                }
            }
        }
    }
}

__device__ __forceinline__ void phase_merge(const Params& p, int l, char* smem) {
    const bf16_t* YA = (const bf16_t*)(p.ws + OFF_YA);
    const bf16_t* YB = (const bf16_t*)(p.ws + OFF_YB);
    const bf16_t* Wa = (const bf16_t*)(p.ws + OFF_WT_PA) + (size_t)l * 1024 * 1024;
    const bf16_t* Wb = (const bf16_t*)(p.ws + OFF_WT_PB) + (size_t)l * 1024 * 1024;
    const bf16_t* P = (const bf16_t*)(p.ws + OFF_P);
    bf16_t* MM = (bf16_t*)(p.ws + OFF_MM);
    constexpr int RT = 96, MT = 3;
    constexpr int nM = T / RT, nN = 8, ntiles = nM * nN;
    for (int L = blockIdx.x; L < ntiles; L += gridDim.x) {
        const int tid = opaque_tid();
        const int lane = tid & 63, wid = tid >> 6, wr = wid >> 1, wc = wid & 1, fr = lane & 15, fq = lane >> 4;
        int tm, tn;
        tile_map(L, ntiles, nM, nN, tm, tn);
        f32x4 acc[MT][4];
#pragma unroll
        for (int m = 0; m < MT; ++m)
#pragma unroll
            for (int n = 0; n < 4; ++n) acc[m][n] = (f32x4){0.f, 0.f, 0.f, 0.f};
        gemm_core<MT>(YA + (size_t)tm * RT * 1024, Wa + (size_t)tn * 128 * 1024, 1024, acc, smem, tid);
        uint2* park = (uint2*)(p.ws + OFF_PARK) + (size_t)blockIdx.x * 4096 + tid;
#pragma unroll
        for (int m = 0; m < MT; ++m) {
            const int row = tm * RT + wr * 16 * MT + m * 16 + fr;
#pragma unroll
            for (int n = 0; n < 4; ++n) {
                const int col = tn * 128 + wc * 64 + n * 16 + fq * 4;
                const uint2 g = *(const uint2*)(P + (size_t)row * PC + C_GA + col);
                park[(m * 4 + n) * 256] = make_uint2(pack2(acc[m][n][0] * lo_bf(g.x), acc[m][n][1] * hi_bf(g.x)),
                                                     pack2(acc[m][n][2] * lo_bf(g.y), acc[m][n][3] * hi_bf(g.y)));
                acc[m][n] = (f32x4){0.f, 0.f, 0.f, 0.f};
            }
            __builtin_amdgcn_sched_barrier(0);
        }
        gemm_core<MT>(YB + (size_t)tm * RT * 1024, Wb + (size_t)tn * 128 * 1024, 1024, acc, smem, tid);
        char* st = smem + opaque_zero();
#pragma unroll
        for (int m = 0; m < MT; ++m) {
            const int rl = wr * 16 * MT + m * 16 + fr;
            const int row = tm * RT + rl;
#pragma unroll
            for (int n = 0; n < 4; ++n) {
                const int cl = wc * 64 + n * 16 + fq * 4;
                const uint2 g = *(const uint2*)(P + (size_t)row * PC + C_GB + tn * 128 + cl);
                const uint2 pm = park[(m * 4 + n) * 256];
                const float a0 = lo_bf(pm.x) + acc[m][n][0] * lo_bf(g.x);
                const float a1 = hi_bf(pm.x) + acc[m][n][1] * hi_bf(g.x);
                const float a2 = lo_bf(pm.y) + acc[m][n][2] * lo_bf(g.y);
                const float a3 = hi_bf(pm.y) + acc[m][n][3] * hi_bf(g.y);
                *(uint2*)(st + rl * 272 + cl * 2) = make_uint2(pack2(a0, a1), pack2(a2, a3));
            }
            __builtin_amdgcn_sched_barrier(0);
        }
        __syncthreads();
#pragma unroll
        for (int i = 0; i < RT / 16; ++i) {
            const int rl = (tid >> 4) + 16 * i, sg = tid & 15;
            const u32x4 v = *(const u32x4*)(st + rl * 272 + sg * 16);
            *(u32x4*)(MM + (size_t)(tm * RT + rl) * 1024 + tn * 128 + sg * 8) = v;
        }
    }
}

__device__ __forceinline__ void phase_outproj(const Params& p, int l, char* smem) {
    const bf16_t* MM = (const bf16_t*)(p.ws + OFF_MM);
    const bf16_t* Wo = (const bf16_t*)(p.ws + OFF_WT_O) + (size_t)l * 1024 * 1024;
    const float* X = (const float*)(p.ws + OFF_X);
    float* TT = (float*)(p.ws + OFF_TT);
    const float* mod = (const float*)(p.ws + OFF_MOD);
    constexpr int RT = 96, MT = 3;
    constexpr int nM = T / RT, nN = 8, ntiles = nM * nN;
    for (int L = blockIdx.x; L < ntiles; L += gridDim.x) {
        const int tid = opaque_tid();
        const int lane = tid & 63, wid = tid >> 6, wr = wid >> 1, wc = wid & 1, fr = lane & 15, fq = lane >> 4;
        int tm, tn;
        tile_map(L, ntiles, nM, nN, tm, tn);
        f32x4 acc[MT][4];
#pragma unroll
        for (int m = 0; m < MT; ++m)
#pragma unroll
            for (int n = 0; n < 4; ++n) acc[m][n] = (f32x4){0.f, 0.f, 0.f, 0.f};
        gemm_core<MT>(MM + (size_t)tm * RT * 1024, Wo + (size_t)tn * 128 * 1024, 1024, acc, smem, tid);
        float* st = (float*)(smem + opaque_zero());
#pragma unroll
        for (int m = 0; m < MT; ++m)
#pragma unroll
            for (int n = 0; n < 4; ++n) *(f32x4*)(st + (wr * 16 * MT + m * 16 + fr) * 132 + wc * 64 + n * 16 + fq * 4) = acc[m][n];
        __syncthreads();
#pragma unroll 4
        for (int i = 0; i < RT / 8; ++i) {
            const int rl = (tid >> 5) + 8 * i, c4 = (tid & 31) * 4;
            const int row = tm * RT + rl, col = tn * 128 + c4;
            const f32x4 a = *(const f32x4*)(st + rl * 132 + c4);
            const float4 x = *(const float4*)(X + (size_t)row * 1024 + col);
            const float4 g = *(const float4*)(mod + ((size_t)l * NROWB + cond_row(row)) * 3072 + 2048 + col);
            *(float4*)(TT + (size_t)row * 1024 + col) = make_float4(ALPHA_DN * x.x + g.x * a[0], ALPHA_DN * x.y + g.y * a[1],
                                                                    ALPHA_DN * x.z + g.z * a[2], ALPHA_DN * x.w + g.w * a[3]);
        }
    }
}

__device__ __forceinline__ void gmlp_prompt_item(const Params& p, int l, int it, char* smem) {
    smem += opaque_zero();
    const int tid = opaque_tid(), lane = tid & 63, wid = tid >> 6, wr = wid >> 1, wc = wid & 1, fr = lane & 15, fq = lane >> 4;
    const int h = it & 7, n = (it >> 3) & 15, b = it >> 7;
    const int tok0 = b * SEQ + n * 128;
    const bf16_t* P = (const bf16_t*)(p.ws + OFF_P);
    bf16_t* YA = (bf16_t*)(p.ws + OFF_YA);
    bf16_t* Wt = (bf16_t*)smem;
    bf16_t* VnT = Wt + 128 * 136;
    float* mu = (float*)(smem + 2 * 34816);
    float* rs = mu + 128;
    __syncthreads();
    {
        const int t = tid >> 1, half = tid & 1;
        if (half == 0) {
            const float2 sv = *(const float2*)((const float*)(p.ws + OFF_STATS) + (size_t)(tok0 + t) * 2);
            const float mean = sv.x * (1.f / 1024.f);
            const float var = fmaxf(sv.y * (1.f / 1024.f) - mean * mean, 0.f);
            mu[t] = mean;
            rs[t] = rsqrtf(var + LN_EPS);
        }
        const float* wsrc = p.w_s + ((size_t)(l * 8 + h) * 128 + t) * 128 + half * 64;
#pragma unroll
        for (int i = 0; i < 8; ++i) {
            const float4 w0 = *(const float4*)(wsrc + i * 8);
            const float4 w1 = *(const float4*)(wsrc + i * 8 + 4);
            const int s0 = half * 64 + i * 8;
            const float e0 = s0 + 0 <= t ? w0.x : 0.f, e1 = s0 + 1 <= t ? w0.y : 0.f, e2 = s0 + 2 <= t ? w0.z : 0.f, e3 = s0 + 3 <= t ? w0.w : 0.f;
            const float e4 = s0 + 4 <= t ? w1.x : 0.f, e5 = s0 + 5 <= t ? w1.y : 0.f, e6 = s0 + 6 <= t ? w1.z : 0.f, e7 = s0 + 7 <= t ? w1.w : 0.f;
            *(uint4*)(Wt + t * 136 + s0) = make_uint4(pack2(e0, e1), pack2(e2, e3), pack2(e4, e5), pack2(e6, e7));
        }
    }
    __syncthreads();
    {
        const int c = tid & 127, sg = tid >> 7;
        const float gam = p.lnv_g[l * 1024 + h * 128 + c], bet = p.lnv_b[l * 1024 + h * 128 + c];
        const bf16_t* src = P + (size_t)tok0 * PC + C_VA + h * 128 + c;
        float* cv = p.out + O_CV_P + ((size_t)(l * NB + b) * 128) * 1024 + h * 128 + c;
#pragma unroll
        for (int oct = 0; oct < 8; ++oct) {
            const int s0 = sg * 64 + oct * 8;
            float e[8];
#pragma unroll
            for (int j = 0; j < 8; ++j) {
                const float x = bf2f(src[(size_t)(s0 + j) * PC]);
                e[j] = (x - mu[s0 + j]) * rs[s0 + j] * gam + bet;
            }
            if (n == 15) {
#pragma unroll
                for (int j = 0; j < 8; ++j) cv[(size_t)(s0 + j) * 1024] = e[j];
            }
            *(uint4*)(VnT + c * 136 + s0) = make_uint4(pack2(e[0], e[1]), pack2(e[2], e[3]), pack2(e[4], e[5]), pack2(e[6], e[7]));
        }
    }
    __syncthreads();
    f32x4 acc[4][4];
#pragma unroll
    for (int m = 0; m < 4; ++m)
#pragma unroll
        for (int nn = 0; nn < 4; ++nn) acc[m][nn] = (f32x4){0.f, 0.f, 0.f, 0.f};
#pragma unroll
    for (int ks = 0; ks < 4; ++ks) {
        bf16x8 af[4], bfr[4];
#pragma unroll
        for (int m = 0; m < 4; ++m) af[m] = *(const bf16x8*)(Wt + (wr * 64 + m * 16 + fr) * 136 + ks * 32 + fq * 8);
#pragma unroll
        for (int nn = 0; nn < 4; ++nn) bfr[nn] = *(const bf16x8*)(VnT + (wc * 64 + nn * 16 + fr) * 136 + ks * 32 + fq * 8);
#pragma unroll
        for (int m = 0; m < 4; ++m)
#pragma unroll
            for (int nn = 0; nn < 4; ++nn) acc[m][nn] = mfma16(bfr[nn], af[m], acc[m][nn]);
    }
#pragma unroll
    for (int m = 0; m < 4; ++m) {
        const int t = wr * 64 + m * 16 + fr;
        const float bs = p.b_s[(l * 8 + h) * 128 + t];
        const bf16_t* prow = P + (size_t)(tok0 + t) * PC + h * 128;
#pragma unroll
        for (int nn = 0; nn < 4; ++nn) {
            const int c = wc * 64 + nn * 16 + fq * 4;
            const uint2 u = *(const uint2*)(prow + C_UA + c);
            const uint2 z = *(const uint2*)(prow + C_ZA + c);
            const float y0 = lo_bf(u.x) * (acc[m][nn][0] + bs) * lo_bf(z.x);
            const float y1 = hi_bf(u.x) * (acc[m][nn][1] + bs) * hi_bf(z.x);
            const float y2 = lo_bf(u.y) * (acc[m][nn][2] + bs) * lo_bf(z.y);
            const float y3 = hi_bf(u.y) * (acc[m][nn][3] + bs) * hi_bf(z.y);
            *(uint2*)(YA + (size_t)(tok0 + t) * 1024 + h * 128 + c) = make_uint2(pack2(y0, y1), pack2(y2, y3));
        }
    }
}

__device__ __forceinline__ void gmlp_sample_item(const Params& p, int l, int b, char* smem) {
    smem += opaque_zero();
    const int tid = opaque_tid(), lane = tid & 63, wid = tid >> 6;
    const int tok0 = TP + b * DSQ;
    const bf16_t* P = (const bf16_t*)(p.ws + OFF_P);
    bf16_t* YA = (bf16_t*)(p.ws + OFF_YA);
    float* red = (float*)smem;
    __syncthreads();
    const int c4 = tid * 4;
    float x[4][4];
    float s[4], ss[4];
#pragma unroll
    for (int t = 0; t < 4; ++t) {
        const uint2 u = *(const uint2*)(P + (size_t)(tok0 + t) * PC + C_VA + c4);
        x[t][0] = lo_bf(u.x); x[t][1] = hi_bf(u.x); x[t][2] = lo_bf(u.y); x[t][3] = hi_bf(u.y);
        s[t] = wave_sum(x[t][0] + x[t][1] + x[t][2] + x[t][3]);
        ss[t] = wave_sum(x[t][0] * x[t][0] + x[t][1] * x[t][1] + x[t][2] * x[t][2] + x[t][3] * x[t][3]);
    }
    if (lane == 0) {
#pragma unroll
        for (int t = 0; t < 4; ++t) { red[wid * 8 + t] = s[t]; red[wid * 8 + 4 + t] = ss[t]; }
    }
    __syncthreads();
    const float4 gam = *(const float4*)(p.lnv_g + l * 1024 + c4);
    const float4 bet = *(const float4*)(p.lnv_b + l * 1024 + c4);
    float vn[4][4];
#pragma unroll
    for (int t = 0; t < 4; ++t) {
        const float st = red[t] + red[8 + t] + red[16 + t] + red[24 + t];
        const float sst = red[4 + t] + red[12 + t] + red[20 + t] + red[28 + t];
        const float mean = st * (1.f / 1024.f);
        const float rstd = rsqrtf(fmaxf(sst * (1.f / 1024.f) - mean * mean, 0.f) + LN_EPS);
        vn[t][0] = (x[t][0] - mean) * rstd * gam.x + bet.x;
        vn[t][1] = (x[t][1] - mean) * rstd * gam.y + bet.y;
        vn[t][2] = (x[t][2] - mean) * rstd * gam.z + bet.z;
        vn[t][3] = (x[t][3] - mean) * rstd * gam.w + bet.w;
        *(float4*)(p.out + O_CV_S + ((size_t)(l * DBT + b) * DSQ + t) * 1024 + c4) = make_float4(vn[t][0], vn[t][1], vn[t][2], vn[t][3]);
    }
    const int h = c4 >> 7;
#pragma unroll
    for (int t = 0; t < 4; ++t) {
        const float bs = p.b_s[(l * 8 + h) * 128 + t];
        float a[4] = {bs, bs, bs, bs};
#pragma unroll
        for (int sidx = 0; sidx <= t; ++sidx) {
            const float w = p.w_s[((size_t)(l * 8 + h) * 128 + t) * 128 + sidx];
#pragma unroll
            for (int e = 0; e < 4; ++e) a[e] += w * vn[sidx][e];
        }
        const uint2 u = *(const uint2*)(P + (size_t)(tok0 + t) * PC + C_UA + c4);
        const uint2 z = *(const uint2*)(P + (size_t)(tok0 + t) * PC + C_ZA + c4);
        const float y0 = lo_bf(u.x) * a[0] * lo_bf(z.x), y1 = hi_bf(u.x) * a[1] * hi_bf(z.x);
        const float y2 = lo_bf(u.y) * a[2] * lo_bf(z.y), y3 = hi_bf(u.y) * a[3] * hi_bf(z.y);
        *(uint2*)(YA + (size_t)(tok0 + t) * 1024 + c4) = make_uint2(pack2(y0, y1), pack2(y2, y3));
    }
}

__device__ __forceinline__ void conv_state_item(const Params& p, int l, int it) {
    const bf16_t* P = (const bf16_t*)(p.ws + OFF_P);
    const bool pr = it < NB;
    const int b = pr ? it : it - NB;
    const int tokb = pr ? b * SEQ + SEQ - 3 : TP + b * DSQ + 1;
    float* dst = pr ? p.out + O_CONV_P + (size_t)(l * NB + b) * 3 * 3072 : p.out + O_CONV_S + (size_t)(l * DBT + b) * 3 * 3072;
    for (int idx = opaque_tid(); idx < 3 * 768; idx += 256) {
        const int j = idx / 768, c = (idx % 768) * 4;
        const uint2 u = *(const uint2*)(P + (size_t)(tokb + j) * PC + C_Q + c);
        *(float4*)(dst + j * 3072 + c) = make_float4(lo_bf(u.x), hi_bf(u.x), lo_bf(u.y), hi_bf(u.y));
    }
}

__device__ __forceinline__ void gdn_sample_item(const Params& p, int l, int it, char* smem) {
    smem += opaque_zero();
    const int tid = opaque_tid(), lane = tid & 63, wid = tid >> 6;
    const int b = it >> 3, h = it & 7;
    const int tok0 = TP + b * DSQ;
    const bf16_t* P = (const bf16_t*)(p.ws + OFF_P);
    const float* BETA = (const float*)(p.ws + OFF_BETA);
    const float* GLOG = (const float*)(p.ws + OFF_GLOG);
    bf16_t* YB = (bf16_t*)(p.ws + OFF_YB);
    float* qs = (float*)smem;
    float* ks = qs + 512;
    float* vs = ks + 512;
    float* red = vs + 512;
    float* part = red + 16;
    float* opart = part + 1024;
    float* red2 = opart + 1024;
    __syncthreads();
    const int j = tid & 127;
    const bool isk = tid >= 128;
    float y1[4], y2[4];
    {
        const int cq = (isk ? 1024 : 0) + h * 128 + j;
        const float* sc = p.state_conv + (size_t)(l * DBT + b) * 3 * 3072;
        const float* cw = p.conv_w + (size_t)l * 4 * 3072;
        float xr[7];
#pragma unroll
        for (int r = 0; r < 3; ++r) xr[r] = sc[r * 3072 + cq];
#pragma unroll
        for (int t = 0; t < 4; ++t) xr[3 + t] = bf2f(P[(size_t)(tok0 + t) * PC + C_Q + cq]);
        const float w0 = cw[cq], w1 = cw[3072 + cq], w2 = cw[2 * 3072 + cq], w3 = cw[3 * 3072 + cq];
#pragma unroll
        for (int t = 0; t < 4; ++t) y1[t] = silu_f(w0 * xr[t] + w1 * xr[t + 1] + w2 * xr[t + 2] + w3 * xr[t + 3]);
        if (!isk) {
            const int cv = 2048 + h * 128 + j;
#pragma unroll
            for (int r = 0; r < 3; ++r) xr[r] = sc[r * 3072 + cv];
#pragma unroll
            for (int t = 0; t < 4; ++t) xr[3 + t] = bf2f(P[(size_t)(tok0 + t) * PC + C_Q + cv]);
            const float v0 = cw[cv], v1 = cw[3072 + cv], v2 = cw[2 * 3072 + cv], v3 = cw[3 * 3072 + cv];
#pragma unroll
            for (int t = 0; t < 4; ++t) y2[t] = silu_f(v0 * xr[t] + v1 * xr[t + 1] + v2 * xr[t + 2] + v3 * xr[t + 3]);
        }
    }
#pragma unroll
    for (int t = 0; t < 4; ++t) {
        const float s = wave_sum(y1[t] * y1[t]);
        if (lane == 0) red[wid * 4 + t] = s;
    }
    __syncthreads();
#pragma unroll
    for (int t = 0; t < 4; ++t) {
        const float tot = isk ? red[8 + t] + red[12 + t] : red[t] + red[4 + t];
        const float rn = rsqrtf(tot + NORM_EPS);
        if (isk) ks[t * 128 + j] = y1[t] * rn;
        else { qs[t * 128 + j] = y1[t] * rn * 0.08838834764831845f; vs[t * 128 + j] = y2[t]; }
    }
    __syncthreads();
    const int vcol = j, kh = tid >> 7;
    float S[64];
    const float* s0 = p.state_ssm + ((size_t)(l * DBT + b) * 8 + h) * 16384 + (size_t)(kh * 64) * 128 + vcol;
#pragma unroll
    for (int kk = 0; kk < 64; ++kk) S[kk] = s0[kk * 128];
#pragma unroll
    for (int t = 0; t < 4; ++t) {
        const float a = __expf(GLOG[(size_t)(tok0 + t) * 8 + h]);
        const float bt = BETA[(size_t)(tok0 + t) * 8 + h];
        float r0 = 0.f, r1 = 0.f;
#pragma unroll
        for (int kk = 0; kk < 64; kk += 4) {
            const float4 kv = *(const float4*)&ks[t * 128 + kh * 64 + kk];
            r0 += S[kk] * kv.x + S[kk + 2] * kv.z;
            r1 += S[kk + 1] * kv.y + S[kk + 3] * kv.w;
        }
        part[(t * 2 + kh) * 128 + vcol] = r0 + r1;
        __syncthreads();
        const float dlt = bt * (vs[t * 128 + vcol] - a * (part[(t * 2) * 128 + vcol] + part[(t * 2 + 1) * 128 + vcol]));
        float o0 = 0.f, o1 = 0.f;
#pragma unroll
        for (int kk = 0; kk < 64; kk += 4) {
            const float4 kv = *(const float4*)&ks[t * 128 + kh * 64 + kk];
            const float4 qv = *(const float4*)&qs[t * 128 + kh * 64 + kk];
            S[kk] = a * S[kk] + kv.x * dlt;
            S[kk + 1] = a * S[kk + 1] + kv.y * dlt;
            S[kk + 2] = a * S[kk + 2] + kv.z * dlt;
            S[kk + 3] = a * S[kk + 3] + kv.w * dlt;
            o0 += S[kk] * qv.x + S[kk + 2] * qv.z;
            o1 += S[kk + 1] * qv.y + S[kk + 3] * qv.w;
        }
        opart[(t * 2 + kh) * 128 + vcol] = o0 + o1;
    }
    float* sout = p.out + O_SSM_S + ((size_t)(l * DBT + b) * 8 + h) * 16384 + (size_t)(kh * 64) * 128 + vcol;
#pragma unroll
    for (int kk = 0; kk < 64; ++kk) sout[kk * 128] = S[kk];
    __syncthreads();
    float o[4];
    if (tid < 128) {
#pragma unroll
        for (int t = 0; t < 4; ++t) {
            o[t] = opart[(t * 2) * 128 + vcol] + opart[(t * 2 + 1) * 128 + vcol];
            const float s = wave_sum(o[t] * o[t]);
            if (lane == 0) red2[wid * 4 + t] = s;
        }
    }
    __syncthreads();
    if (tid < 128) {
        const float gn = p.onorm_g[l * 128 + vcol];
#pragma unroll
        for (int t = 0; t < 4; ++t) {
            const float rinv = rsqrtf((red2[t] + red2[4 + t]) * (1.f / 128.f) + NORM_EPS);
            const float zs = bf2f(P[(size_t)(tok0 + t) * PC + C_ZB + h * 128 + vcol]);
            YB[(size_t)(tok0 + t) * 1024 + h * 128 + vcol] = f2bf(o[t] * rinv * gn * zs);
        }
    }
}

__device__ __forceinline__ void gdn_prep_item(const Params& p, int l, int it, char* smem) {
    smem += opaque_zero();
    const int tid = opaque_tid(), lane = tid & 63, wid = tid >> 6, fr = lane & 15, fq = lane >> 4;
    const int n = it & 31, h = (it >> 5) & 7, b = it >> 8;
    const int tok0 = b * SEQ + n * 64;
    const bf16_t* P = (const bf16_t*)(p.ws + OFF_P);
    const float* BETA = (const float*)(p.ws + OFF_BETA);
    const float* GLOG = (const float*)(p.ws + OFF_GLOG);
    float* Ug = (float*)(p.ws + OFF_U) + (size_t)it * 8192;
    bf16_t* Wg = (bf16_t*)(p.ws + OFF_WG) + (size_t)it * 8192;
    bf16_t* QGg = (bf16_t*)(p.ws + OFF_QG) + (size_t)it * 8192;
    bf16_t* KDTg = (bf16_t*)(p.ws + OFF_KDT) + (size_t)it * 8192;
    bf16_t* QKg = (bf16_t*)(p.ws + OFF_QK) + (size_t)it * 4096;
    float* EGg = (float*)(p.ws + OFF_EG);
    bf16_t* Qs = (bf16_t*)smem;
    bf16_t* Ks = Qs + 64 * 136;
    bf16_t* Kbs = Ks + 64 * 136;
    float* Am = (float*)(smem + 3 * 17408);
    float* gcs = Am + 64 * 68;
    float* betas = gcs + 64;
    float* red = betas + 64;
    __syncthreads();
    if (tid < 64) {
        float g = GLOG[(size_t)(tok0 + tid) * 8 + h];
#pragma unroll
        for (int o = 1; o < 64; o <<= 1) {
            const float t = __shfl_up(g, o);
            if (lane >= o) g += t;
        }
        gcs[tid] = g;
        betas[tid] = BETA[(size_t)(tok0 + tid) * 8 + h];
    }
    const int j = tid & 127;
    const bool isk = tid >= 128;
    float val[64];
    char* R1 = smem + 2 * 17408;
    char* R2 = smem + 3 * 17408;
    {
        const bf16_t* pb = P + ((ptrdiff_t)tok0 - 3) * PC + C_Q + h * 128;
#pragma unroll
        for (int it9 = 0; it9 < 9; ++it9) {
            const int c = tid + 256 * it9;
            if (c < 67 * 32) {
                const int r = c >> 5, sg = c & 31;
                u32x4 v = (u32x4){0u, 0u, 0u, 0u};
                if (n > 0 || r >= 3) v = *(const u32x4*)(pb + (ptrdiff_t)r * PC + (sg >> 4) * 1024 + (sg & 15) * 8);
                *(u32x4*)(R1 + r * 512 + sg * 16) = v;
            }
        }
    }
    __syncthreads();
    {
        const int cq = (isk ? 1024 : 0) + h * 128 + j;
        const float* cw = p.conv_w + (size_t)l * 4 * 3072;
        const float w0 = cw[cq], w1 = cw[3072 + cq], w2 = cw[2 * 3072 + cq], w3 = cw[3 * 3072 + cq];
        const bf16_t* col = (const bf16_t*)(R1 + (isk ? 256 : 0)) + j;
        float x3 = bf2f(col[0]), x2 = bf2f(col[256]), x1 = bf2f(col[512]);
#pragma unroll
        for (int i = 0; i < 64; ++i) {
            const float x0 = bf2f(col[(i + 3) * 256]);
            val[i] = silu_f(w0 * x3 + w1 * x2 + w2 * x1 + w3 * x0);
            x3 = x2; x2 = x1; x1 = x0;
            if ((i & 15) == 15) __builtin_amdgcn_sched_barrier(0);
        }
    }
#pragma unroll
    for (int i = 0; i < 64; ++i) {
        const float s = wave_sum(val[i] * val[i]);
        if (lane == 0) red[wid * 64 + i] = s;
        if ((i & 7) == 7) __builtin_amdgcn_sched_barrier(0);
    }
    __syncthreads();
    const float glast = gcs[63];
    {
        const bf16_t* pb = P + ((ptrdiff_t)tok0 - 3) * PC + C_Q + 2048 + h * 128;
#pragma unroll
        for (int it5 = 0; it5 < 5; ++it5) {
            const int c = tid + 256 * it5;
            if (c < 67 * 16) {
                const int r = c >> 4, sg = c & 15;
                u32x4 v = (u32x4){0u, 0u, 0u, 0u};
                if (n > 0 || r >= 3) v = *(const u32x4*)(pb + (ptrdiff_t)r * PC + sg * 8);
                *(u32x4*)(R2 + r * 256 + sg * 16) = v;
            }
        }
    }
    if (!isk) {
#pragma unroll
        for (int i = 0; i < 64; ++i) {
            const float rn = rsqrtf(red[i] + red[64 + i] + NORM_EPS);
            const float qv = val[i] * rn * 0.08838834764831845f;
            Qs[i * 136 + j] = f2bf(qv);
            QGg[i * 128 + perm32(j)] = f2bf(qv * __expf(gcs[i]));
            if ((i & 7) == 7) __builtin_amdgcn_sched_barrier(0);
        }
    } else {
        unsigned pk[32];
#pragma unroll
        for (int i = 0; i < 64; ++i) {
            const float rn = rsqrtf(red[128 + i] + red[192 + i] + NORM_EPS);
            const float kv = val[i] * rn;
            const float gi = gcs[i], bi = betas[i];
            Ks[i * 136 + j] = f2bf(kv);
            Kbs[i * 136 + j] = f2bf(kv * bi);
            const bf16_t kd = f2bf(kv * __expf(glast - gi));
            if (i & 1) pk[perm32(i) >> 1] |= ((unsigned)kd) << 16; else pk[perm32(i) >> 1] = kd;
            val[i] = kv * bi * __expf(gi);
            if ((i & 7) == 7) __builtin_amdgcn_sched_barrier(0);
        }
#pragma unroll
        for (int i = 0; i < 8; ++i) *(uint4*)(KDTg + j * 64 + i * 8) = make_uint4(pk[i * 4], pk[i * 4 + 1], pk[i * 4 + 2], pk[i * 4 + 3]);
    }
    __syncthreads();
    if (!isk) {
        const int cv = 2048 + h * 128 + j;
        const float* cw = p.conv_w + (size_t)l * 4 * 3072;
        const float w0 = cw[cv], w1 = cw[3072 + cv], w2 = cw[2 * 3072 + cv], w3 = cw[3 * 3072 + cv];
        const bf16_t* col = (const bf16_t*)R2 + j;
        float x3 = bf2f(col[0]), x2 = bf2f(col[128]), x1 = bf2f(col[256]);
#pragma unroll
        for (int i = 0; i < 64; ++i) {
            const float x0 = bf2f(col[(i + 3) * 128]);
            val[i] = silu_f(w0 * x3 + w1 * x2 + w2 * x1 + w3 * x0) * betas[i];
            x3 = x2; x2 = x1; x1 = x0;
            if ((i & 15) == 15) __builtin_amdgcn_sched_barrier(0);
        }
    }
    __syncthreads();
    {
        f32x4 aA[4], aQ[4];
#pragma unroll
        for (int nt = 0; nt < 4; ++nt) { aA[nt] = (f32x4){0.f, 0.f, 0.f, 0.f}; aQ[nt] = (f32x4){0.f, 0.f, 0.f, 0.f}; }
#pragma unroll
        for (int ksi = 0; ksi < 4; ++ksi) {
            const bf16x8 fa = *(const bf16x8*)(Kbs + (wid * 16 + fr) * 136 + ksi * 32 + fq * 8);
            const bf16x8 fqv = *(const bf16x8*)(Qs + (wid * 16 + fr) * 136 + ksi * 32 + fq * 8);
#pragma unroll
            for (int nt = 0; nt < 4; ++nt) {
                const bf16x8 fb = *(const bf16x8*)(Ks + (nt * 16 + fr) * 136 + ksi * 32 + fq * 8);
                aA[nt] = mfma16(fa, fb, aA[nt]);
                aQ[nt] = mfma16(fqv, fb, aQ[nt]);
            }
        }
#pragma unroll
        for (int nt = 0; nt < 4; ++nt) {
            const int jc = nt * 16 + fr;
            const float gj = gcs[jc];
#pragma unroll
            for (int r = 0; r < 4; ++r) {
                const int i = wid * 16 + fq * 4 + r;
                const float dec = jc <= i ? __expf(gcs[i] - gj) : 0.f;
                Am[i * 68 + jc] = jc < i ? aA[nt][r] * dec : 0.f;
                QKg[i * 64 + perm32(jc)] = f2bf(aQ[nt][r] * dec);
            }
        }
    }
    __syncthreads();
#pragma unroll
    for (int i = 1; i < 64; ++i) {
        float s0 = 0.f, s1 = 0.f, s2 = 0.f, s3 = 0.f;
#pragma unroll
        for (int j4 = 0; j4 < (i + 3) / 4; ++j4) {
            const float4 a = *(const float4*)&Am[i * 68 + j4 * 4];
            s0 += a.x * val[j4 * 4];
            s1 += a.y * val[j4 * 4 + 1];
            s2 += a.z * val[j4 * 4 + 2];
            s3 += a.w * val[j4 * 4 + 3];
        }
        val[i] -= (s0 + s1) + (s2 + s3);
        if ((i & 3) == 3) __builtin_amdgcn_sched_barrier(0);
    }
    if (!isk) {
#pragma unroll
        for (int i = 0; i < 64; i += 4)
            *(float4*)(Ug + (((i >> 4) * 8 + (j >> 4)) * 64 + ((i >> 2) & 3) * 16 + (j & 15)) * 4) = make_float4(val[i], val[i + 1], val[i + 2], val[i + 3]);
    } else {
        const int pj = perm32(j);
#pragma unroll
        for (int i = 0; i < 64; ++i) Wg[i * 128 + pj] = f2bf(val[i]);
    }
    if (tid == 0) EGg[it] = __expf(glast);
}

__device__ __forceinline__ void gdn_scan_item(const Params& p, int l, int bh, char* smem) {
    smem += opaque_zero();
    const int tid0 = opaque_tid();
    const int b = bh >> 3, h = bh & 7;
    constexpr int WBY = 64 * 272, BUFB = WBY + 128 * 128;
    const float* EGg = (const float*)(p.ws + OFF_EG);
    f32x4 S[8][2];
#pragma unroll
    for (int mt = 0; mt < 8; ++mt) { S[mt][0] = (f32x4){0.f, 0.f, 0.f, 0.f}; S[mt][1] = (f32x4){0.f, 0.f, 0.f, 0.f}; }
    u32x4 stg[8];
    f32x4 ucur[4][2];
    {
        const size_t item = (size_t)bh * 32;
        const bf16_t* Wp = (const bf16_t*)(p.ws + OFF_WG) + item * 8192;
        const bf16_t* KDTp = (const bf16_t*)(p.ws + OFF_KDT) + item * 8192;
        const float* Up = (const float*)(p.ws + OFF_U) + item * 8192;
        const int lane = tid0 & 63, w = tid0 >> 6, fr = lane & 15, fq = lane >> 4;
#pragma unroll
        for (int i = 0; i < 4; ++i) {
            stg[i] = ldg_b<u32x4>(Wp, 16u * (unsigned)(tid0 + 256 * i));
            stg[4 + i] = ldg_b<u32x4>(KDTp, 16u * (unsigned)(tid0 + 256 * i));
        }
#pragma unroll
        for (int mt = 0; mt < 4; ++mt)
#pragma unroll
            for (int nt = 0; nt < 2; ++nt) ucur[mt][nt] = ldg_b<f32x4>(Up, 16u * (unsigned)((mt * 8 + w * 2 + nt) * 64 + lane));
        __syncthreads();
#pragma unroll
        for (int i = 0; i < 4; ++i) {
            const int c = tid0 + 256 * i;
            *(u32x4*)(smem + (c >> 4) * 272 + (c & 15) * 16) = stg[i];
            *(u32x4*)(smem + WBY + (c >> 3) * 128 + ((((c & 7) ^ ((c >> 3) & 7))) << 4)) = stg[4 + i];
        }
        __syncthreads();
    }
    for (int n = 0; n < 32; ++n) {
        int tid = tid0;
        asm volatile("" : "+v"(tid));
        const int lane = tid & 63, w = tid >> 6, fr = lane & 15, fq = lane >> 4;
        const char* cur = smem + (n & 1) * BUFB;
        const size_t item = (size_t)bh * 32 + n;
        const float eg = EGg[item];
        bf16_t* SBp = (bf16_t*)(p.ws + OFF_SB) + item * 16384;
        bf16_t* VNp = (bf16_t*)(p.ws + OFF_VN) + item * 8192;
        if (n + 1 < 32) {
            const bf16_t* Wp = (const bf16_t*)(p.ws + OFF_WG) + (item + 1) * 8192;
            const bf16_t* KDTp = (const bf16_t*)(p.ws + OFF_KDT) + (item + 1) * 8192;
#pragma unroll
            for (int i = 0; i < 4; ++i) {
                stg[i] = ldg_b<u32x4>(Wp, 16u * (unsigned)(tid + 256 * i));
                stg[4 + i] = ldg_b<u32x4>(KDTp, 16u * (unsigned)(tid + 256 * i));
            }
        }
        bf16x8 sf[4][2];
#pragma unroll
        for (int pp = 0; pp < 4; ++pp)
#pragma unroll
            for (int nt = 0; nt < 2; ++nt) {
                u32x4 t;
                t[0] = pack2(S[2 * pp][nt][0], S[2 * pp][nt][1]);
                t[1] = pack2(S[2 * pp][nt][2], S[2 * pp][nt][3]);
                t[2] = pack2(S[2 * pp + 1][nt][0], S[2 * pp + 1][nt][1]);
                t[3] = pack2(S[2 * pp + 1][nt][2], S[2 * pp + 1][nt][3]);
                stg_b<u32x4>(SBp, 16u * (unsigned)((pp * 8 + w * 2 + nt) * 64 + lane), t);
                sf[pp][nt] = (bf16x8)t;
            }
        bf16x8 vf[2][2];
#pragma unroll
        for (int q = 0; q < 2; ++q) {
            u32x4 t0, t1;
#pragma unroll
            for (int hh = 0; hh < 2; ++hh) {
                const int mt = 2 * q + hh;
                f32x4 a0 = (f32x4){0.f, 0.f, 0.f, 0.f}, a1 = a0;
#pragma unroll
                for (int pp = 0; pp < 4; ++pp) {
                    const bf16x8 wf = *(const bf16x8*)(cur + (mt * 16 + fr) * 272 + pp * 64 + fq * 16);
                    a0 = mfma16(wf, sf[pp][0], a0);
                    a1 = mfma16(wf, sf[pp][1], a1);
                }
                const f32x4 v0 = ucur[mt][0] - a0, v1 = ucur[mt][1] - a1;
                t0[2 * hh] = pack2(v0[0], v0[1]); t0[2 * hh + 1] = pack2(v0[2], v0[3]);
                t1[2 * hh] = pack2(v1[0], v1[1]); t1[2 * hh + 1] = pack2(v1[2], v1[3]);
            }
            stg_b<u32x4>(VNp, 16u * (unsigned)((q * 8 + w * 2) * 64 + lane), t0);
            stg_b<u32x4>(VNp, 16u * (unsigned)((q * 8 + w * 2 + 1) * 64 + lane), t1);
            vf[q][0] = (bf16x8)t0;
            vf[q][1] = (bf16x8)t1;
        }
        if (n + 1 < 32) {
            const float* Up = (const float*)(p.ws + OFF_U) + (item + 1) * 8192;
#pragma unroll
            for (int mt = 0; mt < 4; ++mt)
#pragma unroll
                for (int nt = 0; nt < 2; ++nt) ucur[mt][nt] = ldg_b<f32x4>(Up, 16u * (unsigned)((mt * 8 + w * 2 + nt) * 64 + lane));
        }
#pragma unroll
        for (int mt = 0; mt < 8; ++mt) {
            S[mt][0] *= eg;
            S[mt][1] *= eg;
#pragma unroll
            for (int q = 0; q < 2; ++q) {
                const bf16x8 kf = *(const bf16x8*)(cur + WBY + (mt * 16 + fr) * 128 + (((q * 4 + fq) ^ (fr & 7)) << 4));
                S[mt][0] = mfma16(kf, vf[q][0], S[mt][0]);
                S[mt][1] = mfma16(kf, vf[q][1], S[mt][1]);
            }
        }
        if (n + 1 < 32) {
            char* nxt = smem + ((n + 1) & 1) * BUFB;
#pragma unroll
            for (int i = 0; i < 4; ++i) {
                const int c = tid + 256 * i;
                *(u32x4*)(nxt + (c >> 4) * 272 + (c & 15) * 16) = stg[i];
                *(u32x4*)(nxt + WBY + (c >> 3) * 128 + ((((c & 7) ^ ((c >> 3) & 7))) << 4)) = stg[4 + i];
            }
        }
        __syncthreads();
    }
    const int lane = tid0 & 63, w = tid0 >> 6, fr = lane & 15, fq = lane >> 4;
    float* so = p.out + O_SSM_P + ((size_t)(l * NB + b) * 8 + h) * 16384;
#pragma unroll
    for (int mt = 0; mt < 8; ++mt)
#pragma unroll
        for (int nt = 0; nt < 2; ++nt)
#pragma unroll
            for (int r = 0; r < 4; ++r) so[(mt * 16 + fq * 4 + r) * 128 + w * 32 + nt * 16 + fr] = S[mt][nt][r];
}

__device__ __forceinline__ void gdn_out_item(const Params& p, int l, int it) {
    const int tid = opaque_tid(), lane = tid & 63, w = tid >> 6, fr = lane & 15, fq = lane >> 4;
    const int n = it & 31, h = (it >> 5) & 7, b = it >> 8;
    const bf16_t* QGp = (const bf16_t*)(p.ws + OFF_QG) + (size_t)it * 8192;
    const bf16_t* QKp = (const bf16_t*)(p.ws + OFF_QK) + (size_t)it * 4096;
    const bf16_t* SBp = (const bf16_t*)(p.ws + OFF_SB) + (size_t)it * 16384;
    const bf16_t* VNp = (const bf16_t*)(p.ws + OFF_VN) + (size_t)it * 8192;
    const bf16_t* P = (const bf16_t*)(p.ws + OFF_P);
    bf16_t* YB = (bf16_t*)(p.ws + OFF_YB);
    bf16x8 qg[4], qk[2];
#pragma unroll
    for (int pp = 0; pp < 4; ++pp) qg[pp] = ldg_b<bf16x8>(QGp, 2u * (unsigned)((w * 16 + fr) * 128 + pp * 32 + fq * 8));
#pragma unroll
    for (int q = 0; q < 2; ++q) qk[q] = ldg_b<bf16x8>(QKp, 2u * (unsigned)((w * 16 + fr) * 64 + q * 32 + fq * 8));
    f32x4 acc[8];
    float ss = 0.f;
#pragma unroll
    for (int nt = 0; nt < 8; ++nt) {
        f32x4 a = (f32x4){0.f, 0.f, 0.f, 0.f};
#pragma unroll
        for (int pp = 0; pp < 4; ++pp) a = mfma16(ldg_b<bf16x8>(SBp, 16u * (unsigned)((pp * 8 + nt) * 64 + lane)), qg[pp], a);
#pragma unroll
        for (int q = 0; q < 2; ++q) a = mfma16(ldg_b<bf16x8>(VNp, 16u * (unsigned)((q * 8 + nt) * 64 + lane)), qk[q], a);
        acc[nt] = a;
        ss += a[0] * a[0] + a[1] * a[1] + a[2] * a[2] + a[3] * a[3];
    }
    ss += __shfl_xor(ss, 16);
    ss += __shfl_xor(ss, 32);
    const float rinv = rsqrtf(ss * (1.f / 128.f) + NORM_EPS);
    const size_t tok = (size_t)b * SEQ + n * 64 + w * 16 + fr;
#pragma unroll
    for (int nt = 0; nt < 8; ++nt) {
        const int v0 = nt * 16 + fq * 4;
        const float4 g = *(const float4*)(p.onorm_g + l * 128 + v0);
        const uint2 z = *(const uint2*)(P + tok * PC + C_ZB + h * 128 + v0);
        const float y0 = acc[nt][0] * rinv * g.x * lo_bf(z.x), y1 = acc[nt][1] * rinv * g.y * hi_bf(z.x);
        const float y2 = acc[nt][2] * rinv * g.z * lo_bf(z.y), y3 = acc[nt][3] * rinv * g.w * hi_bf(z.y);
        *(uint2*)(YB + tok * 1024 + h * 128 + v0) = make_uint2(pack2(y0, y1), pack2(y2, y3));
    }
}

constexpr int N_GMLP_P = NB * 16 * 8;
constexpr int N_GDN_S = DBT * 8;
constexpr int N_GMLP_S = DBT;
constexpr int N_CONV = NB + DBT;
constexpr int N_OTHER = N_GMLP_P + N_GDN_S + N_GMLP_S + N_CONV;

__device__ __forceinline__ void other_item(const Params& p, int l, int it, char* smem) {
    if (it < N_GMLP_P) gmlp_prompt_item(p, l, it, smem);
    else if (it < N_GMLP_P + N_GDN_S) gdn_sample_item(p, l, it - N_GMLP_P, smem);
    else if (it < N_GMLP_P + N_GDN_S + N_GMLP_S) gmlp_sample_item(p, l, it - N_GMLP_P - N_GDN_S, smem);
    else conv_state_item(p, l, it - N_GMLP_P - N_GDN_S - N_GMLP_S);
}

__device__ __forceinline__ void phase_mixb(const Params& p, int l, char* smem) {
    const int G = gridDim.x;
    if (G >= 128) {
        if (blockIdx.x < 64) gdn_scan_item(p, l, blockIdx.x, smem);
        else for (int it = blockIdx.x - 64; it < N_OTHER; it += G - 64) other_item(p, l, it, smem);
    } else {
        for (int it = blockIdx.x; it < 64; it += G) gdn_scan_item(p, l, it, smem);
        for (int it = blockIdx.x; it < N_OTHER; it += G) other_item(p, l, it, smem);
    }
}

#define FRESH(q) const Params& q = p
#define XB_TMO      128
#define XB_XCNT(j)  (256  + 64 * (j))
#define XB_XSUB(j)  (1280 + 64 * (j))
#define XB_XGEN(j)  (2304 + 64 * (j))
#define XB_TOP      3328
#define XB_TOPGEN   3392
#define XCD_BAR_WORDS 3456
#define XB_SPIN_CAP (1u << 22)
#define LAS __attribute__((address_space(3)))
__device__ __forceinline__ unsigned xb_ld(unsigned* p) { return __hip_atomic_load(p, __ATOMIC_RELAXED, __HIP_MEMORY_SCOPE_AGENT); }
__device__ __forceinline__ unsigned xb_add(unsigned* p, unsigned v) { return __hip_atomic_fetch_add(p, v, __ATOMIC_RELAXED, __HIP_MEMORY_SCOPE_AGENT); }
__device__ __forceinline__ unsigned xb_xcc_id() { return (unsigned)__builtin_amdgcn_s_getreg((3 << 11) | 20) & 0xFu; }
#define XB_SPIN(cond, bar) do { unsigned _sp = 0; while (cond) { __builtin_amdgcn_s_sleep(1); \
    if ((++_sp & 255u) == 0u) { if (xb_ld(&(bar)[XB_TMO])) break; if (_sp > XB_SPIN_CAP) { atomicAdd(&(bar)[XB_TMO], 1u); break; } } } } while (0)
struct XcdBarrier { unsigned* bar; unsigned x; volatile LAS unsigned* st; };
__device__ __forceinline__ XcdBarrier xcd_barrier_post(unsigned* bar, volatile LAS unsigned* st) {
    XcdBarrier b; b.bar = bar; b.x = xb_xcc_id(); b.st = st;
    if (threadIdx.x == 0) (void)xb_add(&bar[XB_XCNT(b.x)], 1u);
    return b;
}
__device__ __forceinline__ void xcd_barrier_complete(unsigned* bar, unsigned x, unsigned& nloc, unsigned& nx) {
    const unsigned G = gridDim.x * gridDim.y * gridDim.z;
    unsigned sum, cnt, mine, sp = 0u;
    for (;;) {
        sum = 0u; cnt = 0u; mine = 0u;
#pragma unroll
        for (unsigned j = 0; j < 16; ++j) { const unsigned c = xb_ld(&bar[XB_XCNT(j)]); sum += c; cnt += (c > 0u) ? 1u : 0u; mine = (j == x) ? c : mine; }
        if (sum == G) break;
        __builtin_amdgcn_s_sleep(1);
        if ((++sp & 255u) == 0u) { if (xb_ld(&bar[XB_TMO])) break; if (sp > XB_SPIN_CAP) { atomicAdd(&bar[XB_TMO], 1u); break; } }
    }
    nloc = mine > 0u ? mine : 1u; nx = cnt > 0u ? cnt : 1u;
}
__device__ __forceinline__ void xcd_barrier(const XcdBarrier& b) {
    asm volatile("s_waitcnt vmcnt(0)" ::: "memory");
    __syncthreads();
    if (threadIdx.x == 0) {
        unsigned* bar = b.bar;
        __builtin_amdgcn_s_waitcnt(0);
        unsigned nloc = b.st[0], nx = b.st[1];
        if (nloc == 0u) { xcd_barrier_complete(bar, b.x, nloc, nx); b.st[0] = nloc; b.st[1] = nx; }
        const unsigned old = xb_add(&bar[XB_XSUB(b.x)], 1u);
        const unsigned gen = old / nloc;
        if (old + 1u == (gen + 1u) * nloc) {
            __builtin_amdgcn_fence(__ATOMIC_RELEASE, "agent");
            asm volatile("s_waitcnt vmcnt(0)" ::: "memory");
            const unsigned og = xb_add(&bar[XB_TOP], 1u);
            const unsigned tg = og / nx;
            if (og + 1u == (tg + 1u) * nx) xb_add(&bar[XB_TOPGEN], 1u);
            else XB_SPIN(xb_ld(&bar[XB_TOPGEN]) == tg, bar);
            __builtin_amdgcn_fence(__ATOMIC_ACQUIRE, "agent");
            xb_add(&bar[XB_XGEN(b.x)], 1u);
            asm volatile("s_waitcnt vmcnt(0)" ::: "memory");
        } else {
            XB_SPIN(xb_ld(&bar[XB_XGEN(b.x)]) == gen, bar);
            __builtin_amdgcn_fence(__ATOMIC_ACQUIRE, "agent");
            asm volatile("s_waitcnt vmcnt(0)" ::: "memory");
        }
    }
    __syncthreads();
}

__global__ void __launch_bounds__(256, 2) fwd_megakernel(Params p) {
    extern __shared__ __attribute__((aligned(16))) char smem[];
    __shared__ uint4 xb_words;
    cg::grid_group grid = cg::this_grid();
    unsigned* bar = (unsigned*)(p.ws + OFF_BAR);
    if (blockIdx.x == 0) for (int i = threadIdx.x; i < XCD_BAR_WORDS; i += 256) __hip_atomic_store(bar + i, 0u, __ATOMIC_RELAXED, __HIP_MEMORY_SCOPE_AGENT);
    if (threadIdx.x == 0) xb_words = make_uint4(0u, 0u, 0u, 0u);
    { FRESH(q); phase0(q, smem); }
    grid.sync();
    const XcdBarrier xb = xcd_barrier_post(bar, (volatile LAS unsigned*)&xb_words);
#define GBAR() xcd_barrier(xb)
    for (int l = 0; l < DEPTH; ++l) {
        { FRESH(q); phase_rows(q, l); }
        GBAR();
        { FRESH(q); phase_inproj256(q, l, smem); }
        GBAR();
        { FRESH(q); for (int it = blockIdx.x; it < NCHK; it += gridDim.x) gdn_prep_item(q, l, it, smem); }
        GBAR();
        { FRESH(q); phase_mixb(q, l, smem); }
        GBAR();
        { FRESH(q); for (int it = blockIdx.x; it < NCHK; it += gridDim.x) gdn_out_item(q, l, it); }
        GBAR();
        { FRESH(q); phase_merge(q, l, smem); }
        GBAR();
        { FRESH(q); phase_outproj(q, l, smem); }
        GBAR();
    }
    { FRESH(q); phase_rows(q, DEPTH); }
}

extern "C" void kernel_launch(void* const* d_in, const int* in_sizes, int n_in, void* d_out, int out_size, void* d_ws, size_t ws_size,
                              hipStream_t stream) {
    static int grid_blocks = 0;
    if (!grid_blocks) {
        int dev = 0, cus = 0, per_cu = 0;
        hipGetDevice(&dev);
        hipDeviceGetAttribute(&cus, hipDeviceAttributeMultiprocessorCount, dev);
        hipFuncSetAttribute((const void*)fwd_megakernel, hipFuncAttributeMaxDynamicSharedMemorySize, SMEM_BYTES);
        hipOccupancyMaxActiveBlocksPerMultiprocessor(&per_cu, fwd_megakernel, 256, SMEM_BYTES);
        if (per_cu > 2) per_cu = 2;
        if (per_cu < 1) per_cu = 1;
        grid_blocks = cus * per_cu;
    }
    if (ws_size < WS_NEED) {
        fprintf(stderr, "workspace too small: %zu < %zu\n", ws_size, (size_t)WS_NEED);
        return;
    }
    Params p{};
    const float** f = (const float**)&p;
    for (int i = 0; i < 22; ++i) f[i] = (const float*)d_in[i];
    p.out = (float*)d_out;
    p.ws = (char*)d_ws;
    void* args[] = {&p};
    hipError_t e = hipLaunchCooperativeKernel((const void*)fwd_megakernel, dim3(grid_blocks), dim3(256), args, SMEM_BYTES, stream);
    if (e != hipSuccess) fprintf(stderr, "cooperative launch failed: %s (grid %d)\n", hipGetErrorString(e), grid_blocks);
}
```

```cpp
#include <hip/hip_runtime.h>
#include <hip/hip_cooperative_groups.h>
#include <cstdio>
namespace cg = cooperative_groups;

typedef unsigned short bf16_t;
typedef short bf16x8 __attribute__((ext_vector_type(8)));
typedef float f32x4 __attribute__((ext_vector_type(4)));
typedef unsigned u32x4 __attribute__((ext_vector_type(4)));

constexpr int D = 1024;
constexpr int NB = 8, SEQ = 2048, DEPTH = 4, DBT = 128, DSQ = 4;
constexpr int TP = NB * SEQ;
constexpr int TS = DBT * DSQ;
constexpr int T = TP + TS;
constexpr int PIN = 9232;
constexpr int PC = 9216;
constexpr int NPAD = 9344;
constexpr int NROWB = NB + DBT;
constexpr float ALPHA_DN = 1.681792830507429f;
constexpr float LN_EPS = 1e-5f, NORM_EPS = 1e-6f;
constexpr int C_UA = 0, C_VA = 1024, C_ZA = 2048, C_Q = 3072, C_ZB = 6144, C_GA = 7168, C_GB = 8192;

constexpr size_t O_Y_P = 0, O_Y_S = 16777216, O_CONV_P = 17301504, O_SSM_P = 17596416, O_CV_P = 21790720,
                 O_CONV_S = 25985024, O_SSM_S = 30703616, O_CV_S = 97812480;

constexpr size_t SZ_WT_IN = (size_t)DEPTH * NPAD * 1024 * 2;
constexpr size_t SZ_WT_SQ = (size_t)DEPTH * 1024 * 1024 * 2;
constexpr size_t OFF_WT_IN = 0;
constexpr size_t OFF_WT_PA = OFF_WT_IN + SZ_WT_IN;
constexpr size_t OFF_WT_PB = OFF_WT_PA + SZ_WT_SQ;
constexpr size_t OFF_WT_O = OFF_WT_PB + SZ_WT_SQ;
constexpr size_t OFF_MOD = OFF_WT_O + SZ_WT_SQ;
constexpr size_t OFF_X = OFF_MOD + (size_t)DEPTH * NROWB * 3072 * 4;
constexpr size_t OFF_TT = OFF_X + (size_t)T * 1024 * 4;
constexpr size_t OFF_H = OFF_TT + (size_t)T * 1024 * 4;
constexpr size_t OFF_YA = OFF_H + (size_t)T * 1024 * 2;
constexpr size_t OFF_YB = OFF_YA + (size_t)T * 1024 * 2;
constexpr size_t OFF_MM = OFF_YB + (size_t)T * 1024 * 2;
constexpr size_t OFF_P = OFF_MM + (size_t)T * 1024 * 2;
constexpr size_t OFF_BETA = OFF_P + (size_t)T * PC * 2;
constexpr size_t OFF_GLOG = OFF_BETA + (size_t)T * 8 * 4;
constexpr int NCHK = 2048;
constexpr size_t OFF_U = OFF_GLOG + (size_t)T * 8 * 4;
constexpr size_t OFF_WG = OFF_U + (size_t)NCHK * 8192 * 4;
constexpr size_t OFF_QG = OFF_WG + (size_t)NCHK * 8192 * 2;
constexpr size_t OFF_KDT = OFF_QG + (size_t)NCHK * 8192 * 2;
constexpr size_t OFF_QK = OFF_KDT + (size_t)NCHK * 8192 * 2;
constexpr size_t OFF_EG = OFF_QK + (size_t)NCHK * 4096 * 2;
constexpr size_t OFF_SB = OFF_EG + (size_t)NCHK * 4;
constexpr size_t OFF_VN = OFF_SB + (size_t)NCHK * 16384 * 2;
constexpr size_t OFF_PARK = OFF_VN + (size_t)NCHK * 8192 * 2;
constexpr size_t OFF_STATS = OFF_PARK + (size_t)1024 * 32768;
constexpr size_t OFF_BAR = OFF_STATS + (size_t)T * 2 * 4;
constexpr size_t WS_NEED = OFF_BAR + 16384;

constexpr int SMEM_BYTES = 73728;
constexpr int TILE_BYTES = 128 * 128;

struct Params {
    const float *x_prompt, *x_sample, *state_conv, *state_ssm, *c_prompt, *c_sample, *w_ada, *b_ada, *w_in, *w_s, *b_s,
        *lnv_g, *lnv_b, *conv_w, *a_log, *dt_bias, *onorm_g, *w_pa, *w_pb, *w_o, *ln_g, *ln_b;
    float* out;
    char* ws;
};

__device__ __forceinline__ unsigned pack2(float a, float b) {
    unsigned r;
    asm("v_cvt_pk_bf16_f32 %0, %1, %2" : "=v"(r) : "v"(a), "v"(b));
    return r;
}
__device__ __forceinline__ bf16_t f2bf(float f) { return (bf16_t)(pack2(f, 0.f) & 0xffffu); }
__device__ __forceinline__ float bf2f(bf16_t h) { return __uint_as_float(((unsigned)h) << 16); }
__device__ __forceinline__ float lo_bf(unsigned u) { return __uint_as_float(u << 16); }
__device__ __forceinline__ float hi_bf(unsigned u) { return __uint_as_float(u & 0xffff0000u); }
__device__ __forceinline__ float sigmoid_f(float x) { return __builtin_amdgcn_rcpf(1.f + __builtin_amdgcn_exp2f(-1.4426950408889634f * x)); }
__device__ __forceinline__ float silu_f(float x) { return x * sigmoid_f(x); }
__device__ __forceinline__ float gelu_f(float x) {
    const float y2 = x * (1.5957691216057308f + 0.0713548162726f * x * x);
    return x * __builtin_amdgcn_rcpf(1.f + __builtin_amdgcn_exp2f(-1.4426950408889634f * y2));
}
__device__ __forceinline__ float softplus_f(float x) { return fmaxf(x, 0.f) + log1pf(__expf(-fabsf(x))); }
__device__ __forceinline__ float wave_sum(float v) {
#pragma unroll
    for (int o = 32; o >= 1; o >>= 1) v += __shfl_xor(v, o);
    return v;
}
__device__ __forceinline__ f32x4 mfma16(bf16x8 a, bf16x8 b, f32x4 c) { return __builtin_amdgcn_mfma_f32_16x16x32_bf16(a, b, c, 0, 0, 0); }
template <class Tp> __device__ __forceinline__ Tp ldg_b(const void* base, unsigned boff) { return *(const Tp*)((const char*)base + boff); }
template <class Tp> __device__ __forceinline__ void stg_b(void* base, unsigned boff, Tp v) { *(Tp*)((char*)base + boff) = v; }
__host__ __device__ constexpr int perm32(int k) { return (k & ~31) | (((k >> 2) & 3) << 3) | (((k >> 4) & 1) << 2) | (k & 3); }
__device__ __forceinline__ int opaque_tid() { int t = threadIdx.x; asm volatile("" : "+v"(t)); return t; }
__device__ __forceinline__ int opaque_zero() { int z = 0; asm volatile("" : "+v"(z)); return z; }
__device__ __forceinline__ int cond_row(int row) { return row < TP ? (row >> 11) : (NB + ((row - TP) >> 2)); }

template <int WGM = 8>
__device__ __forceinline__ void tile_map(int L, int ntiles, int nM, int nN, int& tm, int& tn) {
    const int q = ntiles / 8, r = ntiles % 8, xcd = L % 8, off = L / 8;
    const int g = (xcd < r ? xcd * (q + 1) : r * (q + 1) + (xcd - r) * q) + off;
    const int nig = WGM * nN, gid = g / nig, fm = gid * WGM, gsz = (nM - fm) < WGM ? (nM - fm) : WGM;
    tm = fm + (g % nig) % gsz;
    tn = (g % nig) / gsz;
}

template <int MT>
__device__ __forceinline__ void gemm_core(const bf16_t* __restrict__ A, const bf16_t* __restrict__ B, const int K,
                                          f32x4 (&acc)[MT][4], char* smem, const int tid) {
    const int lane = tid & 63, wid = tid >> 6, wr = wid >> 1, wc = wid & 1;
    const int srow = tid >> 3, sseg = (tid & 7) ^ ((tid >> 3) & 7);
    const bf16_t* ag = A + (size_t)srow * K + sseg * 8;
    const bf16_t* bg = B + (size_t)srow * K + sseg * 8;
    const int nk = K >> 6;
#define STAGE(BUF, KT) do { char* d_ = smem + (BUF) * 2 * TILE_BYTES + tid * 16; \
        _Pragma("unroll") for (int i = 0; i < MT; ++i) __builtin_amdgcn_global_load_lds((const unsigned*)(ag + (size_t)(32 * i) * K + (KT) * 64), (__attribute__((address_space(3))) unsigned*)(d_ + i * 4096), 16, 0, 0); \
        _Pragma("unroll") for (int i = 0; i < 4; ++i) __builtin_amdgcn_global_load_lds((const unsigned*)(bg + (size_t)(32 * i) * K + (KT) * 64), (__attribute__((address_space(3))) unsigned*)(d_ + TILE_BYTES + i * 4096), 16, 0, 0); } while (0)
#define COMPUTE(BUF) do { const char* cur = smem + (BUF) * 2 * TILE_BYTES; _Pragma("unroll") for (int kk = 0; kk < 2; ++kk) { \
        bf16x8 af[MT], bfr[4]; const int ko = kk ? kx1 : kx0; \
        _Pragma("unroll") for (int m = 0; m < MT; ++m) af[m] = *(const bf16x8*)(cur + aoff + m * 16 * 128 + ko); \
        _Pragma("unroll") for (int n = 0; n < 4; ++n) bfr[n] = *(const bf16x8*)(cur + boff + n * 16 * 128 + ko); \
        _Pragma("unroll") for (int m = 0; m < MT; ++m) _Pragma("unroll") for (int n = 0; n < 4; ++n) acc[m][n] = mfma16(bfr[n], af[m], acc[m][n]); } } while (0)
    const int fr = lane & 15, fq = lane >> 4;
    const int aoff = (wr * 16 * MT + fr) * 128;
    const int boff = TILE_BYTES + (wc * 64 + fr) * 128;
    const int kx0 = (fq ^ (fr & 7)) << 4, kx1 = ((4 + fq) ^ (fr & 7)) << 4;
    __syncthreads();
    STAGE(0, 0);
    asm volatile("s_waitcnt vmcnt(0)" ::: "memory");
    __syncthreads();
    for (int kt = 0; kt < nk; ++kt) {
        if (kt + 1 < nk) STAGE((kt + 1) & 1, kt + 1);
        COMPUTE(kt & 1);
        asm volatile("s_waitcnt vmcnt(0)" ::: "memory");
        __syncthreads();
    }
#undef STAGE
#undef COMPUTE
}

__device__ __forceinline__ int win_src_col(int np) {
    if (np < 7168) return np;
    if (np < 9216) return np + 16;
    if (np < 9232) return np - 9216 + 7168;
    return -1;
}
__device__ __forceinline__ void transpose_item(const float* __restrict__ src, int ld, bool is_win, bf16_t* __restrict__ dst, int kt, int nt, char* smem) {
    smem += opaque_zero();
    float* tile = (float*)smem;
    const int tid = opaque_tid();
    __syncthreads();
    const int nn = tid & 63, kq = tid >> 6;
    const int np = nt * 64 + nn;
    const int oc = is_win ? win_src_col(np) : np;
#pragma unroll
    for (int i = 0; i < 16; ++i) {
        const int kk = kq + 4 * i;
        tile[kk * 65 + nn] = oc >= 0 ? src[(size_t)(kt * 64 + kk) * ld + oc] : 0.f;
    }
    __syncthreads();
    const int r = tid >> 2, seg = tid & 3;
    unsigned pk[8];
#pragma unroll
    for (int j = 0; j < 8; ++j) pk[j] = pack2(tile[(seg * 16 + 2 * j) * 65 + r], tile[(seg * 16 + 2 * j + 1) * 65 + r]);
    uint4* d = (uint4*)(dst + (size_t)(nt * 64 + r) * 1024 + kt * 64 + seg * 16);
    d[0] = make_uint4(pk[0], pk[1], pk[2], pk[3]);
    d[1] = make_uint4(pk[4], pk[5], pk[6], pk[7]);
}

__device__ __forceinline__ void mod_item(const Params& p, int it, char* smem) {
    smem += opaque_zero();
    float* sc = (float*)smem;
    const int tid = opaque_tid();
    const int rg = it & 7, cb = (it >> 3) % 12, l = it / 96;
    __syncthreads();
    for (int idx = tid; idx < 17 * 1024; idx += 256) {
        const int r = idx >> 10, k = idx & 1023, row = rg * 17 + r;
        const float c = row < NB ? p.c_prompt[row * 1024 + k] : p.c_sample[(row - NB) * 1024 + k];
        sc[idx] = silu_f(c);
    }
    __syncthreads();
    const int col = cb * 256 + tid;
    float acc[17];
#pragma unroll
    for (int r = 0; r < 17; ++r) acc[r] = 0.f;
    const float* wp = p.w_ada + (size_t)l * 1024 * 3072 + col;
    for (int k = 0; k < 1024; k += 4) {
        const float w0 = wp[(size_t)(k + 0) * 3072], w1 = wp[(size_t)(k + 1) * 3072], w2 = wp[(size_t)(k + 2) * 3072], w3 = wp[(size_t)(k + 3) * 3072];
#pragma unroll
        for (int r = 0; r < 17; ++r) {
            const float4 s = *(const float4*)&sc[r * 1024 + k];
            acc[r] += s.x * w0 + s.y * w1 + s.z * w2 + s.w * w3;
        }
    }
    float* mod = (float*)(p.ws + OFF_MOD);
    const float bb = p.b_ada[l * 3072 + col];
#pragma unroll
    for (int r = 0; r < 17; ++r) mod[((size_t)l * NROWB + rg * 17 + r) * 3072 + col] = acc[r] + bb;
}

constexpr int N_TR_IN = (NPAD / 64) * 16;
constexpr int N_TR_SQ = 16 * 16;
constexpr int N_TR_LAYER = N_TR_IN + 3 * N_TR_SQ;
constexpr int N_P0_TR = DEPTH * N_TR_LAYER;
constexpr int N_P0_MOD = DEPTH * 12 * 8;

__device__ __forceinline__ void phase0(const Params& p, char* smem) {
    for (int it = blockIdx.x; it < N_P0_TR + N_P0_MOD; it += gridDim.x) {
        if (it < N_P0_TR) {
            const int l = it / N_TR_LAYER;
            int r = it % N_TR_LAYER;
            if (r < N_TR_IN) {
                transpose_item(p.w_in + (size_t)l * 1024 * PIN, PIN, true, (bf16_t*)(p.ws + OFF_WT_IN) + (size_t)l * NPAD * 1024, r & 15, r >> 4, smem);
            } else {
                r -= N_TR_IN;
                const int which = r / N_TR_SQ;
                r %= N_TR_SQ;
                const float* src = (which == 0 ? p.w_pa : which == 1 ? p.w_pb : p.w_o) + (size_t)l * 1024 * 1024;
                bf16_t* dst = (bf16_t*)(p.ws + (which == 0 ? OFF_WT_PA : which == 1 ? OFF_WT_PB : OFF_WT_O)) + (size_t)l * 1024 * 1024;
                transpose_item(src, 1024, false, dst, r & 15, r >> 4, smem);
            }
        } else {
            mod_item(p, it - N_P0_TR, smem);
        }
    }
}

__device__ __forceinline__ void phase_rows(const Params& p, int l) {
    const int tid = opaque_tid();
    const int lane = tid & 63;
    const int gw = blockIdx.x * 4 + (tid >> 6), nw = gridDim.x * 4;
    float* X = (float*)(p.ws + OFF_X);
    const float* TT = (const float*)(p.ws + OFF_TT);
    bf16_t* H = (bf16_t*)(p.ws + OFF_H);
    const float* mod = (const float*)(p.ws + OFF_MOD);
    for (int row = gw; row < T; row += nw) {
        float v[16];
        if (l == 0) {
            const float* src = row < TP ? p.x_prompt + (size_t)row * 1024 : p.x_sample + (size_t)(row - TP) * 1024;
#pragma unroll
            for (int j = 0; j < 4; ++j) {
                const float4 t = *(const float4*)(src + j * 256 + lane * 4);
                v[j * 4 + 0] = t.x; v[j * 4 + 1] = t.y; v[j * 4 + 2] = t.z; v[j * 4 + 3] = t.w;
            }
        } else {
            const float* src = TT + (size_t)row * 1024;
            float s = 0.f;
#pragma unroll
            for (int j = 0; j < 4; ++j) {
                const float4 t = *(const float4*)(src + j * 256 + lane * 4);
                v[j * 4 + 0] = t.x; v[j * 4 + 1] = t.y; v[j * 4 + 2] = t.z; v[j * 4 + 3] = t.w;
                s += t.x + t.y + t.z + t.w;
            }
            const float mean = wave_sum(s) * (1.f / 1024.f);
            float q = 0.f;
#pragma unroll
            for (int e = 0; e < 16; ++e) { v[e] -= mean; q += v[e] * v[e]; }
            const float rstd = rsqrtf(wave_sum(q) * (1.f / 1024.f) + LN_EPS);
            const float* g = p.ln_g + (l - 1) * 1024;
            const float* bb = p.ln_b + (l - 1) * 1024;
#pragma unroll
            for (int j = 0; j < 4; ++j) {
                const float4 gg = *(const float4*)(g + j * 256 + lane * 4);
                const float4 be = *(const float4*)(bb + j * 256 + lane * 4);
                v[j * 4 + 0] = v[j * 4 + 0] * rstd * gg.x + be.x;
                v[j * 4 + 1] = v[j * 4 + 1] * rstd * gg.y + be.y;
                v[j * 4 + 2] = v[j * 4 + 2] * rstd * gg.z + be.z;
                v[j * 4 + 3] = v[j * 4 + 3] * rstd * gg.w + be.w;
            }
        }
        if (l == DEPTH) {
            float* dst = row < TP ? p.out + O_Y_P + (size_t)row * 1024 : p.out + O_Y_S + (size_t)(row - TP) * 1024;
#pragma unroll
            for (int j = 0; j < 4; ++j) *(float4*)(dst + j * 256 + lane * 4) = make_float4(v[j * 4], v[j * 4 + 1], v[j * 4 + 2], v[j * 4 + 3]);
            continue;
        }
        if (lane == 0) *(float2*)((float*)(p.ws + OFF_STATS) + (size_t)row * 2) = make_float2(0.f, 0.f);
        {
            float* dst = X + (size_t)row * 1024;
            float s = 0.f;
#pragma unroll
            for (int j = 0; j < 4; ++j) {
                *(float4*)(dst + j * 256 + lane * 4) = make_float4(v[j * 4], v[j * 4 + 1], v[j * 4 + 2], v[j * 4 + 3]);
                s += v[j * 4] + v[j * 4 + 1] + v[j * 4 + 2] + v[j * 4 + 3];
            }
            const float mean = wave_sum(s) * (1.f / 1024.f);
            float q = 0.f;
#pragma unroll
            for (int e = 0; e < 16; ++e) { v[e] -= mean; q += v[e] * v[e]; }
            const float rstd = rsqrtf(wave_sum(q) * (1.f / 1024.f) + LN_EPS);
            const float* mrow = mod + ((size_t)l * NROWB + cond_row(row)) * 3072;
#pragma unroll
            for (int j = 0; j < 4; ++j) {
                const float4 sh = *(const float4*)(mrow + j * 256 + lane * 4);
                const float4 scl = *(const float4*)(mrow + 1024 + j * 256 + lane * 4);
                const float h0 = v[j * 4 + 0] * rstd * (1.f + scl.x) + sh.x;
                const float h1 = v[j * 4 + 1] * rstd * (1.f + scl.y) + sh.y;
                const float h2 = v[j * 4 + 2] * rstd * (1.f + scl.z) + sh.z;
                const float h3 = v[j * 4 + 3] * rstd * (1.f + scl.w) + sh.w;
                *(uint2*)(H + (size_t)row * 1024 + j * 256 + lane * 4) = make_uint2(pack2(h0, h1), pack2(h2, h3));
            }
        }
    }
}

__device__ __forceinline__ void phase_inproj(const Params& p, int l, char* smem) {
    const bf16_t* H = (const bf16_t*)(p.ws + OFF_H);
    const bf16_t* Wt = (const bf16_t*)(p.ws + OFF_WT_IN) + (size_t)l * NPAD * 1024;
    bf16_t* P = (bf16_t*)(p.ws + OFF_P);
    float* BETA = (float*)(p.ws + OFF_BETA);
    float* GLOG = (float*)(p.ws + OFF_GLOG);
    constexpr int nM = T / 128, nN = NPAD / 128, ntiles = nM * nN;
    for (int L = blockIdx.x; L < ntiles; L += gridDim.x) {
        const int tid = opaque_tid();
        const int lane = tid & 63, wid = tid >> 6, wr = wid >> 1, wc = wid & 1, fr = lane & 15, fq = lane >> 4;
        int tm, tn;
        tile_map(L, ntiles, nM, nN, tm, tn);
        f32x4 acc[4][4];
#pragma unroll
        for (int m = 0; m < 4; ++m)
#pragma unroll
            for (int n = 0; n < 4; ++n) acc[m][n] = (f32x4){0.f, 0.f, 0.f, 0.f};
        gemm_core<4>(H + (size_t)tm * 128 * 1024, Wt + (size_t)tn * 128 * 1024, 1024, acc, smem, tid);
        if (tn == 72) {
            if (wc == 0) {
#pragma unroll
                for (int m = 0; m < 4; ++m) {
                    const int row = tm * 128 + wr * 64 + m * 16 + fr;
#pragma unroll
                    for (int r = 0; r < 4; ++r) {
                        const float a = acc[m][0][r];
                        if (fq < 2) {
                            BETA[(size_t)row * 8 + fq * 4 + r] = sigmoid_f(a);
                        } else {
                            const int h = (fq - 2) * 4 + r;
                            GLOG[(size_t)row * 8 + h] = -__expf(p.a_log[l * 8 + h]) * softplus_f(a + p.dt_bias[l * 8 + h]);
                        }
                    }
                }
            }
        } else {
            const int kind = tn < 16 ? 0 : tn < 24 ? 1 : tn < 48 ? 2 : tn < 56 ? 1 : 3;
            char* st = smem + opaque_zero();
#pragma unroll
            for (int m = 0; m < 4; ++m) {
                const int rl = wr * 64 + m * 16 + fr;
#pragma unroll
                for (int n = 0; n < 4; ++n) {
                    const int cl = wc * 64 + n * 16 + fq * 4;
                    float a[4];
#pragma unroll
                    for (int r = 0; r < 4; ++r) {
                        const float x = acc[m][n][r];
                        a[r] = kind == 0 ? gelu_f(x) : kind == 1 ? silu_f(x) : kind == 2 ? x : sigmoid_f(x);
                    }
                    *(uint2*)(st + rl * 272 + cl * 2) = make_uint2(pack2(a[0], a[1]), pack2(a[2], a[3]));
                }
            }
            __syncthreads();
#pragma unroll
            for (int i = 0; i < 8; ++i) {
                const int rl = (tid >> 4) + 16 * i, sg = tid & 15;
                const u32x4 v = *(const u32x4*)(st + rl * 272 + sg * 16);
                *(u32x4*)(P + (size_t)(tm * 128 + rl) * PC + tn * 128 + sg * 8) = v;
                if (tn >= 8 && tn < 16) {
                    const float a0 = lo_bf(v[0]), a1 = hi_bf(v[0]), a2 = lo_bf(v[1]), a3 = hi_bf(v[1]), a4 = lo_bf(v[2]), a5 = hi_bf(v[2]), a6 = lo_bf(v[3]), a7 = hi_bf(v[3]);
                    float sm = ((a0 + a1) + (a2 + a3)) + ((a4 + a5) + (a6 + a7));
                    float sq = ((a0 * a0 + a1 * a1) + (a2 * a2 + a3 * a3)) + ((a4 * a4 + a5 * a5) + (a6 * a6 + a7 * a7));
#pragma unroll
                    for (int o = 1; o < 16; o <<= 1) { sm += __shfl_xor(sm, o); sq += __shfl_xor(sq, o); }
                    if (sg == 0) {
                        float* stp = (float*)(p.ws + OFF_STATS) + (size_t)(tm * 128 + rl) * 2;
                        atomicAdd(stp, sm);
                        atomicAdd(stp + 1, sq);
                    }
                }
            }
        }
    }
}

constexpr int T2_A = 256 * 64, T2_B = 128 * 64, T2_STAGE = T2_A + T2_B;
__device__ __forceinline__ void gemm_core256(const bf16_t* __restrict__ A, const bf16_t* __restrict__ B, const int K,
                                             f32x4 (&acc)[8][4], char* smem, const int tid,
                                             const bool pre, const bf16_t* __restrict__ An, const bf16_t* __restrict__ Bn) {
    const int lane = tid & 63, wid = tid >> 6, wr = wid >> 1, wc = wid & 1, fr = lane & 15, fq = lane >> 4;
    const int srow = tid >> 2, sseg = (tid & 3) ^ ((tid >> 3) & 3);
    const bf16_t* ag = A + (size_t)srow * K + sseg * 8;
    const bf16_t* bg = B + (size_t)srow * K + sseg * 8;
    const int sw = (fq ^ ((fr >> 1) & 3)) << 4;
    const int aoff = (wr * 128 + fr) * 64 + sw;
    const int boff = T2_A + (wc * 64 + fr) * 64 + sw;
    const int nk = K >> 5;
#define STAGE2(BUF, KT) do { char* d_ = smem + (BUF) * T2_STAGE + tid * 16; \
        _Pragma("unroll") for (int i = 0; i < 4; ++i) __builtin_amdgcn_global_load_lds((const unsigned*)(ag + (size_t)(64 * i) * K + (KT) * 32), (__attribute__((address_space(3))) unsigned*)(d_ + i * 4096), 16, 0, 0); \
        _Pragma("unroll") for (int i = 0; i < 2; ++i) __builtin_amdgcn_global_load_lds((const unsigned*)(bg + (size_t)(64 * i) * K + (KT) * 32), (__attribute__((address_space(3))) unsigned*)(d_ + T2_A + i * 4096), 16, 0, 0); } while (0)
    if (!pre) STAGE2(0, 0);
    STAGE2(1, 1);
    asm volatile("s_waitcnt vmcnt(6)" ::: "memory");
    __builtin_amdgcn_s_barrier();
    asm volatile("" ::: "memory");
    int cb = 0, nb = 2;
    for (int kt = 0; kt < nk; ++kt) {
        if (kt + 2 < nk) STAGE2(nb, kt + 2);
        const char* cur = smem + cb * T2_STAGE;
        bf16x8 bfr[4], af[8];
#pragma unroll
        for (int n = 0; n < 4; ++n) bfr[n] = *(const bf16x8*)(cur + boff + n * 16 * 64);
#pragma unroll
        for (int m = 0; m < 8; ++m) af[m] = *(const bf16x8*)(cur + aoff + m * 16 * 64);
        __builtin_amdgcn_sched_barrier(0);
#pragma unroll
        for (int m = 0; m < 8; ++m)
#pragma unroll
            for (int n = 0; n < 4; ++n) acc[m][n] = mfma16(bfr[n], af[m], acc[m][n]);
        if (kt + 2 < nk) asm volatile("s_waitcnt vmcnt(6)" ::: "memory");
        else asm volatile("s_waitcnt vmcnt(0)" ::: "memory");
        __builtin_amdgcn_s_barrier();
        asm volatile("" ::: "memory");
        cb = cb == 2 ? 0 : cb + 1;
        nb = nb == 2 ? 0 : nb + 1;
    }
#undef STAGE2
    if (An != nullptr) {
        const bf16_t* agn = An + (size_t)srow * K + sseg * 8;
        const bf16_t* bgn = Bn + (size_t)srow * K + sseg * 8;
        char* d_ = smem + tid * 16;
#pragma unroll
        for (int i = 0; i < 4; ++i) __builtin_amdgcn_global_load_lds((const unsigned*)(agn + (size_t)(64 * i) * K), (__attribute__((address_space(3))) unsigned*)(d_ + i * 4096), 16, 0, 0);
#pragma unroll
        for (int i = 0; i < 2; ++i) __builtin_amdgcn_global_load_lds((const unsigned*)(bgn + (size_t)(64 * i) * K), (__attribute__((address_space(3))) unsigned*)(d_ + T2_A + i * 4096), 16, 0, 0);
    }
}

__device__ __forceinline__ void phase_inproj256(const Params& p, int l, char* smem) {
    const bf16_t* H = (const bf16_t*)(p.ws + OFF_H);
    const bf16_t* Wt = (const bf16_t*)(p.ws + OFF_WT_IN) + (size_t)l * NPAD * 1024;
    bf16_t* P = (bf16_t*)(p.ws + OFF_P);
    float* BETA = (float*)(p.ws + OFF_BETA);
    float* GLOG = (float*)(p.ws + OFF_GLOG);
    constexpr int nM = T / 256, nN = NPAD / 128, ntiles = nM * nN;
    bool pre = false;
    for (int L = blockIdx.x; L < ntiles; L += gridDim.x) {
        const int tid = opaque_tid();
        const int lane = tid & 63, wid = tid >> 6, wr = wid >> 1, wc = wid & 1, fr = lane & 15, fq = lane >> 4;
        int tm, tn;
        tile_map<4>(L, ntiles, nM, nN, tm, tn);
        const bool has_next = L + (int)gridDim.x < ntiles;
        int tmn = 0, tnn = 0;
        if (has_next) tile_map<4>(L + (int)gridDim.x, ntiles, nM, nN, tmn, tnn);
        f32x4 acc[8][4];
#pragma unroll
        for (int m = 0; m < 8; ++m)
#pragma unroll
            for (int n = 0; n < 4; ++n) acc[m][n] = (f32x4){0.f, 0.f, 0.f, 0.f};
        gemm_core256(H + (size_t)tm * 256 * 1024, Wt + (size_t)tn * 128 * 1024, 1024, acc, smem, tid, pre,
                     has_next ? H + (size_t)tmn * 256 * 1024 : nullptr, Wt + (size_t)tnn * 128 * 1024);
        pre = has_next;
        if (tn == 72) {
            if (wc == 0) {
#pragma unroll
                for (int m = 0; m < 8; ++m) {
                    const int row = tm * 256 + wr * 128 + m * 16 + fr;
#pragma unroll
                    for (int r = 0; r < 4; ++r) {
                        const float a = acc[m][0][r];
                        if (fq < 2) {
                            BETA[(size_t)row * 8 + fq * 4 + r] = sigmoid_f(a);
                        } else {
                            const int h = (fq - 2) * 4 + r;
                            GLOG[(size_t)row * 8 + h] = -__expf(p.a_log[l * 8 + h]) * softplus_f(a + p.dt_bias[l * 8 + h]);
                        }
                    }
                }
            }
        } else {
            const int kind = tn < 16 ? 0 : tn < 24 ? 1 : tn < 48 ? 2 : tn < 56 ? 1 : 3;
            char* st = smem + 36864 + opaque_zero();
            unsigned pk[8][4][2];
#pragma unroll
            for (int m = 0; m < 8; ++m)
#pragma unroll
                for (int n = 0; n < 4; ++n) {
                    float a[4];
#pragma unroll
                    for (int r = 0; r < 4; ++r) {
                        const float x = acc[m][n][r];
                        a[r] = kind == 0 ? gelu_f(x) : kind == 1 ? silu_f(x) : kind == 2 ? x : sigmoid_f(x);
                    }
                    pk[m][n][0] = pack2(a[0], a[1]);
                    pk[m][n][1] = pack2(a[2], a[3]);
                }
#pragma unroll
            for (int hh = 0; hh < 2; ++hh) {
                if (wr == hh) {
#pragma unroll
                    for (int m = 0; m < 8; ++m)
#pragma unroll
                        for (int n = 0; n < 4; ++n)
                            *(uint2*)(st + (m * 16 + fr) * 272 + (wc * 64 + n * 16 + fq * 4) * 2) = make_uint2(pk[m][n][0], pk[m][n][1]);
                }
                asm volatile("s_waitcnt lgkmcnt(0)" ::: "memory");
                __builtin_amdgcn_s_barrier();
                asm volatile("" ::: "memory");
#pragma unroll 4
                for (int i = 0; i < 8; ++i) {
                    const int rl = (tid >> 4) + 16 * i, sg = tid & 15;
                    const int row = tm * 256 + hh * 128 + rl;
                    const u32x4 v = *(const u32x4*)(st + rl * 272 + sg * 16);
                    *(u32x4*)(P + (size_t)row * PC + tn * 128 + sg * 8) = v;
                    if (tn >= 8 && tn < 16) {
                        const float a0 = lo_bf(v[0]), a1 = hi_bf(v[0]), a2 = lo_bf(v[1]), a3 = hi_bf(v[1]), a4 = lo_bf(v[2]), a5 = hi_bf(v[2]), a6 = lo_bf(v[3]), a7 = hi_bf(v[3]);
                        float sm = ((a0 + a1) + (a2 + a3)) + ((a4 + a5) + (a6 + a7));
                        float sq = ((a0 * a0 + a1 * a1) + (a2 * a2 + a3 * a3)) + ((a4 * a4 + a5 * a5) + (a6 * a6 + a7 * a7));
#pragma unroll
                        for (int o = 1; o < 16; o <<= 1) { sm += __shfl_xor(sm, o); sq += __shfl_xor(sq, o); }
                        if (sg == 0) {
                            float* stp = (float*)(p.ws + OFF_STATS) + (size_t)row * 2;
                            atomicAdd(stp, sm);
                            atomicAdd(stp + 1, sq);
                        }
                    }
                }
                asm volatile("s_waitcnt lgkmcnt(0)" ::: "memory");
                __builtin_amdgcn_s_barrier();
                asm volatile("" ::: "memory");
            }
        }
    }
}

__device__ __forceinline__ void phase_merge(const Params& p, int l, char* smem) {
    const bf16_t* YA = (const bf16_t*)(p.ws + OFF_YA);
    const bf16_t* YB = (const bf16_t*)(p.ws + OFF_YB);
    const bf16_t* Wa = (const bf16_t*)(p.ws + OFF_WT_PA) + (size_t)l * 1024 * 1024;
    const bf16_t* Wb = (const bf16_t*)(p.ws + OFF_WT_PB) + (size_t)l * 1024 * 1024;
    const bf16_t* P = (const bf16_t*)(p.ws + OFF_P);
    bf16_t* MM = (bf16_t*)(p.ws + OFF_MM);
    constexpr int RT = 96, MT = 3;
    constexpr int nM = T / RT, nN = 8, ntiles = nM * nN;
    for (int L = blockIdx.x; L < ntiles; L += gridDim.x) {
        const int tid = opaque_tid();
        const int lane = tid & 63, wid = tid >> 6, wr = wid >> 1, wc = wid & 1, fr = lane & 15, fq = lane >> 4;
        int tm, tn;
        tile_map(L, ntiles, nM, nN, tm, tn);
        f32x4 acc[MT][4];
#pragma unroll
        for (int m = 0; m < MT; ++m)
#pragma unroll
            for (int n = 0; n < 4; ++n) acc[m][n] = (f32x4){0.f, 0.f, 0.f, 0.f};
        gemm_core<MT>(YA + (size_t)tm * RT * 1024, Wa + (size_t)tn * 128 * 1024, 1024, acc, smem, tid);
        uint2* park = (uint2*)(p.ws + OFF_PARK) + (size_t)blockIdx.x * 4096 + tid;
#pragma unroll
        for (int m = 0; m < MT; ++m) {
            const int row = tm * RT + wr * 16 * MT + m * 16 + fr;
#pragma unroll
            for (int n = 0; n < 4; ++n) {
                const int col = tn * 128 + wc * 64 + n * 16 + fq * 4;
                const uint2 g = *(const uint2*)(P + (size_t)row * PC + C_GA + col);
                park[(m * 4 + n) * 256] = make_uint2(pack2(acc[m][n][0] * lo_bf(g.x), acc[m][n][1] * hi_bf(g.x)),
                                                     pack2(acc[m][n][2] * lo_bf(g.y), acc[m][n][3] * hi_bf(g.y)));
                acc[m][n] = (f32x4){0.f, 0.f, 0.f, 0.f};
            }
            __builtin_amdgcn_sched_barrier(0);
        }
        gemm_core<MT>(YB + (size_t)tm * RT * 1024, Wb + (size_t)tn * 128 * 1024, 1024, acc, smem, tid);
        char* st = smem + opaque_zero();
#pragma unroll
        for (int m = 0; m < MT; ++m) {
            const int rl = wr * 16 * MT + m * 16 + fr;
            const int row = tm * RT + rl;
#pragma unroll
            for (int n = 0; n < 4; ++n) {
                const int cl = wc * 64 + n * 16 + fq * 4;
                const uint2 g = *(const uint2*)(P + (size_t)row * PC + C_GB + tn * 128 + cl);
                const uint2 pm = park[(m * 4 + n) * 256];
                const float a0 = lo_bf(pm.x) + acc[m][n][0] * lo_bf(g.x);
                const float a1 = hi_bf(pm.x) + acc[m][n][1] * hi_bf(g.x);
                const float a2 = lo_bf(pm.y) + acc[m][n][2] * lo_bf(g.y);
                const float a3 = hi_bf(pm.y) + acc[m][n][3] * hi_bf(g.y);
                *(uint2*)(st + rl * 272 + cl * 2) = make_uint2(pack2(a0, a1), pack2(a2, a3));
            }
            __builtin_amdgcn_sched_barrier(0);
        }
        __syncthreads();
#pragma unroll
        for (int i = 0; i < RT / 16; ++i) {
            const int rl = (tid >> 4) + 16 * i, sg = tid & 15;
            const u32x4 v = *(const u32x4*)(st + rl * 272 + sg * 16);
            *(u32x4*)(MM + (size_t)(tm * RT + rl) * 1024 + tn * 128 + sg * 8) = v;
        }
    }
}

__device__ __forceinline__ void phase_outproj(const Params& p, int l, char* smem) {
    const bf16_t* MM = (const bf16_t*)(p.ws + OFF_MM);
    const bf16_t* Wo = (const bf16_t*)(p.ws + OFF_WT_O) + (size_t)l * 1024 * 1024;
    const float* X = (const float*)(p.ws + OFF_X);
    float* TT = (float*)(p.ws + OFF_TT);
    const float* mod = (const float*)(p.ws + OFF_MOD);
    constexpr int RT = 96, MT = 3;
    constexpr int nM = T / RT, nN = 8, ntiles = nM * nN;
    for (int L = blockIdx.x; L < ntiles; L += gridDim.x) {
        const int tid = opaque_tid();
        const int lane = tid & 63, wid = tid >> 6, wr = wid >> 1, wc = wid & 1, fr = lane & 15, fq = lane >> 4;
        int tm, tn;
        tile_map(L, ntiles, nM, nN, tm, tn);
        f32x4 acc[MT][4];
#pragma unroll
        for (int m = 0; m < MT; ++m)
#pragma unroll
            for (int n = 0; n < 4; ++n) acc[m][n] = (f32x4){0.f, 0.f, 0.f, 0.f};
        gemm_core<MT>(MM + (size_t)tm * RT * 1024, Wo + (size_t)tn * 128 * 1024, 1024, acc, smem, tid);
        float* st = (float*)(smem + opaque_zero());
#pragma unroll
        for (int m = 0; m < MT; ++m)
#pragma unroll
            for (int n = 0; n < 4; ++n) *(f32x4*)(st + (wr * 16 * MT + m * 16 + fr) * 132 + wc * 64 + n * 16 + fq * 4) = acc[m][n];
        __syncthreads();
#pragma unroll 4
        for (int i = 0; i < RT / 8; ++i) {
            const int rl = (tid >> 5) + 8 * i, c4 = (tid & 31) * 4;
            const int row = tm * RT + rl, col = tn * 128 + c4;
            const f32x4 a = *(const f32x4*)(st + rl * 132 + c4);
            const float4 x = *(const float4*)(X + (size_t)row * 1024 + col);
            const float4 g = *(const float4*)(mod + ((size_t)l * NROWB + cond_row(row)) * 3072 + 2048 + col);
            *(float4*)(TT + (size_t)row * 1024 + col) = make_float4(ALPHA_DN * x.x + g.x * a[0], ALPHA_DN * x.y + g.y * a[1],
                                                                    ALPHA_DN * x.z + g.z * a[2], ALPHA_DN * x.w + g.w * a[3]);
        }
    }
}

__device__ __forceinline__ void gmlp_prompt_item(const Params& p, int l, int it, char* smem) {
    smem += opaque_zero();
    const int tid = opaque_tid(), lane = tid & 63, wid = tid >> 6, wr = wid >> 1, wc = wid & 1, fr = lane & 15, fq = lane >> 4;
    const int h = it & 7, n = (it >> 3) & 15, b = it >> 7;
    const int tok0 = b * SEQ + n * 128;
    const bf16_t* P = (const bf16_t*)(p.ws + OFF_P);
    bf16_t* YA = (bf16_t*)(p.ws + OFF_YA);
    bf16_t* Wt = (bf16_t*)smem;
    bf16_t* VnT = Wt + 128 * 136;
    float* mu = (float*)(smem + 2 * 34816);
    float* rs = mu + 128;
    __syncthreads();
    {
        const int t = tid >> 1, half = tid & 1;
        if (half == 0) {
            const float2 sv = *(const float2*)((const float*)(p.ws + OFF_STATS) + (size_t)(tok0 + t) * 2);
            const float mean = sv.x * (1.f / 1024.f);
            const float var = fmaxf(sv.y * (1.f / 1024.f) - mean * mean, 0.f);
            mu[t] = mean;
            rs[t] = rsqrtf(var + LN_EPS);
        }
        const float* wsrc = p.w_s + ((size_t)(l * 8 + h) * 128 + t) * 128 + half * 64;
#pragma unroll
        for (int i = 0; i < 8; ++i) {
            const float4 w0 = *(const float4*)(wsrc + i * 8);
            const float4 w1 = *(const float4*)(wsrc + i * 8 + 4);
            const int s0 = half * 64 + i * 8;
            const float e0 = s0 + 0 <= t ? w0.x : 0.f, e1 = s0 + 1 <= t ? w0.y : 0.f, e2 = s0 + 2 <= t ? w0.z : 0.f, e3 = s0 + 3 <= t ? w0.w : 0.f;
            const float e4 = s0 + 4 <= t ? w1.x : 0.f, e5 = s0 + 5 <= t ? w1.y : 0.f, e6 = s0 + 6 <= t ? w1.z : 0.f, e7 = s0 + 7 <= t ? w1.w : 0.f;
            *(uint4*)(Wt + t * 136 + s0) = make_uint4(pack2(e0, e1), pack2(e2, e3), pack2(e4, e5), pack2(e6, e7));
        }
    }
    __syncthreads();
    {
        const int c = tid & 127, sg = tid >> 7;
        const float gam = p.lnv_g[l * 1024 + h * 128 + c], bet = p.lnv_b[l * 1024 + h * 128 + c];
        const bf16_t* src = P + (size_t)tok0 * PC + C_VA + h * 128 + c;
        float* cv = p.out + O_CV_P + ((size_t)(l * NB + b) * 128) * 1024 + h * 128 + c;
#pragma unroll
        for (int oct = 0; oct < 8; ++oct) {
            const int s0 = sg * 64 + oct * 8;
            float e[8];
#pragma unroll
            for (int j = 0; j < 8; ++j) {
                const float x = bf2f(src[(size_t)(s0 + j) * PC]);
                e[j] = (x - mu[s0 + j]) * rs[s0 + j] * gam + bet;
            }
            if (n == 15) {
#pragma unroll
                for (int j = 0; j < 8; ++j) cv[(size_t)(s0 + j) * 1024] = e[j];
            }
            *(uint4*)(VnT + c * 136 + s0) = make_uint4(pack2(e[0], e[1]), pack2(e[2], e[3]), pack2(e[4], e[5]), pack2(e[6], e[7]));
        }
    }
    __syncthreads();
    f32x4 acc[4][4];
#pragma unroll
    for (int m = 0; m < 4; ++m)
#pragma unroll
        for (int nn = 0; nn < 4; ++nn) acc[m][nn] = (f32x4){0.f, 0.f, 0.f, 0.f};
#pragma unroll
    for (int ks = 0; ks < 4; ++ks) {
        bf16x8 af[4], bfr[4];
#pragma unroll
        for (int m = 0; m < 4; ++m) af[m] = *(const bf16x8*)(Wt + (wr * 64 + m * 16 + fr) * 136 + ks * 32 + fq * 8);
#pragma unroll
        for (int nn = 0; nn < 4; ++nn) bfr[nn] = *(const bf16x8*)(VnT + (wc * 64 + nn * 16 + fr) * 136 + ks * 32 + fq * 8);
#pragma unroll
        for (int m = 0; m < 4; ++m)
#pragma unroll
            for (int nn = 0; nn < 4; ++nn) acc[m][nn] = mfma16(bfr[nn], af[m], acc[m][nn]);
    }
#pragma unroll
    for (int m = 0; m < 4; ++m) {
        const int t = wr * 64 + m * 16 + fr;
        const float bs = p.b_s[(l * 8 + h) * 128 + t];
        const bf16_t* prow = P + (size_t)(tok0 + t) * PC + h * 128;
#pragma unroll
        for (int nn = 0; nn < 4; ++nn) {
            const int c = wc * 64 + nn * 16 + fq * 4;
            const uint2 u = *(const uint2*)(prow + C_UA + c);
            const uint2 z = *(const uint2*)(prow + C_ZA + c);
            const float y0 = lo_bf(u.x) * (acc[m][nn][0] + bs) * lo_bf(z.x);
            const float y1 = hi_bf(u.x) * (acc[m][nn][1] + bs) * hi_bf(z.x);
            const float y2 = lo_bf(u.y) * (acc[m][nn][2] + bs) * lo_bf(z.y);
            const float y3 = hi_bf(u.y) * (acc[m][nn][3] + bs) * hi_bf(z.y);
            *(uint2*)(YA + (size_t)(tok0 + t) * 1024 + h * 128 + c) = make_uint2(pack2(y0, y1), pack2(y2, y3));
        }
    }
}

__device__ __forceinline__ void gmlp_sample_item(const Params& p, int l, int b, char* smem) {
    smem += opaque_zero();
    const int tid = opaque_tid(), lane = tid & 63, wid = tid >> 6;
    const int tok0 = TP + b * DSQ;
    const bf16_t* P = (const bf16_t*)(p.ws + OFF_P);
    bf16_t* YA = (bf16_t*)(p.ws + OFF_YA);
    float* red = (float*)smem;
    __syncthreads();
    const int c4 = tid * 4;
    float x[4][4];
    float s[4], ss[4];
#pragma unroll
    for (int t = 0; t < 4; ++t) {
        const uint2 u = *(const uint2*)(P + (size_t)(tok0 + t) * PC + C_VA + c4);
        x[t][0] = lo_bf(u.x); x[t][1] = hi_bf(u.x); x[t][2] = lo_bf(u.y); x[t][3] = hi_bf(u.y);
        s[t] = wave_sum(x[t][0] + x[t][1] + x[t][2] + x[t][3]);
        ss[t] = wave_sum(x[t][0] * x[t][0] + x[t][1] * x[t][1] + x[t][2] * x[t][2] + x[t][3] * x[t][3]);
    }
    if (lane == 0) {
#pragma unroll
        for (int t = 0; t < 4; ++t) { red[wid * 8 + t] = s[t]; red[wid * 8 + 4 + t] = ss[t]; }
    }
    __syncthreads();
    const float4 gam = *(const float4*)(p.lnv_g + l * 1024 + c4);
    const float4 bet = *(const float4*)(p.lnv_b + l * 1024 + c4);
    float vn[4][4];
#pragma unroll
    for (int t = 0; t < 4; ++t) {
        const float st = red[t] + red[8 + t] + red[16 + t] + red[24 + t];
        const float sst = red[4 + t] + red[12 + t] + red[20 + t] + red[28 + t];
        const float mean = st * (1.f / 1024.f);
        const float rstd = rsqrtf(fmaxf(sst * (1.f / 1024.f) - mean * mean, 0.f) + LN_EPS);
        vn[t][0] = (x[t][0] - mean) * rstd * gam.x + bet.x;
        vn[t][1] = (x[t][1] - mean) * rstd * gam.y + bet.y;
        vn[t][2] = (x[t][2] - mean) * rstd * gam.z + bet.z;
        vn[t][3] = (x[t][3] - mean) * rstd * gam.w + bet.w;
        *(float4*)(p.out + O_CV_S + ((size_t)(l * DBT + b) * DSQ + t) * 1024 + c4) = make_float4(vn[t][0], vn[t][1], vn[t][2], vn[t][3]);
    }
    const int h = c4 >> 7;
#pragma unroll
    for (int t = 0; t < 4; ++t) {
        const float bs = p.b_s[(l * 8 + h) * 128 + t];
        float a[4] = {bs, bs, bs, bs};
#pragma unroll
        for (int sidx = 0; sidx <= t; ++sidx) {
            const float w = p.w_s[((size_t)(l * 8 + h) * 128 + t) * 128 + sidx];
#pragma unroll
            for (int e = 0; e < 4; ++e) a[e] += w * vn[sidx][e];
        }
        const uint2 u = *(const uint2*)(P + (size_t)(tok0 + t) * PC + C_UA + c4);
        const uint2 z = *(const uint2*)(P + (size_t)(tok0 + t) * PC + C_ZA + c4);
        const float y0 = lo_bf(u.x) * a[0] * lo_bf(z.x), y1 = hi_bf(u.x) * a[1] * hi_bf(z.x);
        const float y2 = lo_bf(u.y) * a[2] * lo_bf(z.y), y3 = hi_bf(u.y) * a[3] * hi_bf(z.y);
        *(uint2*)(YA + (size_t)(tok0 + t) * 1024 + c4) = make_uint2(pack2(y0, y1), pack2(y2, y3));
    }
}

__device__ __forceinline__ void conv_state_item(const Params& p, int l, int it) {
    const bf16_t* P = (const bf16_t*)(p.ws + OFF_P);
    const bool pr = it < NB;
    const int b = pr ? it : it - NB;
    const int tokb = pr ? b * SEQ + SEQ - 3 : TP + b * DSQ + 1;
    float* dst = pr ? p.out + O_CONV_P + (size_t)(l * NB + b) * 3 * 3072 : p.out + O_CONV_S + (size_t)(l * DBT + b) * 3 * 3072;
    for (int idx = opaque_tid(); idx < 3 * 768; idx += 256) {
        const int j = idx / 768, c = (idx % 768) * 4;
        const uint2 u = *(const uint2*)(P + (size_t)(tokb + j) * PC + C_Q + c);
        *(float4*)(dst + j * 3072 + c) = make_float4(lo_bf(u.x), hi_bf(u.x), lo_bf(u.y), hi_bf(u.y));
    }
}

__device__ __forceinline__ void gdn_sample_item(const Params& p, int l, int it, char* smem) {
    smem += opaque_zero();
    const int tid = opaque_tid(), lane = tid & 63, wid = tid >> 6;
    const int b = it >> 3, h = it & 7;
    const int tok0 = TP + b * DSQ;
    const bf16_t* P = (const bf16_t*)(p.ws + OFF_P);
    const float* BETA = (const float*)(p.ws + OFF_BETA);
    const float* GLOG = (const float*)(p.ws + OFF_GLOG);
    bf16_t* YB = (bf16_t*)(p.ws + OFF_YB);
    float* qs = (float*)smem;
    float* ks = qs + 512;
    float* vs = ks + 512;
    float* red = vs + 512;
    float* part = red + 16;
    float* opart = part + 1024;
    float* red2 = opart + 1024;
    __syncthreads();
    const int j = tid & 127;
    const bool isk = tid >= 128;
    float y1[4], y2[4];
    {
        const int cq = (isk ? 1024 : 0) + h * 128 + j;
        const float* sc = p.state_conv + (size_t)(l * DBT + b) * 3 * 3072;
        const float* cw = p.conv_w + (size_t)l * 4 * 3072;
        float xr[7];
#pragma unroll
        for (int r = 0; r < 3; ++r) xr[r] = sc[r * 3072 + cq];
#pragma unroll
        for (int t = 0; t < 4; ++t) xr[3 + t] = bf2f(P[(size_t)(tok0 + t) * PC + C_Q + cq]);
        const float w0 = cw[cq], w1 = cw[3072 + cq], w2 = cw[2 * 3072 + cq], w3 = cw[3 * 3072 + cq];
#pragma unroll
        for (int t = 0; t < 4; ++t) y1[t] = silu_f(w0 * xr[t] + w1 * xr[t + 1] + w2 * xr[t + 2] + w3 * xr[t + 3]);
        if (!isk) {
            const int cv = 2048 + h * 128 + j;
#pragma unroll
            for (int r = 0; r < 3; ++r) xr[r] = sc[r * 3072 + cv];
#pragma unroll
            for (int t = 0; t < 4; ++t) xr[3 + t] = bf2f(P[(size_t)(tok0 + t) * PC + C_Q + cv]);
            const float v0 = cw[cv], v1 = cw[3072 + cv], v2 = cw[2 * 3072 + cv], v3 = cw[3 * 3072 + cv];
#pragma unroll
            for (int t = 0; t < 4; ++t) y2[t] = silu_f(v0 * xr[t] + v1 * xr[t + 1] + v2 * xr[t + 2] + v3 * xr[t + 3]);
        }
    }
#pragma unroll
    for (int t = 0; t < 4; ++t) {
        const float s = wave_sum(y1[t] * y1[t]);
        if (lane == 0) red[wid * 4 + t] = s;
    }
    __syncthreads();
#pragma unroll
    for (int t = 0; t < 4; ++t) {
        const float tot = isk ? red[8 + t] + red[12 + t] : red[t] + red[4 + t];
        const float rn = rsqrtf(tot + NORM_EPS);
        if (isk) ks[t * 128 + j] = y1[t] * rn;
        else { qs[t * 128 + j] = y1[t] * rn * 0.08838834764831845f; vs[t * 128 + j] = y2[t]; }
    }
    __syncthreads();
    const int vcol = j, kh = tid >> 7;
    float S[64];
    const float* s0 = p.state_ssm + ((size_t)(l * DBT + b) * 8 + h) * 16384 + (size_t)(kh * 64) * 128 + vcol;
#pragma unroll
    for (int kk = 0; kk < 64; ++kk) S[kk] = s0[kk * 128];
#pragma unroll
    for (int t = 0; t < 4; ++t) {
        const float a = __expf(GLOG[(size_t)(tok0 + t) * 8 + h]);
        const float bt = BETA[(size_t)(tok0 + t) * 8 + h];
        float r0 = 0.f, r1 = 0.f;
#pragma unroll
        for (int kk = 0; kk < 64; kk += 4) {
            const float4 kv = *(const float4*)&ks[t * 128 + kh * 64 + kk];
            r0 += S[kk] * kv.x + S[kk + 2] * kv.z;
            r1 += S[kk + 1] * kv.y + S[kk + 3] * kv.w;
        }
        part[(t * 2 + kh) * 128 + vcol] = r0 + r1;
        __syncthreads();
        const float dlt = bt * (vs[t * 128 + vcol] - a * (part[(t * 2) * 128 + vcol] + part[(t * 2 + 1) * 128 + vcol]));
        float o0 = 0.f, o1 = 0.f;
#pragma unroll
        for (int kk = 0; kk < 64; kk += 4) {
            const float4 kv = *(const float4*)&ks[t * 128 + kh * 64 + kk];
            const float4 qv = *(const float4*)&qs[t * 128 + kh * 64 + kk];
            S[kk] = a * S[kk] + kv.x * dlt;
            S[kk + 1] = a * S[kk + 1] + kv.y * dlt;
            S[kk + 2] = a * S[kk + 2] + kv.z * dlt;
            S[kk + 3] = a * S[kk + 3] + kv.w * dlt;
            o0 += S[kk] * qv.x + S[kk + 2] * qv.z;
            o1 += S[kk + 1] * qv.y + S[kk + 3] * qv.w;
        }
        opart[(t * 2 + kh) * 128 + vcol] = o0 + o1;
    }
    float* sout = p.out + O_SSM_S + ((size_t)(l * DBT + b) * 8 + h) * 16384 + (size_t)(kh * 64) * 128 + vcol;
#pragma unroll
    for (int kk = 0; kk < 64; ++kk) sout[kk * 128] = S[kk];
    __syncthreads();
    float o[4];
    if (tid < 128) {
#pragma unroll
        for (int t = 0; t < 4; ++t) {
            o[t] = opart[(t * 2) * 128 + vcol] + opart[(t * 2 + 1) * 128 + vcol];
            const float s = wave_sum(o[t] * o[t]);
            if (lane == 0) red2[wid * 4 + t] = s;
        }
    }
    __syncthreads();
    if (tid < 128) {
        const float gn = p.onorm_g[l * 128 + vcol];
#pragma unroll
        for (int t = 0; t < 4; ++t) {
            const float rinv = rsqrtf((red2[t] + red2[4 + t]) * (1.f / 128.f) + NORM_EPS);
            const float zs = bf2f(P[(size_t)(tok0 + t) * PC + C_ZB + h * 128 + vcol]);
            YB[(size_t)(tok0 + t) * 1024 + h * 128 + vcol] = f2bf(o[t] * rinv * gn * zs);
        }
    }
}

__device__ __forceinline__ void gdn_prep_item(const Params& p, int l, int it, char* smem) {
    smem += opaque_zero();
    const int tid = opaque_tid(), lane = tid & 63, wid = tid >> 6, fr = lane & 15, fq = lane >> 4;
    const int n = it & 31, h = (it >> 5) & 7, b = it >> 8;
    const int tok0 = b * SEQ + n * 64;
    const bf16_t* P = (const bf16_t*)(p.ws + OFF_P);
    const float* BETA = (const float*)(p.ws + OFF_BETA);
    const float* GLOG = (const float*)(p.ws + OFF_GLOG);
    float* Ug = (float*)(p.ws + OFF_U) + (size_t)it * 8192;
    bf16_t* Wg = (bf16_t*)(p.ws + OFF_WG) + (size_t)it * 8192;
    bf16_t* QGg = (bf16_t*)(p.ws + OFF_QG) + (size_t)it * 8192;
    bf16_t* KDTg = (bf16_t*)(p.ws + OFF_KDT) + (size_t)it * 8192;
    bf16_t* QKg = (bf16_t*)(p.ws + OFF_QK) + (size_t)it * 4096;
    float* EGg = (float*)(p.ws + OFF_EG);
    bf16_t* Qs = (bf16_t*)smem;
    bf16_t* Ks = Qs + 64 * 136;
    bf16_t* Kbs = Ks + 64 * 136;
    float* Am = (float*)(smem + 3 * 17408);
    float* gcs = Am + 64 * 68;
    float* betas = gcs + 64;
    float* red = betas + 64;
    __syncthreads();
    if (tid < 64) {
        float g = GLOG[(size_t)(tok0 + tid) * 8 + h];
#pragma unroll
        for (int o = 1; o < 64; o <<= 1) {
            const float t = __shfl_up(g, o);
            if (lane >= o) g += t;
        }
        gcs[tid] = g;
        betas[tid] = BETA[(size_t)(tok0 + tid) * 8 + h];
    }
    const int j = tid & 127;
    const bool isk = tid >= 128;
    float val[64];
    char* R1 = smem + 2 * 17408;
    char* R2 = smem + 3 * 17408;
    {
        const bf16_t* pb = P + ((ptrdiff_t)tok0 - 3) * PC + C_Q + h * 128;
#pragma unroll
        for (int it9 = 0; it9 < 9; ++it9) {
            const int c = tid + 256 * it9;
            if (c < 67 * 32) {
                const int r = c >> 5, sg = c & 31;
                u32x4 v = (u32x4){0u, 0u, 0u, 0u};
                if (n > 0 || r >= 3) v = *(const u32x4*)(pb + (ptrdiff_t)r * PC + (sg >> 4) * 1024 + (sg & 15) * 8);
                *(u32x4*)(R1 + r * 512 + sg * 16) = v;
            }
        }
    }
    __syncthreads();
    {
        const int cq = (isk ? 1024 : 0) + h * 128 + j;
        const float* cw = p.conv_w + (size_t)l * 4 * 3072;
        const float w0 = cw[cq], w1 = cw[3072 + cq], w2 = cw[2 * 3072 + cq], w3 = cw[3 * 3072 + cq];
        const bf16_t* col = (const bf16_t*)(R1 + (isk ? 256 : 0)) + j;
        float x3 = bf2f(col[0]), x2 = bf2f(col[256]), x1 = bf2f(col[512]);
#pragma unroll
        for (int i = 0; i < 64; ++i) {
            const float x0 = bf2f(col[(i + 3) * 256]);
            val[i] = silu_f(w0 * x3 + w1 * x2 + w2 * x1 + w3 * x0);
            x3 = x2; x2 = x1; x1 = x0;
            if ((i & 15) == 15) __builtin_amdgcn_sched_barrier(0);
        }
    }
#pragma unroll
    for (int i = 0; i < 64; ++i) {
        const float s = wave_sum(val[i] * val[i]);
        if (lane == 0) red[wid * 64 + i] = s;
        if ((i & 7) == 7) __builtin_amdgcn_sched_barrier(0);
    }
    __syncthreads();
    const float glast = gcs[63];
    {
        const bf16_t* pb = P + ((ptrdiff_t)tok0 - 3) * PC + C_Q + 2048 + h * 128;
#pragma unroll
        for (int it5 = 0; it5 < 5; ++it5) {
            const int c = tid + 256 * it5;
            if (c < 67 * 16) {
                const int r = c >> 4, sg = c & 15;
                u32x4 v = (u32x4){0u, 0u, 0u, 0u};
                if (n > 0 || r >= 3) v = *(const u32x4*)(pb + (ptrdiff_t)r * PC + sg * 8);
                *(u32x4*)(R2 + r * 256 + sg * 16) = v;
            }
        }
    }
    if (!isk) {
#pragma unroll
        for (int i = 0; i < 64; ++i) {
            const float rn = rsqrtf(red[i] + red[64 + i] + NORM_EPS);
            const float qv = val[i] * rn * 0.08838834764831845f;
            Qs[i * 136 + j] = f2bf(qv);
            QGg[i * 128 + perm32(j)] = f2bf(qv * __expf(gcs[i]));
            if ((i & 7) == 7) __builtin_amdgcn_sched_barrier(0);
        }
    } else {
        unsigned pk[32];
#pragma unroll
        for (int i = 0; i < 64; ++i) {
            const float rn = rsqrtf(red[128 + i] + red[192 + i] + NORM_EPS);
            const float kv = val[i] * rn;
            const float gi = gcs[i], bi = betas[i];
            Ks[i * 136 + j] = f2bf(kv);
            Kbs[i * 136 + j] = f2bf(kv * bi);
            const bf16_t kd = f2bf(kv * __expf(glast - gi));
            if (i & 1) pk[perm32(i) >> 1] |= ((unsigned)kd) << 16; else pk[perm32(i) >> 1] = kd;
            val[i] = kv * bi * __expf(gi);
            if ((i & 7) == 7) __builtin_amdgcn_sched_barrier(0);
        }
#pragma unroll
        for (int i = 0; i < 8; ++i) *(uint4*)(KDTg + j * 64 + i * 8) = make_uint4(pk[i * 4], pk[i * 4 + 1], pk[i * 4 + 2], pk[i * 4 + 3]);
    }
    __syncthreads();
    if (!isk) {
        const int cv = 2048 + h * 128 + j;
        const float* cw = p.conv_w + (size_t)l * 4 * 3072;
        const float w0 = cw[cv], w1 = cw[3072 + cv], w2 = cw[2 * 3072 + cv], w3 = cw[3 * 3072 + cv];
        const bf16_t* col = (const bf16_t*)R2 + j;
        float x3 = bf2f(col[0]), x2 = bf2f(col[128]), x1 = bf2f(col[256]);
#pragma unroll
        for (int i = 0; i < 64; ++i) {
            const float x0 = bf2f(col[(i + 3) * 128]);
            val[i] = silu_f(w0 * x3 + w1 * x2 + w2 * x1 + w3 * x0) * betas[i];
            x3 = x2; x2 = x1; x1 = x0;
            if ((i & 15) == 15) __builtin_amdgcn_sched_barrier(0);
        }
    }
    __syncthreads();
    {
        f32x4 aA[4], aQ[4];
#pragma unroll
        for (int nt = 0; nt < 4; ++nt) { aA[nt] = (f32x4){0.f, 0.f, 0.f, 0.f}; aQ[nt] = (f32x4){0.f, 0.f, 0.f, 0.f}; }
#pragma unroll
        for (int ksi = 0; ksi < 4; ++ksi) {
            const bf16x8 fa = *(const bf16x8*)(Kbs + (wid * 16 + fr) * 136 + ksi * 32 + fq * 8);
            const bf16x8 fqv = *(const bf16x8*)(Qs + (wid * 16 + fr) * 136 + ksi * 32 + fq * 8);
#pragma unroll
            for (int nt = 0; nt < 4; ++nt) {
                const bf16x8 fb = *(const bf16x8*)(Ks + (nt * 16 + fr) * 136 + ksi * 32 + fq * 8);
                aA[nt] = mfma16(fa, fb, aA[nt]);
                aQ[nt] = mfma16(fqv, fb, aQ[nt]);
            }
        }
#pragma unroll
        for (int nt = 0; nt < 4; ++nt) {
            const int jc = nt * 16 + fr;
            const float gj = gcs[jc];
#pragma unroll
            for (int r = 0; r < 4; ++r) {
                const int i = wid * 16 + fq * 4 + r;
                const float dec = jc <= i ? __expf(gcs[i] - gj) : 0.f;
                Am[i * 68 + jc] = jc < i ? aA[nt][r] * dec : 0.f;
                QKg[i * 64 + perm32(jc)] = f2bf(aQ[nt][r] * dec);
            }
        }
    }
    __syncthreads();
#pragma unroll
    for (int i = 1; i < 64; ++i) {
        float s0 = 0.f, s1 = 0.f, s2 = 0.f, s3 = 0.f;
#pragma unroll
        for (int j4 = 0; j4 < (i + 3) / 4; ++j4) {
            const float4 a = *(const float4*)&Am[i * 68 + j4 * 4];
            s0 += a.x * val[j4 * 4];
            s1 += a.y * val[j4 * 4 + 1];
            s2 += a.z * val[j4 * 4 + 2];
            s3 += a.w * val[j4 * 4 + 3];
        }
        val[i] -= (s0 + s1) + (s2 + s3);
        if ((i & 3) == 3) __builtin_amdgcn_sched_barrier(0);
    }
    if (!isk) {
#pragma unroll
        for (int i = 0; i < 64; i += 4)
            *(float4*)(Ug + (((i >> 4) * 8 + (j >> 4)) * 64 + ((i >> 2) & 3) * 16 + (j & 15)) * 4) = make_float4(val[i], val[i + 1], val[i + 2], val[i + 3]);
    } else {
        const int pj = perm32(j);
#pragma unroll
        for (int i = 0; i < 64; ++i) Wg[i * 128 + pj] = f2bf(val[i]);
    }
    if (tid == 0) EGg[it] = __expf(glast);
}

__device__ __forceinline__ void gdn_scan_item(const Params& p, int l, int bh, char* smem) {
    smem += opaque_zero();
    const int tid0 = opaque_tid();
    const int b = bh >> 3, h = bh & 7;
    constexpr int WBY = 64 * 272, BUFB = WBY + 128 * 128;
    const float* EGg = (const float*)(p.ws + OFF_EG);
    f32x4 S[8][2];
#pragma unroll
    for (int mt = 0; mt < 8; ++mt) { S[mt][0] = (f32x4){0.f, 0.f, 0.f, 0.f}; S[mt][1] = (f32x4){0.f, 0.f, 0.f, 0.f}; }
    u32x4 stg[8];
    f32x4 ucur[4][2];
    {
        const size_t item = (size_t)bh * 32;
        const bf16_t* Wp = (const bf16_t*)(p.ws + OFF_WG) + item * 8192;
        const bf16_t* KDTp = (const bf16_t*)(p.ws + OFF_KDT) + item * 8192;
        const float* Up = (const float*)(p.ws + OFF_U) + item * 8192;
        const int lane = tid0 & 63, w = tid0 >> 6, fr = lane & 15, fq = lane >> 4;
#pragma unroll
        for (int i = 0; i < 4; ++i) {
            stg[i] = ldg_b<u32x4>(Wp, 16u * (unsigned)(tid0 + 256 * i));
            stg[4 + i] = ldg_b<u32x4>(KDTp, 16u * (unsigned)(tid0 + 256 * i));
        }
#pragma unroll
        for (int mt = 0; mt < 4; ++mt)
#pragma unroll
            for (int nt = 0; nt < 2; ++nt) ucur[mt][nt] = ldg_b<f32x4>(Up, 16u * (unsigned)((mt * 8 + w * 2 + nt) * 64 + lane));
        __syncthreads();
#pragma unroll
        for (int i = 0; i < 4; ++i) {
            const int c = tid0 + 256 * i;
            *(u32x4*)(smem + (c >> 4) * 272 + (c & 15) * 16) = stg[i];
            *(u32x4*)(smem + WBY + (c >> 3) * 128 + ((((c & 7) ^ ((c >> 3) & 7))) << 4)) = stg[4 + i];
        }
        __syncthreads();
    }
    for (int n = 0; n < 32; ++n) {
        int tid = tid0;
        asm volatile("" : "+v"(tid));
        const int lane = tid & 63, w = tid >> 6, fr = lane & 15, fq = lane >> 4;
        const char* cur = smem + (n & 1) * BUFB;
        const size_t item = (size_t)bh * 32 + n;
        const float eg = EGg[item];
        bf16_t* SBp = (bf16_t*)(p.ws + OFF_SB) + item * 16384;
        bf16_t* VNp = (bf16_t*)(p.ws + OFF_VN) + item * 8192;
        if (n + 1 < 32) {
            const bf16_t* Wp = (const bf16_t*)(p.ws + OFF_WG) + (item + 1) * 8192;
            const bf16_t* KDTp = (const bf16_t*)(p.ws + OFF_KDT) + (item + 1) * 8192;
#pragma unroll
            for (int i = 0; i < 4; ++i) {
                stg[i] = ldg_b<u32x4>(Wp, 16u * (unsigned)(tid + 256 * i));
                stg[4 + i] = ldg_b<u32x4>(KDTp, 16u * (unsigned)(tid + 256 * i));
            }
        }
        bf16x8 sf[4][2];
#pragma unroll
        for (int pp = 0; pp < 4; ++pp)
#pragma unroll
            for (int nt = 0; nt < 2; ++nt) {
                u32x4 t;
                t[0] = pack2(S[2 * pp][nt][0], S[2 * pp][nt][1]);
                t[1] = pack2(S[2 * pp][nt][2], S[2 * pp][nt][3]);
                t[2] = pack2(S[2 * pp + 1][nt][0], S[2 * pp + 1][nt][1]);
                t[3] = pack2(S[2 * pp + 1][nt][2], S[2 * pp + 1][nt][3]);
                stg_b<u32x4>(SBp, 16u * (unsigned)((pp * 8 + w * 2 + nt) * 64 + lane), t);
                sf[pp][nt] = (bf16x8)t;
            }
        bf16x8 vf[2][2];
#pragma unroll
        for (int q = 0; q < 2; ++q) {
            u32x4 t0, t1;
#pragma unroll
            for (int hh = 0; hh < 2; ++hh) {
                const int mt = 2 * q + hh;
                f32x4 a0 = (f32x4){0.f, 0.f, 0.f, 0.f}, a1 = a0;
#pragma unroll
                for (int pp = 0; pp < 4; ++pp) {
                    const bf16x8 wf = *(const bf16x8*)(cur + (mt * 16 + fr) * 272 + pp * 64 + fq * 16);
                    a0 = mfma16(wf, sf[pp][0], a0);
                    a1 = mfma16(wf, sf[pp][1], a1);
                }
                const f32x4 v0 = ucur[mt][0] - a0, v1 = ucur[mt][1] - a1;
                t0[2 * hh] = pack2(v0[0], v0[1]); t0[2 * hh + 1] = pack2(v0[2], v0[3]);
                t1[2 * hh] = pack2(v1[0], v1[1]); t1[2 * hh + 1] = pack2(v1[2], v1[3]);
            }
            stg_b<u32x4>(VNp, 16u * (unsigned)((q * 8 + w * 2) * 64 + lane), t0);
            stg_b<u32x4>(VNp, 16u * (unsigned)((q * 8 + w * 2 + 1) * 64 + lane), t1);
            vf[q][0] = (bf16x8)t0;
            vf[q][1] = (bf16x8)t1;
        }
        if (n + 1 < 32) {
            const float* Up = (const float*)(p.ws + OFF_U) + (item + 1) * 8192;
#pragma unroll
            for (int mt = 0; mt < 4; ++mt)
#pragma unroll
                for (int nt = 0; nt < 2; ++nt) ucur[mt][nt] = ldg_b<f32x4>(Up, 16u * (unsigned)((mt * 8 + w * 2 + nt) * 64 + lane));
        }
#pragma unroll
        for (int mt = 0; mt < 8; ++mt) {
            S[mt][0] *= eg;
            S[mt][1] *= eg;
#pragma unroll
            for (int q = 0; q < 2; ++q) {
                const bf16x8 kf = *(const bf16x8*)(cur + WBY + (mt * 16 + fr) * 128 + (((q * 4 + fq) ^ (fr & 7)) << 4));
                S[mt][0] = mfma16(kf, vf[q][0], S[mt][0]);
                S[mt][1] = mfma16(kf, vf[q][1], S[mt][1]);
            }
        }
        if (n + 1 < 32) {
            char* nxt = smem + ((n + 1) & 1) * BUFB;
#pragma unroll
            for (int i = 0; i < 4; ++i) {
                const int c = tid + 256 * i;
                *(u32x4*)(nxt + (c >> 4) * 272 + (c & 15) * 16) = stg[i];
                *(u32x4*)(nxt + WBY + (c >> 3) * 128 + ((((c & 7) ^ ((c >> 3) & 7))) << 4)) = stg[4 + i];
            }
        }
        __syncthreads();
    }
    const int lane = tid0 & 63, w = tid0 >> 6, fr = lane & 15, fq = lane >> 4;
    float* so = p.out + O_SSM_P + ((size_t)(l * NB + b) * 8 + h) * 16384;
#pragma unroll
    for (int mt = 0; mt < 8; ++mt)
#pragma unroll
        for (int nt = 0; nt < 2; ++nt)
#pragma unroll
            for (int r = 0; r < 4; ++r) so[(mt * 16 + fq * 4 + r) * 128 + w * 32 + nt * 16 + fr] = S[mt][nt][r];
}

__device__ __forceinline__ void gdn_out_item(const Params& p, int l, int it) {
    const int tid = opaque_tid(), lane = tid & 63, w = tid >> 6, fr = lane & 15, fq = lane >> 4;
    const int n = it & 31, h = (it >> 5) & 7, b = it >> 8;
    const bf16_t* QGp = (const bf16_t*)(p.ws + OFF_QG) + (size_t)it * 8192;
    const bf16_t* QKp = (const bf16_t*)(p.ws + OFF_QK) + (size_t)it * 4096;
    const bf16_t* SBp = (const bf16_t*)(p.ws + OFF_SB) + (size_t)it * 16384;
    const bf16_t* VNp = (const bf16_t*)(p.ws + OFF_VN) + (size_t)it * 8192;
    const bf16_t* P = (const bf16_t*)(p.ws + OFF_P);
    bf16_t* YB = (bf16_t*)(p.ws + OFF_YB);
    bf16x8 qg[4], qk[2];
#pragma unroll
    for (int pp = 0; pp < 4; ++pp) qg[pp] = ldg_b<bf16x8>(QGp, 2u * (unsigned)((w * 16 + fr) * 128 + pp * 32 + fq * 8));
#pragma unroll
    for (int q = 0; q < 2; ++q) qk[q] = ldg_b<bf16x8>(QKp, 2u * (unsigned)((w * 16 + fr) * 64 + q * 32 + fq * 8));
    f32x4 acc[8];
    float ss = 0.f;
#pragma unroll
    for (int nt = 0; nt < 8; ++nt) {
        f32x4 a = (f32x4){0.f, 0.f, 0.f, 0.f};
#pragma unroll
        for (int pp = 0; pp < 4; ++pp) a = mfma16(ldg_b<bf16x8>(SBp, 16u * (unsigned)((pp * 8 + nt) * 64 + lane)), qg[pp], a);
#pragma unroll
        for (int q = 0; q < 2; ++q) a = mfma16(ldg_b<bf16x8>(VNp, 16u * (unsigned)((q * 8 + nt) * 64 + lane)), qk[q], a);
        acc[nt] = a;
        ss += a[0] * a[0] + a[1] * a[1] + a[2] * a[2] + a[3] * a[3];
    }
    ss += __shfl_xor(ss, 16);
    ss += __shfl_xor(ss, 32);
    const float rinv = rsqrtf(ss * (1.f / 128.f) + NORM_EPS);
    const size_t tok = (size_t)b * SEQ + n * 64 + w * 16 + fr;
#pragma unroll
    for (int nt = 0; nt < 8; ++nt) {
        const int v0 = nt * 16 + fq * 4;
        const float4 g = *(const float4*)(p.onorm_g + l * 128 + v0);
        const uint2 z = *(const uint2*)(P + tok * PC + C_ZB + h * 128 + v0);
        const float y0 = acc[nt][0] * rinv * g.x * lo_bf(z.x), y1 = acc[nt][1] * rinv * g.y * hi_bf(z.x);
        const float y2 = acc[nt][2] * rinv * g.z * lo_bf(z.y), y3 = acc[nt][3] * rinv * g.w * hi_bf(z.y);
        *(uint2*)(YB + tok * 1024 + h * 128 + v0) = make_uint2(pack2(y0, y1), pack2(y2, y3));
    }
}

constexpr int N_GMLP_P = NB * 16 * 8;
constexpr int N_GDN_S = DBT * 8;
constexpr int N_GMLP_S = DBT;
constexpr int N_CONV = NB + DBT;
constexpr int N_OTHER = N_GMLP_P + N_GDN_S + N_GMLP_S + N_CONV;

__device__ __forceinline__ void other_item(const Params& p, int l, int it, char* smem) {
    if (it < N_GMLP_P) gmlp_prompt_item(p, l, it, smem);
    else if (it < N_GMLP_P + N_GDN_S) gdn_sample_item(p, l, it - N_GMLP_P, smem);
    else if (it < N_GMLP_P + N_GDN_S + N_GMLP_S) gmlp_sample_item(p, l, it - N_GMLP_P - N_GDN_S, smem);
    else conv_state_item(p, l, it - N_GMLP_P - N_GDN_S - N_GMLP_S);
}

__device__ __forceinline__ void phase_mixb(const Params& p, int l, char* smem) {
    const int G = gridDim.x;
    if (G >= 128) {
        if (blockIdx.x < 64) gdn_scan_item(p, l, blockIdx.x, smem);
        else for (int it = blockIdx.x - 64; it < N_OTHER; it += G - 64) other_item(p, l, it, smem);
    } else {
        for (int it = blockIdx.x; it < 64; it += G) gdn_scan_item(p, l, it, smem);
        for (int it = blockIdx.x; it < N_OTHER; it += G) other_item(p, l, it, smem);
    }
}

#define FRESH(q) const Params& q = p
#define XB_TMO      128
#define XB_XCNT(j)  (256  + 64 * (j))
#define XB_XSUB(j)  (1280 + 64 * (j))
#define XB_XGEN(j)  (2304 + 64 * (j))
#define XB_TOP      3328
#define XB_TOPGEN   3392
#define XCD_BAR_WORDS 3456
#define XB_SPIN_CAP (1u << 22)
#define LAS __attribute__((address_space(3)))
__device__ __forceinline__ unsigned xb_ld(unsigned* p) { return __hip_atomic_load(p, __ATOMIC_RELAXED, __HIP_MEMORY_SCOPE_AGENT); }
__device__ __forceinline__ unsigned xb_add(unsigned* p, unsigned v) { return __hip_atomic_fetch_add(p, v, __ATOMIC_RELAXED, __HIP_MEMORY_SCOPE_AGENT); }
__device__ __forceinline__ unsigned xb_xcc_id() { return (unsigned)__builtin_amdgcn_s_getreg((3 << 11) | 20) & 0xFu; }
#define XB_SPIN(cond, bar) do { unsigned _sp = 0; while (cond) { __builtin_amdgcn_s_sleep(1); \
    if ((++_sp & 255u) == 0u) { if (xb_ld(&(bar)[XB_TMO])) break; if (_sp > XB_SPIN_CAP) { atomicAdd(&(bar)[XB_TMO], 1u); break; } } } } while (0)
struct XcdBarrier { unsigned* bar; unsigned x; volatile LAS unsigned* st; };
__device__ __forceinline__ XcdBarrier xcd_barrier_post(unsigned* bar, volatile LAS unsigned* st) {
    XcdBarrier b; b.bar = bar; b.x = xb_xcc_id(); b.st = st;
    if (threadIdx.x == 0) (void)xb_add(&bar[XB_XCNT(b.x)], 1u);
    return b;
}
__device__ __forceinline__ void xcd_barrier_complete(unsigned* bar, unsigned x, unsigned& nloc, unsigned& nx) {
    const unsigned G = gridDim.x * gridDim.y * gridDim.z;
    unsigned sum, cnt, mine, sp = 0u;
    for (;;) {
        sum = 0u; cnt = 0u; mine = 0u;
#pragma unroll
        for (unsigned j = 0; j < 16; ++j) { const unsigned c = xb_ld(&bar[XB_XCNT(j)]); sum += c; cnt += (c > 0u) ? 1u : 0u; mine = (j == x) ? c : mine; }
        if (sum == G) break;
        __builtin_amdgcn_s_sleep(1);
        if ((++sp & 255u) == 0u) { if (xb_ld(&bar[XB_TMO])) break; if (sp > XB_SPIN_CAP) { atomicAdd(&bar[XB_TMO], 1u); break; } }
    }
    nloc = mine > 0u ? mine : 1u; nx = cnt > 0u ? cnt : 1u;
}
__device__ __forceinline__ void xcd_barrier(const XcdBarrier& b) {
    asm volatile("s_waitcnt vmcnt(0)" ::: "memory");
    __syncthreads();
    if (threadIdx.x == 0) {
        unsigned* bar = b.bar;
        __builtin_amdgcn_s_waitcnt(0);
        unsigned nloc = b.st[0], nx = b.st[1];
        if (nloc == 0u) { xcd_barrier_complete(bar, b.x, nloc, nx); b.st[0] = nloc; b.st[1] = nx; }
        const unsigned old = xb_add(&bar[XB_XSUB(b.x)], 1u);
        const unsigned gen = old / nloc;
        if (old + 1u == (gen + 1u) * nloc) {
            __builtin_amdgcn_fence(__ATOMIC_RELEASE, "agent");
            asm volatile("s_waitcnt vmcnt(0)" ::: "memory");
            const unsigned og = xb_add(&bar[XB_TOP], 1u);
            const unsigned tg = og / nx;
            if (og + 1u == (tg + 1u) * nx) xb_add(&bar[XB_TOPGEN], 1u);
            else XB_SPIN(xb_ld(&bar[XB_TOPGEN]) == tg, bar);
            __builtin_amdgcn_fence(__ATOMIC_ACQUIRE, "agent");
            xb_add(&bar[XB_XGEN(b.x)], 1u);
            asm volatile("s_waitcnt vmcnt(0)" ::: "memory");
        } else {
            XB_SPIN(xb_ld(&bar[XB_XGEN(b.x)]) == gen, bar);
            __builtin_amdgcn_fence(__ATOMIC_ACQUIRE, "agent");
            asm volatile("s_waitcnt vmcnt(0)" ::: "memory");
        }
    }
    __syncthreads();
}

__global__ void __launch_bounds__(256, 2) fwd_megakernel(Params p) {
    extern __shared__ __attribute__((aligned(16))) char smem[];
    __shared__ uint4 xb_words;
    cg::grid_group grid = cg::this_grid();
    unsigned* bar = (unsigned*)(p.ws + OFF_BAR);
    if (blockIdx.x == 0) for (int i = threadIdx.x; i < XCD_BAR_WORDS; i += 256) __hip_atomic_store(bar + i, 0u, __ATOMIC_RELAXED, __HIP_MEMORY_SCOPE_AGENT);
    if (threadIdx.x == 0) xb_words = make_uint4(0u, 0u, 0u, 0u);
    { FRESH(q); phase0(q, smem); }
    grid.sync();
    const XcdBarrier xb = xcd_barrier_post(bar, (volatile LAS unsigned*)&xb_words);
#define GBAR() xcd_barrier(xb)
    for (int l = 0; l < DEPTH; ++l) {
        { FRESH(q); phase_rows(q, l); }
        GBAR();
        { FRESH(q); phase_inproj256(q, l, smem); }
        GBAR();
        { FRESH(q); for (int it = blockIdx.x; it < NCHK; it += gridDim.x) gdn_prep_item(q, l, it, smem); }
        GBAR();
        { FRESH(q); phase_mixb(q, l, smem); }
        GBAR();
        { FRESH(q); for (int it = blockIdx.x; it < NCHK; it += gridDim.x) gdn_out_item(q, l, it); }
        GBAR();
        { FRESH(q); phase_merge(q, l, smem); }
        GBAR();
        { FRESH(q); phase_outproj(q, l, smem); }
        GBAR();
    }
    { FRESH(q); phase_rows(q, DEPTH); }
}

extern "C" void kernel_launch(void* const* d_in, const int* in_sizes, int n_in, void* d_out, int out_size, void* d_ws, size_t ws_size,
                              hipStream_t stream) {
    static int grid_blocks = 0;
    if (!grid_blocks) {
        int dev = 0, cus = 0, per_cu = 0;
        hipGetDevice(&dev);
        hipDeviceGetAttribute(&cus, hipDeviceAttributeMultiprocessorCount, dev);
        hipFuncSetAttribute((const void*)fwd_megakernel, hipFuncAttributeMaxDynamicSharedMemorySize, SMEM_BYTES);
        hipOccupancyMaxActiveBlocksPerMultiprocessor(&per_cu, fwd_megakernel, 256, SMEM_BYTES);
        if (per_cu > 2) per_cu = 2;
        if (per_cu < 1) per_cu = 1;
        grid_blocks = cus * per_cu;
    }
    if (ws_size < WS_NEED) {
        fprintf(stderr, "workspace too small: %zu < %zu\n", ws_size, (size_t)WS_NEED);
        return;
    }
    Params p{};
    const float** f = (const float**)&p;
    for (int i = 0; i < 22; ++i) f[i] = (const float*)d_in[i];
    p.out = (float*)d_out;
    p.ws = (char*)d_ws;
    void* args[] = {&p};
    hipError_t e = hipLaunchCooperativeKernel((const void*)fwd_megakernel, dim3(grid_blocks), dim3(256), args, SMEM_BYTES, stream);
    if (e != hipSuccess) fprintf(stderr, "cooperative launch failed: %s (grid %d)\n", hipGetErrorString(e), grid_blocks);
}
```

```cpp
#include <hip/hip_runtime.h>
#include <hip/hip_cooperative_groups.h>
#include <cstdio>
namespace cg = cooperative_groups;

typedef unsigned short bf16_t;
typedef short bf16x8 __attribute__((ext_vector_type(8)));
typedef float f32x4 __attribute__((ext_vector_type(4)));
typedef unsigned u32x4 __attribute__((ext_vector_type(4)));

constexpr int D = 1024;
constexpr int NB = 8, SEQ = 2048, DEPTH = 4, DBT = 128, DSQ = 4;
constexpr int TP = NB * SEQ;
constexpr int TS = DBT * DSQ;
constexpr int T = TP + TS;
constexpr int PIN = 9232;
constexpr int PC = 9216;
constexpr int NPAD = 9344;
constexpr int NROWB = NB + DBT;
constexpr float ALPHA_DN = 1.681792830507429f;
constexpr float LN_EPS = 1e-5f, NORM_EPS = 1e-6f;
constexpr int C_UA = 0, C_VA = 1024, C_ZA = 2048, C_Q = 3072, C_ZB = 6144, C_GA = 7168, C_GB = 8192;

constexpr size_t O_Y_P = 0, O_Y_S = 16777216, O_CONV_P = 17301504, O_SSM_P = 17596416, O_CV_P = 21790720,
                 O_CONV_S = 25985024, O_SSM_S = 30703616, O_CV_S = 97812480;

constexpr size_t SZ_WT_IN = (size_t)DEPTH * NPAD * 1024 * 2;
constexpr size_t SZ_WT_SQ = (size_t)DEPTH * 1024 * 1024 * 2;
constexpr size_t OFF_WT_IN = 0;
constexpr size_t OFF_WT_PA = OFF_WT_IN + SZ_WT_IN;
constexpr size_t OFF_WT_PB = OFF_WT_PA + SZ_WT_SQ;
constexpr size_t OFF_WT_O = OFF_WT_PB + SZ_WT_SQ;
constexpr size_t OFF_MOD = OFF_WT_O + SZ_WT_SQ;
constexpr size_t OFF_X = OFF_MOD + (size_t)DEPTH * NROWB * 3072 * 4;
constexpr size_t OFF_TT = OFF_X + (size_t)T * 1024 * 4;
constexpr size_t OFF_H = OFF_TT + (size_t)T * 1024 * 4;
constexpr size_t OFF_YA = OFF_H + (size_t)T * 1024 * 2;
constexpr size_t OFF_YB = OFF_YA + (size_t)T * 1024 * 2;
constexpr size_t OFF_MM = OFF_YB + (size_t)T * 1024 * 2;
constexpr size_t OFF_P = OFF_MM + (size_t)T * 1024 * 2;
constexpr size_t OFF_BETA = OFF_P + (size_t)T * PC * 2;
constexpr size_t OFF_GLOG = OFF_BETA + (size_t)T * 8 * 4;
constexpr int NCHK = 2048;
constexpr size_t OFF_U = OFF_GLOG + (size_t)T * 8 * 4;
constexpr size_t OFF_WG = OFF_U + (size_t)NCHK * 8192 * 4;
constexpr size_t OFF_QG = OFF_WG + (size_t)NCHK * 8192 * 2;
constexpr size_t OFF_KDT = OFF_QG + (size_t)NCHK * 8192 * 2;
constexpr size_t OFF_QK = OFF_KDT + (size_t)NCHK * 8192 * 2;
constexpr size_t OFF_EG = OFF_QK + (size_t)NCHK * 4096 * 2;
constexpr size_t OFF_SB = OFF_EG + (size_t)NCHK * 4;
constexpr size_t OFF_VN = OFF_SB + (size_t)NCHK * 16384 * 2;
constexpr size_t OFF_PARK = OFF_VN + (size_t)NCHK * 8192 * 2;
constexpr size_t OFF_STATS = OFF_PARK + (size_t)1024 * 32768;
constexpr size_t OFF_BAR = OFF_STATS + (size_t)T * 2 * 4;
constexpr size_t WS_NEED = OFF_BAR + 16384;

constexpr int SMEM_BYTES = 73728;
constexpr int TILE_BYTES = 128 * 128;

struct Params {
    const float *x_prompt, *x_sample, *state_conv, *state_ssm, *c_prompt, *c_sample, *w_ada, *b_ada, *w_in, *w_s, *b_s,
        *lnv_g, *lnv_b, *conv_w, *a_log, *dt_bias, *onorm_g, *w_pa, *w_pb, *w_o, *ln_g, *ln_b;
    float* out;
    char* ws;
};

__device__ __forceinline__ unsigned pack2(float a, float b) {
    unsigned r;
    asm("v_cvt_pk_bf16_f32 %0, %1, %2" : "=v"(r) : "v"(a), "v"(b));
    return r;
}
__device__ __forceinline__ bf16_t f2bf(float f) { return (bf16_t)(pack2(f, 0.f) & 0xffffu); }
__device__ __forceinline__ float bf2f(bf16_t h) { return __uint_as_float(((unsigned)h) << 16); }
__device__ __forceinline__ float lo_bf(unsigned u) { return __uint_as_float(u << 16); }
__device__ __forceinline__ float hi_bf(unsigned u) { return __uint_as_float(u & 0xffff0000u); }
__device__ __forceinline__ float sigmoid_f(float x) { return __builtin_amdgcn_rcpf(1.f + __builtin_amdgcn_exp2f(-1.4426950408889634f * x)); }
__device__ __forceinline__ float silu_f(float x) { return x * sigmoid_f(x); }
__device__ __forceinline__ float gelu_f(float x) {
    const float y2 = x * (1.5957691216057308f + 0.0713548162726f * x * x);
    return x * __builtin_amdgcn_rcpf(1.f + __builtin_amdgcn_exp2f(-1.4426950408889634f * y2));
}
__device__ __forceinline__ float softplus_f(float x) { return fmaxf(x, 0.f) + log1pf(__expf(-fabsf(x))); }
__device__ __forceinline__ float wave_sum(float v) {
#pragma unroll
    for (int o = 32; o >= 1; o >>= 1) v += __shfl_xor(v, o);
    return v;
}
__device__ __forceinline__ f32x4 mfma16(bf16x8 a, bf16x8 b, f32x4 c) { return __builtin_amdgcn_mfma_f32_16x16x32_bf16(a, b, c, 0, 0, 0); }
template <class Tp> __device__ __forceinline__ Tp ldg_b(const void* base, unsigned boff) { return *(const Tp*)((const char*)base + boff); }
template <class Tp> __device__ __forceinline__ void stg_b(void* base, unsigned boff, Tp v) { *(Tp*)((char*)base + boff) = v; }
__host__ __device__ constexpr int perm32(int k) { return (k & ~31) | (((k >> 2) & 3) << 3) | (((k >> 4) & 1) << 2) | (k & 3); }
__device__ __forceinline__ int opaque_tid() { int t = threadIdx.x; asm volatile("" : "+v"(t)); return t; }
__device__ __forceinline__ int opaque_zero() { int z = 0; asm volatile("" : "+v"(z)); return z; }
__device__ __forceinline__ int cond_row(int row) { return row < TP ? (row >> 11) : (NB + ((row - TP) >> 2)); }

template <int WGM = 8>
__device__ __forceinline__ void tile_map(int L, int ntiles, int nM, int nN, int& tm, int& tn) {
    const int q = ntiles / 8, r = ntiles % 8, xcd = L % 8, off = L / 8;
    const int g = (xcd < r ? xcd * (q + 1) : r * (q + 1) + (xcd - r) * q) + off;
    const int nig = WGM * nN, gid = g / nig, fm = gid * WGM, gsz = (nM - fm) < WGM ? (nM - fm) : WGM;
    tm = fm + (g % nig) % gsz;
    tn = (g % nig) / gsz;
}

template <int MT>
__device__ __forceinline__ void gemm_core(const bf16_t* __restrict__ A, const bf16_t* __restrict__ B, const int K,
                                          f32x4 (&acc)[MT][4], char* smem, const int tid) {
    const int lane = tid & 63, wid = tid >> 6, wr = wid >> 1, wc = wid & 1;
    const int srow = tid >> 3, sseg = (tid & 7) ^ ((tid >> 3) & 7);
    const bf16_t* ag = A + (size_t)srow * K + sseg * 8;
    const bf16_t* bg = B + (size_t)srow * K + sseg * 8;
    const int nk = K >> 6;
#define STAGE(BUF, KT) do { char* d_ = smem + (BUF) * 2 * TILE_BYTES + tid * 16; \
        _Pragma("unroll") for (int i = 0; i < MT; ++i) __builtin_amdgcn_global_load_lds((const unsigned*)(ag + (size_t)(32 * i) * K + (KT) * 64), (__attribute__((address_space(3))) unsigned*)(d_ + i * 4096), 16, 0, 0); \
        _Pragma("unroll") for (int i = 0; i < 4; ++i) __builtin_amdgcn_global_load_lds((const unsigned*)(bg + (size_t)(32 * i) * K + (KT) * 64), (__attribute__((address_space(3))) unsigned*)(d_ + TILE_BYTES + i * 4096), 16, 0, 0); } while (0)
#define COMPUTE(BUF) do { const char* cur = smem + (BUF) * 2 * TILE_BYTES; _Pragma("unroll") for (int kk = 0; kk < 2; ++kk) { \
        bf16x8 af[MT], bfr[4]; const int ko = kk ? kx1 : kx0; \
        _Pragma("unroll") for (int m = 0; m < MT; ++m) af[m] = *(const bf16x8*)(cur + aoff + m * 16 * 128 + ko); \
        _Pragma("unroll") for (int n = 0; n < 4; ++n) bfr[n] = *(const bf16x8*)(cur + boff + n * 16 * 128 + ko); \
        _Pragma("unroll") for (int m = 0; m < MT; ++m) _Pragma("unroll") for (int n = 0; n < 4; ++n) acc[m][n] = mfma16(bfr[n], af[m], acc[m][n]); } } while (0)
    const int fr = lane & 15, fq = lane >> 4;
    const int aoff = (wr * 16 * MT + fr) * 128;
    const int boff = TILE_BYTES + (wc * 64 + fr) * 128;
    const int kx0 = (fq ^ (fr & 7)) << 4, kx1 = ((4 + fq) ^ (fr & 7)) << 4;
    __syncthreads();
    STAGE(0, 0);
    asm volatile("s_waitcnt vmcnt(0)" ::: "memory");
    __syncthreads();
    for (int kt = 0; kt < nk; ++kt) {
        if (kt + 1 < nk) STAGE((kt + 1) & 1, kt + 1);
        COMPUTE(kt & 1);
        asm volatile("s_waitcnt vmcnt(0)" ::: "memory");
        __syncthreads();
    }
#undef STAGE
#undef COMPUTE
}

__device__ __forceinline__ int win_src_col(int np) {
    if (np < 7168) return np;
    if (np < 9216) return np + 16;
    if (np < 9232) return np - 9216 + 7168;
    return -1;
}
__device__ __forceinline__ void transpose_item(const float* __restrict__ src, int ld, bool is_win, bf16_t* __restrict__ dst, int kt, int nt, char* smem) {
    smem += opaque_zero();
    float* tile = (float*)smem;
    const int tid = opaque_tid();
    __syncthreads();
    const int nn = tid & 63, kq = tid >> 6;
    const int np = nt * 64 + nn;
    const int oc = is_win ? win_src_col(np) : np;
#pragma unroll
    for (int i = 0; i < 16; ++i) {
        const int kk = kq + 4 * i;
        tile[kk * 65 + nn] = oc >= 0 ? src[(size_t)(kt * 64 + kk) * ld + oc] : 0.f;
    }
    __syncthreads();
    const int r = tid >> 2, seg = tid & 3;
    unsigned pk[8];
#pragma unroll
    for (int j = 0; j < 8; ++j) pk[j] = pack2(tile[(seg * 16 + 2 * j) * 65 + r], tile[(seg * 16 + 2 * j + 1) * 65 + r]);
    uint4* d = (uint4*)(dst + (size_t)(nt * 64 + r) * 1024 + kt * 64 + seg * 16);
    d[0] = make_uint4(pk[0], pk[1], pk[2], pk[3]);
    d[1] = make_uint4(pk[4], pk[5], pk[6], pk[7]);
}

__device__ __forceinline__ void mod_item(const Params& p, int it, char* smem) {
    smem += opaque_zero();
    float* sc = (float*)smem;
    const int tid = opaque_tid();
    const int rg = it & 7, cb = (it >> 3) % 12, l = it / 96;
    __syncthreads();
    for (int idx = tid; idx < 17 * 1024; idx += 256) {
        const int r = idx >> 10, k = idx & 1023, row = rg * 17 + r;
        const float c = row < NB ? p.c_prompt[row * 1024 + k] : p.c_sample[(row - NB) * 1024 + k];
        sc[idx] = silu_f(c);
    }
    __syncthreads();
    const int col = cb * 256 + tid;
    float acc[17];
#pragma unroll
    for (int r = 0; r < 17; ++r) acc[r] = 0.f;
    const float* wp = p.w_ada + (size_t)l * 1024 * 3072 + col;
    for (int k = 0; k < 1024; k += 4) {
        const float w0 = wp[(size_t)(k + 0) * 3072], w1 = wp[(size_t)(k + 1) * 3072], w2 = wp[(size_t)(k + 2) * 3072], w3 = wp[(size_t)(k + 3) * 3072];
#pragma unroll
        for (int r = 0; r < 17; ++r) {
            const float4 s = *(const float4*)&sc[r * 1024 + k];
            acc[r] += s.x * w0 + s.y * w1 + s.z * w2 + s.w * w3;
        }
    }
    float* mod = (float*)(p.ws + OFF_MOD);
    const float bb = p.b_ada[l * 3072 + col];
#pragma unroll
    for (int r = 0; r < 17; ++r) mod[((size_t)l * NROWB + rg * 17 + r) * 3072 + col] = acc[r] + bb;
}

constexpr int N_TR_IN = (NPAD / 64) * 16;
constexpr int N_TR_SQ = 16 * 16;
constexpr int N_TR_LAYER = N_TR_IN + 3 * N_TR_SQ;
constexpr int N_P0_TR = DEPTH * N_TR_LAYER;
constexpr int N_P0_MOD = DEPTH * 12 * 8;

__device__ __forceinline__ void phase0(const Params& p, char* smem) {
    for (int it = blockIdx.x; it < N_P0_TR + N_P0_MOD; it += gridDim.x) {
        if (it < N_P0_TR) {
            const int l = it / N_TR_LAYER;
            int r = it % N_TR_LAYER;
            if (r < N_TR_IN) {
                transpose_item(p.w_in + (size_t)l * 1024 * PIN, PIN, true, (bf16_t*)(p.ws + OFF_WT_IN) + (size_t)l * NPAD * 1024, r & 15, r >> 4, smem);
            } else {
                r -= N_TR_IN;
                const int which = r / N_TR_SQ;
                r %= N_TR_SQ;
                const float* src = (which == 0 ? p.w_pa : which == 1 ? p.w_pb : p.w_o) + (size_t)l * 1024 * 1024;
                bf16_t* dst = (bf16_t*)(p.ws + (which == 0 ? OFF_WT_PA : which == 1 ? OFF_WT_PB : OFF_WT_O)) + (size_t)l * 1024 * 1024;
                transpose_item(src, 1024, false, dst, r & 15, r >> 4, smem);
            }
        } else {
            mod_item(p, it - N_P0_TR, smem);
        }
    }
}

__device__ __forceinline__ void phase_rows(const Params& p, int l) {
    const int tid = opaque_tid();
    const int lane = tid & 63;
    const int gw = blockIdx.x * 4 + (tid >> 6), nw = gridDim.x * 4;
    float* X = (float*)(p.ws + OFF_X);
    const float* TT = (const float*)(p.ws + OFF_TT);
    bf16_t* H = (bf16_t*)(p.ws + OFF_H);
    const float* mod = (const float*)(p.ws + OFF_MOD);
    for (int row = gw; row < T; row += nw) {
        float v[16];
        if (l == 0) {
            const float* src = row < TP ? p.x_prompt + (size_t)row * 1024 : p.x_sample + (size_t)(row - TP) * 1024;
#pragma unroll
            for (int j = 0; j < 4; ++j) {
                const float4 t = *(const float4*)(src + j * 256 + lane * 4);
                v[j * 4 + 0] = t.x; v[j * 4 + 1] = t.y; v[j * 4 + 2] = t.z; v[j * 4 + 3] = t.w;
            }
        } else {
            const float* src = TT + (size_t)row * 1024;
            float s = 0.f;
#pragma unroll
            for (int j = 0; j < 4; ++j) {
                const float4 t = *(const float4*)(src + j * 256 + lane * 4);
                v[j * 4 + 0] = t.x; v[j * 4 + 1] = t.y; v[j * 4 + 2] = t.z; v[j * 4 + 3] = t.w;
                s += t.x + t.y + t.z + t.w;
            }
            const float mean = wave_sum(s) * (1.f / 1024.f);
            float q = 0.f;
#pragma unroll
            for (int e = 0; e < 16; ++e) { v[e] -= mean; q += v[e] * v[e]; }
            const float rstd = rsqrtf(wave_sum(q) * (1.f / 1024.f) + LN_EPS);
            const float* g = p.ln_g + (l - 1) * 1024;
            const float* bb = p.ln_b + (l - 1) * 1024;
#pragma unroll
            for (int j = 0; j < 4; ++j) {
                const float4 gg = *(const float4*)(g + j * 256 + lane * 4);
                const float4 be = *(const float4*)(bb + j * 256 + lane * 4);
                v[j * 4 + 0] = v[j * 4 + 0] * rstd * gg.x + be.x;
                v[j * 4 + 1] = v[j * 4 + 1] * rstd * gg.y + be.y;
                v[j * 4 + 2] = v[j * 4 + 2] * rstd * gg.z + be.z;
                v[j * 4 + 3] = v[j * 4 + 3] * rstd * gg.w + be.w;
            }
        }
        if (l == DEPTH) {
            float* dst = row < TP ? p.out + O_Y_P + (size_t)row * 1024 : p.out + O_Y_S + (size_t)(row - TP) * 1024;
#pragma unroll
            for (int j = 0; j < 4; ++j) *(float4*)(dst + j * 256 + lane * 4) = make_float4(v[j * 4], v[j * 4 + 1], v[j * 4 + 2], v[j * 4 + 3]);
            continue;
        }
        if (lane == 0) *(float2*)((float*)(p.ws + OFF_STATS) + (size_t)row * 2) = make_float2(0.f, 0.f);
        {
            float* dst = X + (size_t)row * 1024;
            float s = 0.f;
#pragma unroll
            for (int j = 0; j < 4; ++j) {
                *(float4*)(dst + j * 256 + lane * 4) = make_float4(v[j * 4], v[j * 4 + 1], v[j * 4 + 2], v[j * 4 + 3]);
                s += v[j * 4] + v[j * 4 + 1] + v[j * 4 + 2] + v[j * 4 + 3];
            }
            const float mean = wave_sum(s) * (1.f / 1024.f);
            float q = 0.f;
#pragma unroll
            for (int e = 0; e < 16; ++e) { v[e] -= mean; q += v[e] * v[e]; }
            const float rstd = rsqrtf(wave_sum(q) * (1.f / 1024.f) + LN_EPS);
            const float* mrow = mod + ((size_t)l * NROWB + cond_row(row)) * 3072;
#pragma unroll
            for (int j = 0; j < 4; ++j) {
                const float4 sh = *(const float4*)(mrow + j * 256 + lane * 4);
                const float4 scl = *(const float4*)(mrow + 1024 + j * 256 + lane * 4);
                const float h0 = v[j * 4 + 0] * rstd * (1.f + scl.x) + sh.x;
                const float h1 = v[j * 4 + 1] * rstd * (1.f + scl.y) + sh.y;
                const float h2 = v[j * 4 + 2] * rstd * (1.f + scl.z) + sh.z;
                const float h3 = v[j * 4 + 3] * rstd * (1.f + scl.w) + sh.w;
                *(uint2*)(H + (size_t)row * 1024 + j * 256 + lane * 4) = make_uint2(pack2(h0, h1), pack2(h2, h3));
            }
        }
    }
}

__device__ __forceinline__ void phase_inproj(const Params& p, int l, char* smem) {
    const bf16_t* H = (const bf16_t*)(p.ws + OFF_H);
    const bf16_t* Wt = (const bf16_t*)(p.ws + OFF_WT_IN) + (size_t)l * NPAD * 1024;
    bf16_t* P = (bf16_t*)(p.ws + OFF_P);
    float* BETA = (float*)(p.ws + OFF_BETA);
    float* GLOG = (float*)(p.ws + OFF_GLOG);
    constexpr int nM = T / 128, nN = NPAD / 128, ntiles = nM * nN;
    for (int L = blockIdx.x; L < ntiles; L += gridDim.x) {
        const int tid = opaque_tid();
        const int lane = tid & 63, wid = tid >> 6, wr = wid >> 1, wc = wid & 1, fr = lane & 15, fq = lane >> 4;
        int tm, tn;
        tile_map(L, ntiles, nM, nN, tm, tn);
        f32x4 acc[4][4];
#pragma unroll
        for (int m = 0; m < 4; ++m)
#pragma unroll
            for (int n = 0; n < 4; ++n) acc[m][n] = (f32x4){0.f, 0.f, 0.f, 0.f};
        gemm_core<4>(H + (size_t)tm * 128 * 1024, Wt + (size_t)tn * 128 * 1024, 1024, acc, smem, tid);
        if (tn == 72) {
            if (wc == 0) {
#pragma unroll
                for (int m = 0; m < 4; ++m) {
                    const int row = tm * 128 + wr * 64 + m * 16 + fr;
#pragma unroll
                    for (int r = 0; r < 4; ++r) {
                        const float a = acc[m][0][r];
                        if (fq < 2) {
                            BETA[(size_t)row * 8 + fq * 4 + r] = sigmoid_f(a);
                        } else {
                            const int h = (fq - 2) * 4 + r;
                            GLOG[(size_t)row * 8 + h] = -__expf(p.a_log[l * 8 + h]) * softplus_f(a + p.dt_bias[l * 8 + h]);
                        }
                    }
                }
            }
        } else {
            const int kind = tn < 16 ? 0 : tn < 24 ? 1 : tn < 48 ? 2 : tn < 56 ? 1 : 3;
            char* st = smem + opaque_zero();
#pragma unroll
            for (int m = 0; m < 4; ++m) {
                const int rl = wr * 64 + m * 16 + fr;
#pragma unroll
                for (int n = 0; n < 4; ++n) {
                    const int cl = wc * 64 + n * 16 + fq * 4;
                    float a[4];
#pragma unroll
                    for (int r = 0; r < 4; ++r) {
                        const float x = acc[m][n][r];
                        a[r] = kind == 0 ? gelu_f(x) : kind == 1 ? silu_f(x) : kind == 2 ? x : sigmoid_f(x);
                    }
                    *(uint2*)(st + rl * 272 + cl * 2) = make_uint2(pack2(a[0], a[1]), pack2(a[2], a[3]));
                }
            }
            __syncthreads();
#pragma unroll
            for (int i = 0; i < 8; ++i) {
                const int rl = (tid >> 4) + 16 * i, sg = tid & 15;
                const u32x4 v = *(const u32x4*)(st + rl * 272 + sg * 16);
                *(u32x4*)(P + (size_t)(tm * 128 + rl) * PC + tn * 128 + sg * 8) = v;
                if (tn >= 8 && tn < 16) {
                    const float a0 = lo_bf(v[0]), a1 = hi_bf(v[0]), a2 = lo_bf(v[1]), a3 = hi_bf(v[1]), a4 = lo_bf(v[2]), a5 = hi_bf(v[2]), a6 = lo_bf(v[3]), a7 = hi_bf(v[3]);
                    float sm = ((a0 + a1) + (a2 + a3)) + ((a4 + a5) + (a6 + a7));
                    float sq = ((a0 * a0 + a1 * a1) + (a2 * a2 + a3 * a3)) + ((a4 * a4 + a5 * a5) + (a6 * a6 + a7 * a7));
#pragma unroll
                    for (int o = 1; o < 16; o <<= 1) { sm += __shfl_xor(sm, o); sq += __shfl_xor(sq, o); }
                    if (sg == 0) {
                        float* stp = (float*)(p.ws + OFF_STATS) + (size_t)(tm * 128 + rl) * 2;
                        atomicAdd(stp, sm);
                        atomicAdd(stp + 1, sq);
                    }
                }
            }
        }
    }
}

constexpr int T2_A = 256 * 64, T2_B = 128 * 64, T2_STAGE = T2_A + T2_B;
__device__ __forceinline__ void gemm_core256(const bf16_t* __restrict__ A, const bf16_t* __restrict__ B, const int K,
                                             f32x4 (&acc)[8][4], char* smem, const int tid) {
    const int lane = tid & 63, wid = tid >> 6, wr = wid >> 1, wc = wid & 1, fr = lane & 15, fq = lane >> 4;
    const int srow = tid >> 2, sseg = (tid & 3) ^ ((tid >> 3) & 3);
    const bf16_t* ag = A + (size_t)srow * K + sseg * 8;
    const bf16_t* bg = B + (size_t)srow * K + sseg * 8;
    const int sw = (fq ^ ((fr >> 1) & 3)) << 4;
    const int aoff = (wr * 128 + fr) * 64 + sw;
    const int boff = T2_A + (wc * 64 + fr) * 64 + sw;
    const int nk = K >> 5;
#define STAGE2(BUF, KT) do { char* d_ = smem + (BUF) * T2_STAGE + tid * 16; \
        _Pragma("unroll") for (int i = 0; i < 4; ++i) __builtin_amdgcn_global_load_lds((const unsigned*)(ag + (size_t)(64 * i) * K + (KT) * 32), (__attribute__((address_space(3))) unsigned*)(d_ + i * 4096), 16, 0, 0); \
        _Pragma("unroll") for (int i = 0; i < 2; ++i) __builtin_amdgcn_global_load_lds((const unsigned*)(bg + (size_t)(64 * i) * K + (KT) * 32), (__attribute__((address_space(3))) unsigned*)(d_ + T2_A + i * 4096), 16, 0, 0); } while (0)
    __syncthreads();
    STAGE2(0, 0);
    STAGE2(1, 1);
    asm volatile("s_waitcnt vmcnt(6)" ::: "memory");
    __builtin_amdgcn_s_barrier();
    asm volatile("" ::: "memory");
    int cb = 0, nb = 2;
    for (int kt = 0; kt < nk; ++kt) {
        if (kt + 2 < nk) STAGE2(nb, kt + 2);
        const char* cur = smem + cb * T2_STAGE;
        bf16x8 bfr[4], af[8];
#pragma unroll
        for (int n = 0; n < 4; ++n) bfr[n] = *(const bf16x8*)(cur + boff + n * 16 * 64);
#pragma unroll
        for (int m = 0; m < 8; ++m) af[m] = *(const bf16x8*)(cur + aoff + m * 16 * 64);
        __builtin_amdgcn_sched_barrier(0);
#pragma unroll
        for (int m = 0; m < 8; ++m)
#pragma unroll
            for (int n = 0; n < 4; ++n) acc[m][n] = mfma16(bfr[n], af[m], acc[m][n]);
        if (kt + 2 < nk) asm volatile("s_waitcnt vmcnt(6)" ::: "memory");
        else asm volatile("s_waitcnt vmcnt(0)" ::: "memory");
        __builtin_amdgcn_s_barrier();
        asm volatile("" ::: "memory");
        cb = cb == 2 ? 0 : cb + 1;
        nb = nb == 2 ? 0 : nb + 1;
    }
#undef STAGE2
    __syncthreads();
}

__device__ __forceinline__ void phase_inproj256(const Params& p, int l, char* smem) {
    const bf16_t* H = (const bf16_t*)(p.ws + OFF_H);
    const bf16_t* Wt = (const bf16_t*)(p.ws + OFF_WT_IN) + (size_t)l * NPAD * 1024;
    bf16_t* P = (bf16_t*)(p.ws + OFF_P);
    float* BETA = (float*)(p.ws + OFF_BETA);
    float* GLOG = (float*)(p.ws + OFF_GLOG);
    constexpr int nM = T / 256, nN = NPAD / 128, ntiles = nM * nN;
    for (int L = blockIdx.x; L < ntiles; L += gridDim.x) {
        const int tid = opaque_tid();
        const int lane = tid & 63, wid = tid >> 6, wr = wid >> 1, wc = wid & 1, fr = lane & 15, fq = lane >> 4;
        int tm, tn;
        tile_map<4>(L, ntiles, nM, nN, tm, tn);
        f32x4 acc[8][4];
#pragma unroll
        for (int m = 0; m < 8; ++m)
#pragma unroll
            for (int n = 0; n < 4; ++n) acc[m][n] = (f32x4){0.f, 0.f, 0.f, 0.f};
        gemm_core256(H + (size_t)tm * 256 * 1024, Wt + (size_t)tn * 128 * 1024, 1024, acc, smem, tid);
        if (tn == 72) {
            if (wc == 0) {
#pragma unroll
                for (int m = 0; m < 8; ++m) {
                    const int row = tm * 256 + wr * 128 + m * 16 + fr;
#pragma unroll
                    for (int r = 0; r < 4; ++r) {
                        const float a = acc[m][0][r];
                        if (fq < 2) {
                            BETA[(size_t)row * 8 + fq * 4 + r] = sigmoid_f(a);
                        } else {
                            const int h = (fq - 2) * 4 + r;
                            GLOG[(size_t)row * 8 + h] = -__expf(p.a_log[l * 8 + h]) * softplus_f(a + p.dt_bias[l * 8 + h]);
                        }
                    }
                }
            }
        } else {
            const int kind = tn < 16 ? 0 : tn < 24 ? 1 : tn < 48 ? 2 : tn < 56 ? 1 : 3;
            char* st = smem + opaque_zero();
#pragma unroll
            for (int m = 0; m < 8; ++m) {
                const int rl = wr * 128 + m * 16 + fr;
#pragma unroll
                for (int n = 0; n < 4; ++n) {
                    const int cl = wc * 64 + n * 16 + fq * 4;
                    float a[4];
#pragma unroll
                    for (int r = 0; r < 4; ++r) {
                        const float x = acc[m][n][r];
                        a[r] = kind == 0 ? gelu_f(x) : kind == 1 ? silu_f(x) : kind == 2 ? x : sigmoid_f(x);
                    }
                    *(uint2*)(st + rl * 272 + cl * 2) = make_uint2(pack2(a[0], a[1]), pack2(a[2], a[3]));
                }
            }
            __syncthreads();
#pragma unroll 4
            for (int i = 0; i < 16; ++i) {
                const int rl = (tid >> 4) + 16 * i, sg = tid & 15;
                const u32x4 v = *(const u32x4*)(st + rl * 272 + sg * 16);
                *(u32x4*)(P + (size_t)(tm * 256 + rl) * PC + tn * 128 + sg * 8) = v;
                if (tn >= 8 && tn < 16) {
                    const float a0 = lo_bf(v[0]), a1 = hi_bf(v[0]), a2 = lo_bf(v[1]), a3 = hi_bf(v[1]), a4 = lo_bf(v[2]), a5 = hi_bf(v[2]), a6 = lo_bf(v[3]), a7 = hi_bf(v[3]);
                    float sm = ((a0 + a1) + (a2 + a3)) + ((a4 + a5) + (a6 + a7));
                    float sq = ((a0 * a0 + a1 * a1) + (a2 * a2 + a3 * a3)) + ((a4 * a4 + a5 * a5) + (a6 * a6 + a7 * a7));
#pragma unroll
                    for (int o = 1; o < 16; o <<= 1) { sm += __shfl_xor(sm, o); sq += __shfl_xor(sq, o); }
                    if (sg == 0) {
                        float* stp = (float*)(p.ws + OFF_STATS) + (size_t)(tm * 256 + rl) * 2;
                        atomicAdd(stp, sm);
                        atomicAdd(stp + 1, sq);
                    }
                }
            }
        }
    }
}

__device__ __forceinline__ void phase_merge(const Params& p, int l, char* smem) {
    const bf16_t* YA = (const bf16_t*)(p.ws + OFF_YA);
    const bf16_t* YB = (const bf16_t*)(p.ws + OFF_YB);
    const bf16_t* Wa = (const bf16_t*)(p.ws + OFF_WT_PA) + (size_t)l * 1024 * 1024;
    const bf16_t* Wb = (const bf16_t*)(p.ws + OFF_WT_PB) + (size_t)l * 1024 * 1024;
    const bf16_t* P = (const bf16_t*)(p.ws + OFF_P);
    bf16_t* MM = (bf16_t*)(p.ws + OFF_MM);
    constexpr int RT = 96, MT = 3;
    constexpr int nM = T / RT, nN = 8, ntiles = nM * nN;
    for (int L = blockIdx.x; L < ntiles; L += gridDim.x) {
        const int tid = opaque_tid();
        const int lane = tid & 63, wid = tid >> 6, wr = wid >> 1, wc = wid & 1, fr = lane & 15, fq = lane >> 4;
        int tm, tn;
        tile_map(L, ntiles, nM, nN, tm, tn);
        f32x4 acc[MT][4];
#pragma unroll
        for (int m = 0; m < MT; ++m)
#pragma unroll
            for (int n = 0; n < 4; ++n) acc[m][n] = (f32x4){0.f, 0.f, 0.f, 0.f};
        gemm_core<MT>(YA + (size_t)tm * RT * 1024, Wa + (size_t)tn * 128 * 1024, 1024, acc, smem, tid);
        uint2* park = (uint2*)(p.ws + OFF_PARK) + (size_t)blockIdx.x * 4096 + tid;
#pragma unroll
        for (int m = 0; m < MT; ++m) {
            const int row = tm * RT + wr * 16 * MT + m * 16 + fr;
#pragma unroll
            for (int n = 0; n < 4; ++n) {
                const int col = tn * 128 + wc * 64 + n * 16 + fq * 4;
                const uint2 g = *(const uint2*)(P + (size_t)row * PC + C_GA + col);
                park[(m * 4 + n) * 256] = make_uint2(pack2(acc[m][n][0] * lo_bf(g.x), acc[m][n][1] * hi_bf(g.x)),
                                                     pack2(acc[m][n][2] * lo_bf(g.y), acc[m][n][3] * hi_bf(g.y)));
                acc[m][n] = (f32x4){0.f, 0.f, 0.f, 0.f};
            }
            __builtin_amdgcn_sched_barrier(0);
        }
        gemm_core<MT>(YB + (size_t)tm * RT * 1024, Wb + (size_t)tn * 128 * 1024, 1024, acc, smem, tid);
        char* st = smem + opaque_zero();
#pragma unroll
        for (int m = 0; m < MT; ++m) {
            const int rl = wr * 16 * MT + m * 16 + fr;
            const int row = tm * RT + rl;
#pragma unroll
            for (int n = 0; n < 4; ++n) {
                const int cl = wc * 64 + n * 16 + fq * 4;
                const uint2 g = *(const uint2*)(P + (size_t)row * PC + C_GB + tn * 128 + cl);
                const uint2 pm = park[(m * 4 + n) * 256];
                const float a0 = lo_bf(pm.x) + acc[m][n][0] * lo_bf(g.x);
                const float a1 = hi_bf(pm.x) + acc[m][n][1] * hi_bf(g.x);
                const float a2 = lo_bf(pm.y) + acc[m][n][2] * lo_bf(g.y);
                const float a3 = hi_bf(pm.y) + acc[m][n][3] * hi_bf(g.y);
                *(uint2*)(st + rl * 272 + cl * 2) = make_uint2(pack2(a0, a1), pack2(a2, a3));
            }
            __builtin_amdgcn_sched_barrier(0);
        }
        __syncthreads();
#pragma unroll
        for (int i = 0; i < RT / 16; ++i) {
            const int rl = (tid >> 4) + 16 * i, sg = tid & 15;
            const u32x4 v = *(const u32x4*)(st + rl * 272 + sg * 16);
            *(u32x4*)(MM + (size_t)(tm * RT + rl) * 1024 + tn * 128 + sg * 8) = v;
        }
    }
}

__device__ __forceinline__ void phase_outproj(const Params& p, int l, char* smem) {
    const bf16_t* MM = (const bf16_t*)(p.ws + OFF_MM);
    const bf16_t* Wo = (const bf16_t*)(p.ws + OFF_WT_O) + (size_t)l * 1024 * 1024;
    const float* X = (const float*)(p.ws + OFF_X);
    float* TT = (float*)(p.ws + OFF_TT);
    const float* mod = (const float*)(p.ws + OFF_MOD);
    constexpr int RT = 96, MT = 3;
    constexpr int nM = T / RT, nN = 8, ntiles = nM * nN;
    for (int L = blockIdx.x; L < ntiles; L += gridDim.x) {
        const int tid = opaque_tid();
        const int lane = tid & 63, wid = tid >> 6, wr = wid >> 1, wc = wid & 1, fr = lane & 15, fq = lane >> 4;
        int tm, tn;
        tile_map(L, ntiles, nM, nN, tm, tn);
        f32x4 acc[MT][4];
#pragma unroll
        for (int m = 0; m < MT; ++m)
#pragma unroll
            for (int n = 0; n < 4; ++n) acc[m][n] = (f32x4){0.f, 0.f, 0.f, 0.f};
        gemm_core<MT>(MM + (size_t)tm * RT * 1024, Wo + (size_t)tn * 128 * 1024, 1024, acc, smem, tid);
        float* st = (float*)(smem + opaque_zero());
#pragma unroll
        for (int m = 0; m < MT; ++m)
#pragma unroll
            for (int n = 0; n < 4; ++n) *(f32x4*)(st + (wr * 16 * MT + m * 16 + fr) * 132 + wc * 64 + n * 16 + fq * 4) = acc[m][n];
        __syncthreads();
#pragma unroll 4
        for (int i = 0; i < RT / 8; ++i) {
            const int rl = (tid >> 5) + 8 * i, c4 = (tid & 31) * 4;
            const int row = tm * RT + rl, col = tn * 128 + c4;
            const f32x4 a = *(const f32x4*)(st + rl * 132 + c4);
            const float4 x = *(const float4*)(X + (size_t)row * 1024 + col);
            const float4 g = *(const float4*)(mod + ((size_t)l * NROWB + cond_row(row)) * 3072 + 2048 + col);
            *(float4*)(TT + (size_t)row * 1024 + col) = make_float4(ALPHA_DN * x.x + g.x * a[0], ALPHA_DN * x.y + g.y * a[1],
                                                                    ALPHA_DN * x.z + g.z * a[2], ALPHA_DN * x.w + g.w * a[3]);
        }
    }
}

__device__ __forceinline__ void gmlp_prompt_item(const Params& p, int l, int it, char* smem) {
    smem += opaque_zero();
    const int tid = opaque_tid(), lane = tid & 63, wid = tid >> 6, wr = wid >> 1, wc = wid & 1, fr = lane & 15, fq = lane >> 4;
    const int h = it & 7, n = (it >> 3) & 15, b = it >> 7;
    const int tok0 = b * SEQ + n * 128;
    const bf16_t* P = (const bf16_t*)(p.ws + OFF_P);
    bf16_t* YA = (bf16_t*)(p.ws + OFF_YA);
    bf16_t* Wt = (bf16_t*)smem;
    bf16_t* VnT = Wt + 128 * 136;
    float* mu = (float*)(smem + 2 * 34816);
    float* rs = mu + 128;
    __syncthreads();
    {
        const int t = tid >> 1, half = tid & 1;
        if (half == 0) {
            const float2 sv = *(const float2*)((const float*)(p.ws + OFF_STATS) + (size_t)(tok0 + t) * 2);
            const float mean = sv.x * (1.f / 1024.f);
            const float var = fmaxf(sv.y * (1.f / 1024.f) - mean * mean, 0.f);
            mu[t] = mean;
            rs[t] = rsqrtf(var + LN_EPS);
        }
        const float* wsrc = p.w_s + ((size_t)(l * 8 + h) * 128 + t) * 128 + half * 64;
#pragma unroll
        for (int i = 0; i < 8; ++i) {
            const float4 w0 = *(const float4*)(wsrc + i * 8);
            const float4 w1 = *(const float4*)(wsrc + i * 8 + 4);
            const int s0 = half * 64 + i * 8;
            const float e0 = s0 + 0 <= t ? w0.x : 0.f, e1 = s0 + 1 <= t ? w0.y : 0.f, e2 = s0 + 2 <= t ? w0.z : 0.f, e3 = s0 + 3 <= t ? w0.w : 0.f;
            const float e4 = s0 + 4 <= t ? w1.x : 0.f, e5 = s0 + 5 <= t ? w1.y : 0.f, e6 = s0 + 6 <= t ? w1.z : 0.f, e7 = s0 + 7 <= t ? w1.w : 0.f;
            *(uint4*)(Wt + t * 136 + s0) = make_uint4(pack2(e0, e1), pack2(e2, e3), pack2(e4, e5), pack2(e6, e7));
        }
    }
    __syncthreads();
    {
        const int c = tid & 127, sg = tid >> 7;
        const float gam = p.lnv_g[l * 1024 + h * 128 + c], bet = p.lnv_b[l * 1024 + h * 128 + c];
        const bf16_t* src = P + (size_t)tok0 * PC + C_VA + h * 128 + c;
        float* cv = p.out + O_CV_P + ((size_t)(l * NB + b) * 128) * 1024 + h * 128 + c;
#pragma unroll
        for (int oct = 0; oct < 8; ++oct) {
            const int s0 = sg * 64 + oct * 8;
            float e[8];
#pragma unroll
            for (int j = 0; j < 8; ++j) {
                const float x = bf2f(src[(size_t)(s0 + j) * PC]);
                e[j] = (x - mu[s0 + j]) * rs[s0 + j] * gam + bet;
            }
            if (n == 15) {
#pragma unroll
                for (int j = 0; j < 8; ++j) cv[(size_t)(s0 + j) * 1024] = e[j];
            }
            *(uint4*)(VnT + c * 136 + s0) = make_uint4(pack2(e[0], e[1]), pack2(e[2], e[3]), pack2(e[4], e[5]), pack2(e[6], e[7]));
        }
    }
    __syncthreads();
    f32x4 acc[4][4];
#pragma unroll
    for (int m = 0; m < 4; ++m)
#pragma unroll
        for (int nn = 0; nn < 4; ++nn) acc[m][nn] = (f32x4){0.f, 0.f, 0.f, 0.f};
#pragma unroll
    for (int ks = 0; ks < 4; ++ks) {
        bf16x8 af[4], bfr[4];
#pragma unroll
        for (int m = 0; m < 4; ++m) af[m] = *(const bf16x8*)(Wt + (wr * 64 + m * 16 + fr) * 136 + ks * 32 + fq * 8);
#pragma unroll
        for (int nn = 0; nn < 4; ++nn) bfr[nn] = *(const bf16x8*)(VnT + (wc * 64 + nn * 16 + fr) * 136 + ks * 32 + fq * 8);
#pragma unroll
        for (int m = 0; m < 4; ++m)
#pragma unroll
            for (int nn = 0; nn < 4; ++nn) acc[m][nn] = mfma16(bfr[nn], af[m], acc[m][nn]);
    }
#pragma unroll
    for (int m = 0; m < 4; ++m) {
        const int t = wr * 64 + m * 16 + fr;
        const float bs = p.b_s[(l * 8 + h) * 128 + t];
        const bf16_t* prow = P + (size_t)(tok0 + t) * PC + h * 128;
#pragma unroll
        for (int nn = 0; nn < 4; ++nn) {
            const int c = wc * 64 + nn * 16 + fq * 4;
            const uint2 u = *(const uint2*)(prow + C_UA + c);
            const uint2 z = *(const uint2*)(prow + C_ZA + c);
            const float y0 = lo_bf(u.x) * (acc[m][nn][0] + bs) * lo_bf(z.x);
            const float y1 = hi_bf(u.x) * (acc[m][nn][1] + bs) * hi_bf(z.x);
            const float y2 = lo_bf(u.y) * (acc[m][nn][2] + bs) * lo_bf(z.y);
            const float y3 = hi_bf(u.y) * (acc[m][nn][3] + bs) * hi_bf(z.y);
            *(uint2*)(YA + (size_t)(tok0 + t) * 1024 + h * 128 + c) = make_uint2(pack2(y0, y1), pack2(y2, y3));
        }
    }
}

__device__ __forceinline__ void gmlp_sample_item(const Params& p, int l, int b, char* smem) {
    smem += opaque_zero();
    const int tid = opaque_tid(), lane = tid & 63, wid = tid >> 6;
    const int tok0 = TP + b * DSQ;
    const bf16_t* P = (const bf16_t*)(p.ws + OFF_P);
    bf16_t* YA = (bf16_t*)(p.ws + OFF_YA);
    float* red = (float*)smem;
    __syncthreads();
    const int c4 = tid * 4;
    float x[4][4];
    float s[4], ss[4];
#pragma unroll
    for (int t = 0; t < 4; ++t) {
        const uint2 u = *(const uint2*)(P + (size_t)(tok0 + t) * PC + C_VA + c4);
        x[t][0] = lo_bf(u.x); x[t][1] = hi_bf(u.x); x[t][2] = lo_bf(u.y); x[t][3] = hi_bf(u.y);
        s[t] = wave_sum(x[t][0] + x[t][1] + x[t][2] + x[t][3]);
        ss[t] = wave_sum(x[t][0] * x[t][0] + x[t][1] * x[t][1] + x[t][2] * x[t][2] + x[t][3] * x[t][3]);
    }
    if (lane == 0) {
#pragma unroll
        for (int t = 0; t < 4; ++t) { red[wid * 8 + t] = s[t]; red[wid * 8 + 4 + t] = ss[t]; }
    }
    __syncthreads();
    const float4 gam = *(const float4*)(p.lnv_g + l * 1024 + c4);
    const float4 bet = *(const float4*)(p.lnv_b + l * 1024 + c4);
    float vn[4][4];
#pragma unroll
    for (int t = 0; t < 4; ++t) {
        const float st = red[t] + red[8 + t] + red[16 + t] + red[24 + t];
        const float sst = red[4 + t] + red[12 + t] + red[20 + t] + red[28 + t];
        const float mean = st * (1.f / 1024.f);
        const float rstd = rsqrtf(fmaxf(sst * (1.f / 1024.f) - mean * mean, 0.f) + LN_EPS);
        vn[t][0] = (x[t][0] - mean) * rstd * gam.x + bet.x;
        vn[t][1] = (x[t][1] - mean) * rstd * gam.y + bet.y;
        vn[t][2] = (x[t][2] - mean) * rstd * gam.z + bet.z;
        vn[t][3] = (x[t][3] - mean) * rstd * gam.w + bet.w;
        *(float4*)(p.out + O_CV_S + ((size_t)(l * DBT + b) * DSQ + t) * 1024 + c4) = make_float4(vn[t][0], vn[t][1], vn[t][2], vn[t][3]);
    }
    const int h = c4 >> 7;
#pragma unroll
    for (int t = 0; t < 4; ++t) {
        const float bs = p.b_s[(l * 8 + h) * 128 + t];
        float a[4] = {bs, bs, bs, bs};
#pragma unroll
        for (int sidx = 0; sidx <= t; ++sidx) {
            const float w = p.w_s[((size_t)(l * 8 + h) * 128 + t) * 128 + sidx];
#pragma unroll
            for (int e = 0; e < 4; ++e) a[e] += w * vn[sidx][e];
        }
        const uint2 u = *(const uint2*)(P + (size_t)(tok0 + t) * PC + C_UA + c4);
        const uint2 z = *(const uint2*)(P + (size_t)(tok0 + t) * PC + C_ZA + c4);
        const float y0 = lo_bf(u.x) * a[0] * lo_bf(z.x), y1 = hi_bf(u.x) * a[1] * hi_bf(z.x);
        const float y2 = lo_bf(u.y) * a[2] * lo_bf(z.y), y3 = hi_bf(u.y) * a[3] * hi_bf(z.y);
        *(uint2*)(YA + (size_t)(tok0 + t) * 1024 + c4) = make_uint2(pack2(y0, y1), pack2(y2, y3));
    }
}

__device__ __forceinline__ void conv_state_item(const Params& p, int l, int it) {
    const bf16_t* P = (const bf16_t*)(p.ws + OFF_P);
    const bool pr = it < NB;
    const int b = pr ? it : it - NB;
    const int tokb = pr ? b * SEQ + SEQ - 3 : TP + b * DSQ + 1;
    float* dst = pr ? p.out + O_CONV_P + (size_t)(l * NB + b) * 3 * 3072 : p.out + O_CONV_S + (size_t)(l * DBT + b) * 3 * 3072;
    for (int idx = opaque_tid(); idx < 3 * 768; idx += 256) {
        const int j = idx / 768, c = (idx % 768) * 4;
        const uint2 u = *(const uint2*)(P + (size_t)(tokb + j) * PC + C_Q + c);
        *(float4*)(dst + j * 3072 + c) = make_float4(lo_bf(u.x), hi_bf(u.x), lo_bf(u.y), hi_bf(u.y));
    }
}

__device__ __forceinline__ void gdn_sample_item(const Params& p, int l, int it, char* smem) {
    smem += opaque_zero();
    const int tid = opaque_tid(), lane = tid & 63, wid = tid >> 6;
    const int b = it >> 3, h = it & 7;
    const int tok0 = TP + b * DSQ;
    const bf16_t* P = (const bf16_t*)(p.ws + OFF_P);
    const float* BETA = (const float*)(p.ws + OFF_BETA);
    const float* GLOG = (const float*)(p.ws + OFF_GLOG);
    bf16_t* YB = (bf16_t*)(p.ws + OFF_YB);
    float* qs = (float*)smem;
    float* ks = qs + 512;
    float* vs = ks + 512;
    float* red = vs + 512;
    float* part = red + 16;
    float* opart = part + 1024;
    float* red2 = opart + 1024;
    __syncthreads();
    const int j = tid & 127;
    const bool isk = tid >= 128;
    float y1[4], y2[4];
    {
        const int cq = (isk ? 1024 : 0) + h * 128 + j;
        const float* sc = p.state_conv + (size_t)(l * DBT + b) * 3 * 3072;
        const float* cw = p.conv_w + (size_t)l * 4 * 3072;
        float xr[7];
#pragma unroll
        for (int r = 0; r < 3; ++r) xr[r] = sc[r * 3072 + cq];
#pragma unroll
        for (int t = 0; t < 4; ++t) xr[3 + t] = bf2f(P[(size_t)(tok0 + t) * PC + C_Q + cq]);
        const float w0 = cw[cq], w1 = cw[3072 + cq], w2 = cw[2 * 3072 + cq], w3 = cw[3 * 3072 + cq];
#pragma unroll
        for (int t = 0; t < 4; ++t) y1[t] = silu_f(w0 * xr[t] + w1 * xr[t + 1] + w2 * xr[t + 2] + w3 * xr[t + 3]);
        if (!isk) {
            const int cv = 2048 + h * 128 + j;
#pragma unroll
            for (int r = 0; r < 3; ++r) xr[r] = sc[r * 3072 + cv];
#pragma unroll
            for (int t = 0; t < 4; ++t) xr[3 + t] = bf2f(P[(size_t)(tok0 + t) * PC + C_Q + cv]);
            const float v0 = cw[cv], v1 = cw[3072 + cv], v2 = cw[2 * 3072 + cv], v3 = cw[3 * 3072 + cv];
#pragma unroll
            for (int t = 0; t < 4; ++t) y2[t] = silu_f(v0 * xr[t] + v1 * xr[t + 1] + v2 * xr[t + 2] + v3 * xr[t + 3]);
        }
    }
#pragma unroll
    for (int t = 0; t < 4; ++t) {
        const float s = wave_sum(y1[t] * y1[t]);
        if (lane == 0) red[wid * 4 + t] = s;
    }
    __syncthreads();
#pragma unroll
    for (int t = 0; t < 4; ++t) {
        const float tot = isk ? red[8 + t] + red[12 + t] : red[t] + red[4 + t];
        const float rn = rsqrtf(tot + NORM_EPS);
        if (isk) ks[t * 128 + j] = y1[t] * rn;
        else { qs[t * 128 + j] = y1[t] * rn * 0.08838834764831845f; vs[t * 128 + j] = y2[t]; }
    }
    __syncthreads();
    const int vcol = j, kh = tid >> 7;
    float S[64];
    const float* s0 = p.state_ssm + ((size_t)(l * DBT + b) * 8 + h) * 16384 + (size_t)(kh * 64) * 128 + vcol;
#pragma unroll
    for (int kk = 0; kk < 64; ++kk) S[kk] = s0[kk * 128];
#pragma unroll
    for (int t = 0; t < 4; ++t) {
        const float a = __expf(GLOG[(size_t)(tok0 + t) * 8 + h]);
        const float bt = BETA[(size_t)(tok0 + t) * 8 + h];
        float r0 = 0.f, r1 = 0.f;
#pragma unroll
        for (int kk = 0; kk < 64; kk += 4) {
            const float4 kv = *(const float4*)&ks[t * 128 + kh * 64 + kk];
            r0 += S[kk] * kv.x + S[kk + 2] * kv.z;
            r1 += S[kk + 1] * kv.y + S[kk + 3] * kv.w;
        }
        part[(t * 2 + kh) * 128 + vcol] = r0 + r1;
        __syncthreads();
        const float dlt = bt * (vs[t * 128 + vcol] - a * (part[(t * 2) * 128 + vcol] + part[(t * 2 + 1) * 128 + vcol]));
        float o0 = 0.f, o1 = 0.f;
#pragma unroll
        for (int kk = 0; kk < 64; kk += 4) {
            const float4 kv = *(const float4*)&ks[t * 128 + kh * 64 + kk];
            const float4 qv = *(const float4*)&qs[t * 128 + kh * 64 + kk];
            S[kk] = a * S[kk] + kv.x * dlt;
            S[kk + 1] = a * S[kk + 1] + kv.y * dlt;
            S[kk + 2] = a * S[kk + 2] + kv.z * dlt;
            S[kk + 3] = a * S[kk + 3] + kv.w * dlt;
            o0 += S[kk] * qv.x + S[kk + 2] * qv.z;
            o1 += S[kk + 1] * qv.y + S[kk + 3] * qv.w;
        }
        opart[(t * 2 + kh) * 128 + vcol] = o0 + o1;
    }
    float* sout = p.out + O_SSM_S + ((size_t)(l * DBT + b) * 8 + h) * 16384 + (size_t)(kh * 64) * 128 + vcol;
#pragma unroll
    for (int kk = 0; kk < 64; ++kk) sout[kk * 128] = S[kk];
    __syncthreads();
    float o[4];
    if (tid < 128) {
#pragma unroll
        for (int t = 0; t < 4; ++t) {
            o[t] = opart[(t * 2) * 128 + vcol] + opart[(t * 2 + 1) * 128 + vcol];
            const float s = wave_sum(o[t] * o[t]);
            if (lane == 0) red2[wid * 4 + t] = s;
        }
    }
    __syncthreads();
    if (tid < 128) {
        const float gn = p.onorm_g[l * 128 + vcol];
#pragma unroll
        for (int t = 0; t < 4; ++t) {
            const float rinv = rsqrtf((red2[t] + red2[4 + t]) * (1.f / 128.f) + NORM_EPS);
            const float zs = bf2f(P[(size_t)(tok0 + t) * PC + C_ZB + h * 128 + vcol]);
            YB[(size_t)(tok0 + t) * 1024 + h * 128 + vcol] = f2bf(o[t] * rinv * gn * zs);
        }
    }
}

__device__ __forceinline__ void gdn_prep_item(const Params& p, int l, int it, char* smem) {
    smem += opaque_zero();
    const int tid = opaque_tid(), lane = tid & 63, wid = tid >> 6, fr = lane & 15, fq = lane >> 4;
    const int n = it & 31, h = (it >> 5) & 7, b = it >> 8;
    const int tok0 = b * SEQ + n * 64;
    const bf16_t* P = (const bf16_t*)(p.ws + OFF_P);
    const float* BETA = (const float*)(p.ws + OFF_BETA);
    const float* GLOG = (const float*)(p.ws + OFF_GLOG);
    float* Ug = (float*)(p.ws + OFF_U) + (size_t)it * 8192;
    bf16_t* Wg = (bf16_t*)(p.ws + OFF_WG) + (size_t)it * 8192;
    bf16_t* QGg = (bf16_t*)(p.ws + OFF_QG) + (size_t)it * 8192;
    bf16_t* KDTg = (bf16_t*)(p.ws + OFF_KDT) + (size_t)it * 8192;
    bf16_t* QKg = (bf16_t*)(p.ws + OFF_QK) + (size_t)it * 4096;
    float* EGg = (float*)(p.ws + OFF_EG);
    bf16_t* Qs = (bf16_t*)smem;
    bf16_t* Ks = Qs + 64 * 136;
    bf16_t* Kbs = Ks + 64 * 136;
    float* Am = (float*)(smem + 3 * 17408);
    float* gcs = Am + 64 * 68;
    float* betas = gcs + 64;
    float* red = betas + 64;
    __syncthreads();
    if (tid < 64) {
        float g = GLOG[(size_t)(tok0 + tid) * 8 + h];
#pragma unroll
        for (int o = 1; o < 64; o <<= 1) {
            const float t = __shfl_up(g, o);
            if (lane >= o) g += t;
        }
        gcs[tid] = g;
        betas[tid] = BETA[(size_t)(tok0 + tid) * 8 + h];
    }
    const int j = tid & 127;
    const bool isk = tid >= 128;
    float val[64];
    char* R1 = smem + 2 * 17408;
    char* R2 = smem + 3 * 17408;
    {
        const bf16_t* pb = P + ((ptrdiff_t)tok0 - 3) * PC + C_Q + h * 128;
#pragma unroll
        for (int it9 = 0; it9 < 9; ++it9) {
            const int c = tid + 256 * it9;
            if (c < 67 * 32) {
                const int r = c >> 5, sg = c & 31;
                u32x4 v = (u32x4){0u, 0u, 0u, 0u};
                if (n > 0 || r >= 3) v = *(const u32x4*)(pb + (ptrdiff_t)r * PC + (sg >> 4) * 1024 + (sg & 15) * 8);
                *(u32x4*)(R1 + r * 512 + sg * 16) = v;
            }
        }
    }
    __syncthreads();
    {
        const int cq = (isk ? 1024 : 0) + h * 128 + j;
        const float* cw = p.conv_w + (size_t)l * 4 * 3072;
        const float w0 = cw[cq], w1 = cw[3072 + cq], w2 = cw[2 * 3072 + cq], w3 = cw[3 * 3072 + cq];
        const bf16_t* col = (const bf16_t*)(R1 + (isk ? 256 : 0)) + j;
        float x3 = bf2f(col[0]), x2 = bf2f(col[256]), x1 = bf2f(col[512]);
#pragma unroll
        for (int i = 0; i < 64; ++i) {
            const float x0 = bf2f(col[(i + 3) * 256]);
            val[i] = silu_f(w0 * x3 + w1 * x2 + w2 * x1 + w3 * x0);
            x3 = x2; x2 = x1; x1 = x0;
            if ((i & 15) == 15) __builtin_amdgcn_sched_barrier(0);
        }
    }
#pragma unroll
    for (int i = 0; i < 64; ++i) {
        const float s = wave_sum(val[i] * val[i]);
        if (lane == 0) red[wid * 64 + i] = s;
        if ((i & 7) == 7) __builtin_amdgcn_sched_barrier(0);
    }
    __syncthreads();
    const float glast = gcs[63];
    {
        const bf16_t* pb = P + ((ptrdiff_t)tok0 - 3) * PC + C_Q + 2048 + h * 128;
#pragma unroll
        for (int it5 = 0; it5 < 5; ++it5) {
            const int c = tid + 256 * it5;
            if (c < 67 * 16) {
                const int r = c >> 4, sg = c & 15;
                u32x4 v = (u32x4){0u, 0u, 0u, 0u};
                if (n > 0 || r >= 3) v = *(const u32x4*)(pb + (ptrdiff_t)r * PC + sg * 8);
                *(u32x4*)(R2 + r * 256 + sg * 16) = v;
            }
        }
    }
    if (!isk) {
#pragma unroll
        for (int i = 0; i < 64; ++i) {
            const float rn = rsqrtf(red[i] + red[64 + i] + NORM_EPS);
            const float qv = val[i] * rn * 0.08838834764831845f;
            Qs[i * 136 + j] = f2bf(qv);
            QGg[i * 128 + perm32(j)] = f2bf(qv * __expf(gcs[i]));
            if ((i & 7) == 7) __builtin_amdgcn_sched_barrier(0);
        }
    } else {
        unsigned pk[32];
#pragma unroll
        for (int i = 0; i < 64; ++i) {
            const float rn = rsqrtf(red[128 + i] + red[192 + i] + NORM_EPS);
            const float kv = val[i] * rn;
            const float gi = gcs[i], bi = betas[i];
            Ks[i * 136 + j] = f2bf(kv);
            Kbs[i * 136 + j] = f2bf(kv * bi);
            const bf16_t kd = f2bf(kv * __expf(glast - gi));
            if (i & 1) pk[perm32(i) >> 1] |= ((unsigned)kd) << 16; else pk[perm32(i) >> 1] = kd;
            val[i] = kv * bi * __expf(gi);
            if ((i & 7) == 7) __builtin_amdgcn_sched_barrier(0);
        }
#pragma unroll
        for (int i = 0; i < 8; ++i) *(uint4*)(KDTg + j * 64 + i * 8) = make_uint4(pk[i * 4], pk[i * 4 + 1], pk[i * 4 + 2], pk[i * 4 + 3]);
    }
    __syncthreads();
    if (!isk) {
        const int cv = 2048 + h * 128 + j;
        const float* cw = p.conv_w + (size_t)l * 4 * 3072;
        const float w0 = cw[cv], w1 = cw[3072 + cv], w2 = cw[2 * 3072 + cv], w3 = cw[3 * 3072 + cv];
        const bf16_t* col = (const bf16_t*)R2 + j;
        float x3 = bf2f(col[0]), x2 = bf2f(col[128]), x1 = bf2f(col[256]);
#pragma unroll
        for (int i = 0; i < 64; ++i) {
            const float x0 = bf2f(col[(i + 3) * 128]);
            val[i] = silu_f(w0 * x3 + w1 * x2 + w2 * x1 + w3 * x0) * betas[i];
            x3 = x2; x2 = x1; x1 = x0;
            if ((i & 15) == 15) __builtin_amdgcn_sched_barrier(0);
        }
    }
    __syncthreads();
    {
        f32x4 aA[4], aQ[4];
#pragma unroll
        for (int nt = 0; nt < 4; ++nt) { aA[nt] = (f32x4){0.f, 0.f, 0.f, 0.f}; aQ[nt] = (f32x4){0.f, 0.f, 0.f, 0.f}; }
#pragma unroll
        for (int ksi = 0; ksi < 4; ++ksi) {
            const bf16x8 fa = *(const bf16x8*)(Kbs + (wid * 16 + fr) * 136 + ksi * 32 + fq * 8);
            const bf16x8 fqv = *(const bf16x8*)(Qs + (wid * 16 + fr) * 136 + ksi * 32 + fq * 8);
#pragma unroll
            for (int nt = 0; nt < 4; ++nt) {
                const bf16x8 fb = *(const bf16x8*)(Ks + (nt * 16 + fr) * 136 + ksi * 32 + fq * 8);
                aA[nt] = mfma16(fa, fb, aA[nt]);
                aQ[nt] = mfma16(fqv, fb, aQ[nt]);
            }
        }
#pragma unroll
        for (int nt = 0; nt < 4; ++nt) {
            const int jc = nt * 16 + fr;
            const float gj = gcs[jc];
#pragma unroll
            for (int r = 0; r < 4; ++r) {
                const int i = wid * 16 + fq * 4 + r;
                const float dec = jc <= i ? __expf(gcs[i] - gj) : 0.f;
                Am[i * 68 + jc] = jc < i ? aA[nt][r] * dec : 0.f;
                QKg[i * 64 + perm32(jc)] = f2bf(aQ[nt][r] * dec);
            }
        }
    }
    __syncthreads();
#pragma unroll
    for (int i = 1; i < 64; ++i) {
        float s0 = 0.f, s1 = 0.f, s2 = 0.f, s3 = 0.f;
#pragma unroll
        for (int j4 = 0; j4 < (i + 3) / 4; ++j4) {
            const float4 a = *(const float4*)&Am[i * 68 + j4 * 4];
            s0 += a.x * val[j4 * 4];
            s1 += a.y * val[j4 * 4 + 1];
            s2 += a.z * val[j4 * 4 + 2];
            s3 += a.w * val[j4 * 4 + 3];
        }
        val[i] -= (s0 + s1) + (s2 + s3);
        if ((i & 3) == 3) __builtin_amdgcn_sched_barrier(0);
    }
    if (!isk) {
#pragma unroll
        for (int i = 0; i < 64; i += 4)
            *(float4*)(Ug + (((i >> 4) * 8 + (j >> 4)) * 64 + ((i >> 2) & 3) * 16 + (j & 15)) * 4) = make_float4(val[i], val[i + 1], val[i + 2], val[i + 3]);
    } else {
        const int pj = perm32(j);
#pragma unroll
        for (int i = 0; i < 64; ++i) Wg[i * 128 + pj] = f2bf(val[i]);
    }
    if (tid == 0) EGg[it] = __expf(glast);
}

__device__ __forceinline__ void gdn_scan_item(const Params& p, int l, int bh, char* smem) {
    smem += opaque_zero();
    const int tid0 = opaque_tid();
    const int b = bh >> 3, h = bh & 7;
    constexpr int WBY = 64 * 272, BUFB = WBY + 128 * 128;
    const float* EGg = (const float*)(p.ws + OFF_EG);
    f32x4 S[8][2];
#pragma unroll
    for (int mt = 0; mt < 8; ++mt) { S[mt][0] = (f32x4){0.f, 0.f, 0.f, 0.f}; S[mt][1] = (f32x4){0.f, 0.f, 0.f, 0.f}; }
    u32x4 stg[8];
    f32x4 ucur[4][2];
    {
        const size_t item = (size_t)bh * 32;
        const bf16_t* Wp = (const bf16_t*)(p.ws + OFF_WG) + item * 8192;
        const bf16_t* KDTp = (const bf16_t*)(p.ws + OFF_KDT) + item * 8192;
        const float* Up = (const float*)(p.ws + OFF_U) + item * 8192;
        const int lane = tid0 & 63, w = tid0 >> 6, fr = lane & 15, fq = lane >> 4;
#pragma unroll
        for (int i = 0; i < 4; ++i) {
            stg[i] = ldg_b<u32x4>(Wp, 16u * (unsigned)(tid0 + 256 * i));
            stg[4 + i] = ldg_b<u32x4>(KDTp, 16u * (unsigned)(tid0 + 256 * i));
        }
#pragma unroll
        for (int mt = 0; mt < 4; ++mt)
#pragma unroll
            for (int nt = 0; nt < 2; ++nt) ucur[mt][nt] = ldg_b<f32x4>(Up, 16u * (unsigned)((mt * 8 + w * 2 + nt) * 64 + lane));
        __syncthreads();
#pragma unroll
        for (int i = 0; i < 4; ++i) {
            const int c = tid0 + 256 * i;
            *(u32x4*)(smem + (c >> 4) * 272 + (c & 15) * 16) = stg[i];
            *(u32x4*)(smem + WBY + (c >> 3) * 128 + ((((c & 7) ^ ((c >> 3) & 7))) << 4)) = stg[4 + i];
        }
        __syncthreads();
    }
    for (int n = 0; n < 32; ++n) {
        int tid = tid0;
        asm volatile("" : "+v"(tid));
        const int lane = tid & 63, w = tid >> 6, fr = lane & 15, fq = lane >> 4;
        const char* cur = smem + (n & 1) * BUFB;
        const size_t item = (size_t)bh * 32 + n;
        const float eg = EGg[item];
        bf16_t* SBp = (bf16_t*)(p.ws + OFF_SB) + item * 16384;
        bf16_t* VNp = (bf16_t*)(p.ws + OFF_VN) + item * 8192;
        if (n + 1 < 32) {
            const bf16_t* Wp = (const bf16_t*)(p.ws + OFF_WG) + (item + 1) * 8192;
            const bf16_t* KDTp = (const bf16_t*)(p.ws + OFF_KDT) + (item + 1) * 8192;
#pragma unroll
            for (int i = 0; i < 4; ++i) {
                stg[i] = ldg_b<u32x4>(Wp, 16u * (unsigned)(tid + 256 * i));
                stg[4 + i] = ldg_b<u32x4>(KDTp, 16u * (unsigned)(tid + 256 * i));
            }
        }
        bf16x8 sf[4][2];
#pragma unroll
        for (int pp = 0; pp < 4; ++pp)
#pragma unroll
            for (int nt = 0; nt < 2; ++nt) {
                u32x4 t;
                t[0] = pack2(S[2 * pp][nt][0], S[2 * pp][nt][1]);
                t[1] = pack2(S[2 * pp][nt][2], S[2 * pp][nt][3]);
                t[2] = pack2(S[2 * pp + 1][nt][0], S[2 * pp + 1][nt][1]);
                t[3] = pack2(S[2 * pp + 1][nt][2], S[2 * pp + 1][nt][3]);
                stg_b<u32x4>(SBp, 16u * (unsigned)((pp * 8 + w * 2 + nt) * 64 + lane), t);
                sf[pp][nt] = (bf16x8)t;
            }
        bf16x8 vf[2][2];
#pragma unroll
        for (int q = 0; q < 2; ++q) {
            u32x4 t0, t1;
#pragma unroll
            for (int hh = 0; hh < 2; ++hh) {
                const int mt = 2 * q + hh;
                f32x4 a0 = (f32x4){0.f, 0.f, 0.f, 0.f}, a1 = a0;
#pragma unroll
                for (int pp = 0; pp < 4; ++pp) {
                    const bf16x8 wf = *(const bf16x8*)(cur + (mt * 16 + fr) * 272 + pp * 64 + fq * 16);
                    a0 = mfma16(wf, sf[pp][0], a0);
                    a1 = mfma16(wf, sf[pp][1], a1);
                }
                const f32x4 v0 = ucur[mt][0] - a0, v1 = ucur[mt][1] - a1;
                t0[2 * hh] = pack2(v0[0], v0[1]); t0[2 * hh + 1] = pack2(v0[2], v0[3]);
                t1[2 * hh] = pack2(v1[0], v1[1]); t1[2 * hh + 1] = pack2(v1[2], v1[3]);
            }
            stg_b<u32x4>(VNp, 16u * (unsigned)((q * 8 + w * 2) * 64 + lane), t0);
            stg_b<u32x4>(VNp, 16u * (unsigned)((q * 8 + w * 2 + 1) * 64 + lane), t1);
            vf[q][0] = (bf16x8)t0;
            vf[q][1] = (bf16x8)t1;
        }
        if (n + 1 < 32) {
            const float* Up = (const float*)(p.ws + OFF_U) + (item + 1) * 8192;
#pragma unroll
            for (int mt = 0; mt < 4; ++mt)
#pragma unroll
                for (int nt = 0; nt < 2; ++nt) ucur[mt][nt] = ldg_b<f32x4>(Up, 16u * (unsigned)((mt * 8 + w * 2 + nt) * 64 + lane));
        }
#pragma unroll
        for (int mt = 0; mt < 8; ++mt) {
            S[mt][0] *= eg;
            S[mt][1] *= eg;
#pragma unroll
            for (int q = 0; q < 2; ++q) {
                const bf16x8 kf = *(const bf16x8*)(cur + WBY + (mt * 16 + fr) * 128 + (((q * 4 + fq) ^ (fr & 7)) << 4));
                S[mt][0] = mfma16(kf, vf[q][0], S[mt][0]);
                S[mt][1] = mfma16(kf, vf[q][1], S[mt][1]);
            }
        }
        if (n + 1 < 32) {
            char* nxt = smem + ((n + 1) & 1) * BUFB;
#pragma unroll
            for (int i = 0; i < 4; ++i) {
                const int c = tid + 256 * i;
                *(u32x4*)(nxt + (c >> 4) * 272 + (c & 15) * 16) = stg[i];
                *(u32x4*)(nxt + WBY + (c >> 3) * 128 + ((((c & 7) ^ ((c >> 3) & 7))) << 4)) = stg[4 + i];
            }
        }
        __syncthreads();
    }
    const int lane = tid0 & 63, w = tid0 >> 6, fr = lane & 15, fq = lane >> 4;
    float* so = p.out + O_SSM_P + ((size_t)(l * NB + b) * 8 + h) * 16384;
#pragma unroll
    for (int mt = 0; mt < 8; ++mt)
#pragma unroll
        for (int nt = 0; nt < 2; ++nt)
#pragma unroll
            for (int r = 0; r < 4; ++r) so[(mt * 16 + fq * 4 + r) * 128 + w * 32 + nt * 16 + fr] = S[mt][nt][r];
}

__device__ __forceinline__ void gdn_out_item(const Params& p, int l, int it) {
    const int tid = opaque_tid(), lane = tid & 63, w = tid >> 6, fr = lane & 15, fq = lane >> 4;
    const int n = it & 31, h = (it >> 5) & 7, b = it >> 8;
    const bf16_t* QGp = (const bf16_t*)(p.ws + OFF_QG) + (size_t)it * 8192;
    const bf16_t* QKp = (const bf16_t*)(p.ws + OFF_QK) + (size_t)it * 4096;
    const bf16_t* SBp = (const bf16_t*)(p.ws + OFF_SB) + (size_t)it * 16384;
    const bf16_t* VNp = (const bf16_t*)(p.ws + OFF_VN) + (size_t)it * 8192;
    const bf16_t* P = (const bf16_t*)(p.ws + OFF_P);
    bf16_t* YB = (bf16_t*)(p.ws + OFF_YB);
    bf16x8 qg[4], qk[2];
#pragma unroll
    for (int pp = 0; pp < 4; ++pp) qg[pp] = ldg_b<bf16x8>(QGp, 2u * (unsigned)((w * 16 + fr) * 128 + pp * 32 + fq * 8));
#pragma unroll
    for (int q = 0; q < 2; ++q) qk[q] = ldg_b<bf16x8>(QKp, 2u * (unsigned)((w * 16 + fr) * 64 + q * 32 + fq * 8));
    f32x4 acc[8];
    float ss = 0.f;
    const size_t tok = (size_t)b * SEQ + n * 64 + w * 16 + fr;
    uint2 zz[8];
#pragma unroll
    for (int nt = 0; nt < 8; ++nt) zz[nt] = *(const uint2*)(P + tok * PC + C_ZB + h * 128 + nt * 16 + fq * 4);
#pragma unroll
    for (int g = 0; g < 2; ++g) {
        bf16x8 sb[4][4], vn[4][2];
#pragma unroll
        for (int t = 0; t < 4; ++t) {
#pragma unroll
            for (int pp = 0; pp < 4; ++pp) sb[t][pp] = ldg_b<bf16x8>(SBp, 16u * (unsigned)((pp * 8 + g * 4 + t) * 64 + lane));
#pragma unroll
            for (int q = 0; q < 2; ++q) vn[t][q] = ldg_b<bf16x8>(VNp, 16u * (unsigned)((q * 8 + g * 4 + t) * 64 + lane));
        }
        __builtin_amdgcn_sched_barrier(0);
#pragma unroll
        for (int t = 0; t < 4; ++t) {
            f32x4 a = (f32x4){0.f, 0.f, 0.f, 0.f};
#pragma unroll
            for (int pp = 0; pp < 4; ++pp) a = mfma16(sb[t][pp], qg[pp], a);
#pragma unroll
            for (int q = 0; q < 2; ++q) a = mfma16(vn[t][q], qk[q], a);
            acc[g * 4 + t] = a;
            ss += a[0] * a[0] + a[1] * a[1] + a[2] * a[2] + a[3] * a[3];
        }
        __builtin_amdgcn_sched_barrier(0);
    }
    ss += __shfl_xor(ss, 16);
    ss += __shfl_xor(ss, 32);
    const float rinv = rsqrtf(ss * (1.f / 128.f) + NORM_EPS);
#pragma unroll
    for (int nt = 0; nt < 8; ++nt) {
        const int v0 = nt * 16 + fq * 4;
        const float4 g = *(const float4*)(p.onorm_g + l * 128 + v0);
        const uint2 z = zz[nt];
        const float y0 = acc[nt][0] * rinv * g.x * lo_bf(z.x), y1 = acc[nt][1] * rinv * g.y * hi_bf(z.x);
        const float y2 = acc[nt][2] * rinv * g.z * lo_bf(z.y), y3 = acc[nt][3] * rinv * g.w * hi_bf(z.y);
        *(uint2*)(YB + tok * 1024 + h * 128 + v0) = make_uint2(pack2(y0, y1), pack2(y2, y3));
    }
}

constexpr int N_GMLP_P = NB * 16 * 8;
constexpr int N_GDN_S = DBT * 8;
constexpr int N_GMLP_S = DBT;
constexpr int N_CONV = NB + DBT;
constexpr int N_OTHER = N_GMLP_P + N_GDN_S + N_GMLP_S + N_CONV;

__device__ __forceinline__ void other_item(const Params& p, int l, int it, char* smem) {
    if (it < N_GMLP_P) gmlp_prompt_item(p, l, it, smem);
    else if (it < N_GMLP_P + N_GDN_S) gdn_sample_item(p, l, it - N_GMLP_P, smem);
    else if (it < N_GMLP_P + N_GDN_S + N_GMLP_S) gmlp_sample_item(p, l, it - N_GMLP_P - N_GDN_S, smem);
    else conv_state_item(p, l, it - N_GMLP_P - N_GDN_S - N_GMLP_S);
}

__device__ __forceinline__ void phase_mixb(const Params& p, int l, char* smem) {
    const int G = gridDim.x;
    if (G >= 128) {
        if (blockIdx.x < 64) gdn_scan_item(p, l, blockIdx.x, smem);
        else for (int it = blockIdx.x - 64; it < N_OTHER; it += G - 64) other_item(p, l, it, smem);
    } else {
        for (int it = blockIdx.x; it < 64; it += G) gdn_scan_item(p, l, it, smem);
        for (int it = blockIdx.x; it < N_OTHER; it += G) other_item(p, l, it, smem);
    }
}

#define FRESH(q) const Params& q = p
#define XB_TMO      128
#define XB_XCNT(j)  (256  + 64 * (j))
#define XB_XSUB(j)  (1280 + 64 * (j))
#define XB_XGEN(j)  (2304 + 64 * (j))
#define XB_TOP      3328
#define XB_TOPGEN   3392
#define XCD_BAR_WORDS 3456
#define XB_SPIN_CAP (1u << 22)
#define LAS __attribute__((address_space(3)))
__device__ __forceinline__ unsigned xb_ld(unsigned* p) { return __hip_atomic_load(p, __ATOMIC_RELAXED, __HIP_MEMORY_SCOPE_AGENT); }
__device__ __forceinline__ unsigned xb_add(unsigned* p, unsigned v) { return __hip_atomic_fetch_add(p, v, __ATOMIC_RELAXED, __HIP_MEMORY_SCOPE_AGENT); }
__device__ __forceinline__ unsigned xb_xcc_id() { return (unsigned)__builtin_amdgcn_s_getreg((3 << 11) | 20) & 0xFu; }
#define XB_SPIN(cond, bar) do { unsigned _sp = 0; while (cond) { __builtin_amdgcn_s_sleep(1); \
    if ((++_sp & 255u) == 0u) { if (xb_ld(&(bar)[XB_TMO])) break; if (_sp > XB_SPIN_CAP) { atomicAdd(&(bar)[XB_TMO], 1u); break; } } } } while (0)
struct XcdBarrier { unsigned* bar; unsigned x; volatile LAS unsigned* st; };
__device__ __forceinline__ XcdBarrier xcd_barrier_post(unsigned* bar, volatile LAS unsigned* st) {
    XcdBarrier b; b.bar = bar; b.x = xb_xcc_id(); b.st = st;
    if (threadIdx.x == 0) (void)xb_add(&bar[XB_XCNT(b.x)], 1u);
    return b;
}
__device__ __forceinline__ void xcd_barrier_complete(unsigned* bar, unsigned x, unsigned& nloc, unsigned& nx) {
    const unsigned G = gridDim.x * gridDim.y * gridDim.z;
    unsigned sum, cnt, mine, sp = 0u;
    for (;;) {
        sum = 0u; cnt = 0u; mine = 0u;
#pragma unroll
        for (unsigned j = 0; j < 16; ++j) { const unsigned c = xb_ld(&bar[XB_XCNT(j)]); sum += c; cnt += (c > 0u) ? 1u : 0u; mine = (j == x) ? c : mine; }
        if (sum == G) break;
        __builtin_amdgcn_s_sleep(1);
        if ((++sp & 255u) == 0u) { if (xb_ld(&bar[XB_TMO])) break; if (sp > XB_SPIN_CAP) { atomicAdd(&bar[XB_TMO], 1u); break; } }
    }
    nloc = mine > 0u ? mine : 1u; nx = cnt > 0u ? cnt : 1u;
}
__device__ __forceinline__ void xcd_barrier(const XcdBarrier& b) {
    asm volatile("s_waitcnt vmcnt(0)" ::: "memory");
    __syncthreads();
    if (threadIdx.x == 0) {
        unsigned* bar = b.bar;
        __builtin_amdgcn_s_waitcnt(0);
        unsigned nloc = b.st[0], nx = b.st[1];
        if (nloc == 0u) { xcd_barrier_complete(bar, b.x, nloc, nx); b.st[0] = nloc; b.st[1] = nx; }
        const unsigned old = xb_add(&bar[XB_XSUB(b.x)], 1u);
        const unsigned gen = old / nloc;
        if (old + 1u == (gen + 1u) * nloc) {
            __builtin_amdgcn_fence(__ATOMIC_RELEASE, "agent");
            asm volatile("s_waitcnt vmcnt(0)" ::: "memory");
            const unsigned og = xb_add(&bar[XB_TOP], 1u);
            const unsigned tg = og / nx;
            if (og + 1u == (tg + 1u) * nx) xb_add(&bar[XB_TOPGEN], 1u);
            else XB_SPIN(xb_ld(&bar[XB_TOPGEN]) == tg, bar);
            __builtin_amdgcn_fence(__ATOMIC_ACQUIRE, "agent");
            xb_add(&bar[XB_XGEN(b.x)], 1u);
            asm volatile("s_waitcnt vmcnt(0)" ::: "memory");
        } else {
            XB_SPIN(xb_ld(&bar[XB_XGEN(b.x)]) == gen, bar);
            __builtin_amdgcn_fence(__ATOMIC_ACQUIRE, "agent");
            asm volatile("s_waitcnt vmcnt(0)" ::: "memory");
        }
    }
    __syncthreads();
}

__global__ void __launch_bounds__(256, 2) fwd_megakernel(Params p) {
    extern __shared__ __attribute__((aligned(16))) char smem[];
    __shared__ uint4 xb_words;
    cg::grid_group grid = cg::this_grid();
    unsigned* bar = (unsigned*)(p.ws + OFF_BAR);
    if (blockIdx.x == 0) for (int i = threadIdx.x; i < XCD_BAR_WORDS; i += 256) __hip_atomic_store(bar + i, 0u, __ATOMIC_RELAXED, __HIP_MEMORY_SCOPE_AGENT);
    if (threadIdx.x == 0) xb_words = make_uint4(0u, 0u, 0u, 0u);
    { FRESH(q); phase0(q, smem); }
    grid.sync();
    const XcdBarrier xb = xcd_barrier_post(bar, (volatile LAS unsigned*)&xb_words);
#define GBAR() xcd_barrier(xb)
    for (int l = 0; l < DEPTH; ++l) {
        { FRESH(q); phase_rows(q, l); }
        GBAR();
        { FRESH(q); phase_inproj256(q, l, smem); }
        GBAR();
        { FRESH(q); for (int it = blockIdx.x; it < NCHK; it += gridDim.x) gdn_prep_item(q, l, it, smem); }
        GBAR();
        { FRESH(q); phase_mixb(q, l, smem); }
        GBAR();
        { FRESH(q); for (int it = blockIdx.x; it < NCHK; it += gridDim.x) gdn_out_item(q, l, it); }
        GBAR();
        { FRESH(q); phase_merge(q, l, smem); }
        GBAR();
        { FRESH(q); phase_outproj(q, l, smem); }
        GBAR();
    }
    { FRESH(q); phase_rows(q, DEPTH); }
}

extern "C" void kernel_launch(void* const* d_in, const int* in_sizes, int n_in, void* d_out, int out_size, void* d_ws, size_t ws_size,
                              hipStream_t stream) {
    static int grid_blocks = 0;
    if (!grid_blocks) {
        int dev = 0, cus = 0, per_cu = 0;
        hipGetDevice(&dev);
        hipDeviceGetAttribute(&cus, hipDeviceAttributeMultiprocessorCount, dev);
        hipFuncSetAttribute((const void*)fwd_megakernel, hipFuncAttributeMaxDynamicSharedMemorySize, SMEM_BYTES);
        hipOccupancyMaxActiveBlocksPerMultiprocessor(&per_cu, fwd_megakernel, 256, SMEM_BYTES);
        if (per_cu > 2) per_cu = 2;
        if (per_cu < 1) per_cu = 1;
        grid_blocks = cus * per_cu;
    }
    if (ws_size < WS_NEED) {
        fprintf(stderr, "workspace too small: %zu < %zu\n", ws_size, (size_t)WS_NEED);
        return;
    }
    Params p{};
    const float** f = (const float**)&p;
    for (int i = 0; i < 22; ++i) f[i] = (const float*)d_in[i];
    p.out = (float*)d_out;
    p.ws = (char*)d_ws;
    void* args[] = {&p};
    hipError_t e = hipLaunchCooperativeKernel((const void*)fwd_megakernel, dim3(grid_blocks), dim3(256), args, SMEM_BYTES, stream);
    if (e != hipSuccess) fprintf(stderr, "cooperative launch failed: %s (grid %d)\n", hipGetErrorString(e), grid_blocks);
}
```

```cpp
#include <hip/hip_runtime.h>
#include <hip/hip_cooperative_groups.h>
#include <cstdio>
namespace cg = cooperative_groups;

typedef unsigned short bf16_t;
typedef short bf16x8 __attribute__((ext_vector_type(8)));
typedef float f32x4 __attribute__((ext_vector_type(4)));
typedef unsigned u32x4 __attribute__((ext_vector_type(4)));

constexpr int D = 1024;
constexpr int NB = 8, SEQ = 2048, DEPTH = 4, DBT = 128, DSQ = 4;
constexpr int TP = NB * SEQ;
constexpr int TS = DBT * DSQ;
constexpr int T = TP + TS;
constexpr int PIN = 9232;
constexpr int PC = 9216;
constexpr int NPAD = 9344;
constexpr int NROWB = NB + DBT;
constexpr float ALPHA_DN = 1.681792830507429f;
constexpr float LN_EPS = 1e-5f, NORM_EPS = 1e-6f;
constexpr int C_UA = 0, C_VA = 1024, C_ZA = 2048, C_Q = 3072, C_ZB = 6144, C_GA = 7168, C_GB = 8192;

constexpr size_t O_Y_P = 0, O_Y_S = 16777216, O_CONV_P = 17301504, O_SSM_P = 17596416, O_CV_P = 21790720,
                 O_CONV_S = 25985024, O_SSM_S = 30703616, O_CV_S = 97812480;

constexpr size_t SZ_WT_IN = (size_t)DEPTH * NPAD * 1024 * 2;
constexpr size_t SZ_WT_SQ = (size_t)DEPTH * 1024 * 1024 * 2;
constexpr size_t OFF_WT_IN = 0;
constexpr size_t OFF_WT_PA = OFF_WT_IN + SZ_WT_IN;
constexpr size_t OFF_WT_PB = OFF_WT_PA + SZ_WT_SQ;
constexpr size_t OFF_WT_O = OFF_WT_PB + SZ_WT_SQ;
constexpr size_t OFF_MOD = OFF_WT_O + SZ_WT_SQ;
constexpr size_t OFF_X = OFF_MOD + (size_t)DEPTH * NROWB * 3072 * 4;
constexpr size_t OFF_TT = OFF_X + (size_t)T * 1024 * 4;
constexpr size_t OFF_H = OFF_TT + (size_t)T * 1024 * 4;
constexpr size_t OFF_YA = OFF_H + (size_t)T * 1024 * 2;
constexpr size_t OFF_YB = OFF_YA + (size_t)T * 1024 * 2;
constexpr size_t OFF_MM = OFF_YB + (size_t)T * 1024 * 2;
constexpr size_t OFF_P = OFF_MM + (size_t)T * 1024 * 2;
constexpr size_t OFF_BETA = OFF_P + (size_t)T * PC * 2;
constexpr size_t OFF_GLOG = OFF_BETA + (size_t)T * 8 * 4;
constexpr int NCHK = 2048;
constexpr size_t OFF_U = OFF_GLOG + (size_t)T * 8 * 4;
constexpr size_t OFF_WG = OFF_U + (size_t)NCHK * 8192 * 4;
constexpr size_t OFF_QG = OFF_WG + (size_t)NCHK * 8192 * 2;
constexpr size_t OFF_KDT = OFF_QG + (size_t)NCHK * 8192 * 2;
constexpr size_t OFF_QK = OFF_KDT + (size_t)NCHK * 8192 * 2;
constexpr size_t OFF_EG = OFF_QK + (size_t)NCHK * 4096 * 2;
constexpr size_t OFF_SB = OFF_EG + (size_t)NCHK * 4;
constexpr size_t OFF_VN = OFF_SB + (size_t)NCHK * 16384 * 2;
constexpr size_t OFF_PARK = OFF_VN + (size_t)NCHK * 8192 * 2;
constexpr size_t OFF_STATS = OFF_PARK + (size_t)1024 * 32768;
constexpr size_t OFF_BAR = OFF_STATS + (size_t)T * 2 * 4;
constexpr size_t WS_NEED = OFF_BAR + 16384;

constexpr int SMEM_BYTES = 73728;
constexpr int TILE_BYTES = 128 * 128;

struct Params {
    const float *x_prompt, *x_sample, *state_conv, *state_ssm, *c_prompt, *c_sample, *w_ada, *b_ada, *w_in, *w_s, *b_s,
        *lnv_g, *lnv_b, *conv_w, *a_log, *dt_bias, *onorm_g, *w_pa, *w_pb, *w_o, *ln_g, *ln_b;
    float* out;
    char* ws;
};

__device__ __forceinline__ unsigned pack2(float a, float b) {
    unsigned r;
    asm("v_cvt_pk_bf16_f32 %0, %1, %2" : "=v"(r) : "v"(a), "v"(b));
    return r;
}
__device__ __forceinline__ bf16_t f2bf(float f) { return (bf16_t)(pack2(f, 0.f) & 0xffffu); }
__device__ __forceinline__ float bf2f(bf16_t h) { return __uint_as_float(((unsigned)h) << 16); }
__device__ __forceinline__ float lo_bf(unsigned u) { return __uint_as_float(u << 16); }
__device__ __forceinline__ float hi_bf(unsigned u) { return __uint_as_float(u & 0xffff0000u); }
__device__ __forceinline__ float sigmoid_f(float x) { return __builtin_amdgcn_rcpf(1.f + __builtin_amdgcn_exp2f(-1.4426950408889634f * x)); }
__device__ __forceinline__ float silu_f(float x) { return x * sigmoid_f(x); }
__device__ __forceinline__ float gelu_f(float x) {
    const float y2 = x * (1.5957691216057308f + 0.0713548162726f * x * x);
    return x * __builtin_amdgcn_rcpf(1.f + __builtin_amdgcn_exp2f(-1.4426950408889634f * y2));
}
__device__ __forceinline__ float softplus_f(float x) { return fmaxf(x, 0.f) + log1pf(__expf(-fabsf(x))); }
__device__ __forceinline__ float wave_sum(float v) {
#pragma unroll
    for (int o = 32; o >= 1; o >>= 1) v += __shfl_xor(v, o);
    return v;
}
__device__ __forceinline__ f32x4 mfma16(bf16x8 a, bf16x8 b, f32x4 c) { return __builtin_amdgcn_mfma_f32_16x16x32_bf16(a, b, c, 0, 0, 0); }
template <class Tp> __device__ __forceinline__ Tp ldg_b(const void* base, unsigned boff) { return *(const Tp*)((const char*)base + boff); }
template <class Tp> __device__ __forceinline__ void stg_b(void* base, unsigned boff, Tp v) { *(Tp*)((char*)base + boff) = v; }
__host__ __device__ constexpr int perm32(int k) { return (k & ~31) | (((k >> 2) & 3) << 3) | (((k >> 4) & 1) << 2) | (k & 3); }
__device__ __forceinline__ int opaque_tid() { int t = threadIdx.x; asm volatile("" : "+v"(t)); return t; }
__device__ __forceinline__ int opaque_zero() { int z = 0; asm volatile("" : "+v"(z)); return z; }
__device__ __forceinline__ int cond_row(int row) { return row < TP ? (row >> 11) : (NB + ((row - TP) >> 2)); }

template <int WGM = 8>
__device__ __forceinline__ void tile_map(int L, int ntiles, int nM, int nN, int& tm, int& tn) {
    const int q = ntiles / 8, r = ntiles % 8, xcd = L % 8, off = L / 8;
    const int g = (xcd < r ? xcd * (q + 1) : r * (q + 1) + (xcd - r) * q) + off;
    const int nig = WGM * nN, gid = g / nig, fm = gid * WGM, gsz = (nM - fm) < WGM ? (nM - fm) : WGM;
    tm = fm + (g % nig) % gsz;
    tn = (g % nig) / gsz;
}

template <int MT>
__device__ __forceinline__ void gemm_core(const bf16_t* __restrict__ A, const bf16_t* __restrict__ B, const int K,
                                          f32x4 (&acc)[MT][4], char* smem, const int tid) {
    const int lane = tid & 63, wid = tid >> 6, wr = wid >> 1, wc = wid & 1;
    const int srow = tid >> 3, sseg = (tid & 7) ^ ((tid >> 3) & 7);
    const bf16_t* ag = A + (size_t)srow * K + sseg * 8;
    const bf16_t* bg = B + (size_t)srow * K + sseg * 8;
    const int nk = K >> 6;
#define STAGE(BUF, KT) do { char* d_ = smem + (BUF) * 2 * TILE_BYTES + tid * 16; \
        _Pragma("unroll") for (int i = 0; i < MT; ++i) __builtin_amdgcn_global_load_lds((const unsigned*)(ag + (size_t)(32 * i) * K + (KT) * 64), (__attribute__((address_space(3))) unsigned*)(d_ + i * 4096), 16, 0, 0); \
        _Pragma("unroll") for (int i = 0; i < 4; ++i) __builtin_amdgcn_global_load_lds((const unsigned*)(bg + (size_t)(32 * i) * K + (KT) * 64), (__attribute__((address_space(3))) unsigned*)(d_ + TILE_BYTES + i * 4096), 16, 0, 0); } while (0)
#define COMPUTE(BUF) do { const char* cur = smem + (BUF) * 2 * TILE_BYTES; _Pragma("unroll") for (int kk = 0; kk < 2; ++kk) { \
        bf16x8 af[MT], bfr[4]; const int ko = kk ? kx1 : kx0; \
        _Pragma("unroll") for (int m = 0; m < MT; ++m) af[m] = *(const bf16x8*)(cur + aoff + m * 16 * 128 + ko); \
        _Pragma("unroll") for (int n = 0; n < 4; ++n) bfr[n] = *(const bf16x8*)(cur + boff + n * 16 * 128 + ko); \
        _Pragma("unroll") for (int m = 0; m < MT; ++m) _Pragma("unroll") for (int n = 0; n < 4; ++n) acc[m][n] = mfma16(bfr[n], af[m], acc[m][n]); } } while (0)
    const int fr = lane & 15, fq = lane >> 4;
    const int aoff = (wr * 16 * MT + fr) * 128;
    const int boff = TILE_BYTES + (wc * 64 + fr) * 128;
    const int kx0 = (fq ^ (fr & 7)) << 4, kx1 = ((4 + fq) ^ (fr & 7)) << 4;
    __syncthreads();
    STAGE(0, 0);
    asm volatile("s_waitcnt vmcnt(0)" ::: "memory");
    __syncthreads();
    for (int kt = 0; kt < nk; ++kt) {
        if (kt + 1 < nk) STAGE((kt + 1) & 1, kt + 1);
        COMPUTE(kt & 1);
        asm volatile("s_waitcnt vmcnt(0)" ::: "memory");
        __syncthreads();
    }
#undef STAGE
#undef COMPUTE
}

__device__ __forceinline__ int win_src_col(int np) {
    if (np < 7168) return np;
    if (np < 9216) return np + 16;
    if (np < 9232) return np - 9216 + 7168;
    return -1;
}
__device__ __forceinline__ void transpose_item(const float* __restrict__ src, int ld, bool is_win, bf16_t* __restrict__ dst, int kt, int nt, char* smem) {
    smem += opaque_zero();
    float* tile = (float*)smem;
    const int tid = opaque_tid();
    __syncthreads();
    const int nn = tid & 63, kq = tid >> 6;
    const int np = nt * 64 + nn;
    const int oc = is_win ? win_src_col(np) : np;
#pragma unroll
    for (int i = 0; i < 16; ++i) {
        const int kk = kq + 4 * i;
        tile[kk * 65 + nn] = oc >= 0 ? src[(size_t)(kt * 64 + kk) * ld + oc] : 0.f;
    }
    __syncthreads();
    const int r = tid >> 2, seg = tid & 3;
    unsigned pk[8];
#pragma unroll
    for (int j = 0; j < 8; ++j) pk[j] = pack2(tile[(seg * 16 + 2 * j) * 65 + r], tile[(seg * 16 + 2 * j + 1) * 65 + r]);
    uint4* d = (uint4*)(dst + (size_t)(nt * 64 + r) * 1024 + kt * 64 + seg * 16);
    d[0] = make_uint4(pk[0], pk[1], pk[2], pk[3]);
    d[1] = make_uint4(pk[4], pk[5], pk[6], pk[7]);
}

__device__ __forceinline__ void mod_item(const Params& p, int it, char* smem) {
    smem += opaque_zero();
    float* sc = (float*)smem;
    const int tid = opaque_tid();
    const int rg = it & 7, cb = (it >> 3) % 12, l = it / 96;
    __syncthreads();
    for (int idx = tid; idx < 17 * 1024; idx += 256) {
        const int r = idx >> 10, k = idx & 1023, row = rg * 17 + r;
        const float c = row < NB ? p.c_prompt[row * 1024 + k] : p.c_sample[(row - NB) * 1024 + k];
        sc[idx] = silu_f(c);
    }
    __syncthreads();
    const int col = cb * 256 + tid;
    float acc[17];
#pragma unroll
    for (int r = 0; r < 17; ++r) acc[r] = 0.f;
    const float* wp = p.w_ada + (size_t)l * 1024 * 3072 + col;
    for (int k = 0; k < 1024; k += 4) {
        const float w0 = wp[(size_t)(k + 0) * 3072], w1 = wp[(size_t)(k + 1) * 3072], w2 = wp[(size_t)(k + 2) * 3072], w3 = wp[(size_t)(k + 3) * 3072];
#pragma unroll
        for (int r = 0; r < 17; ++r) {
            const float4 s = *(const float4*)&sc[r * 1024 + k];
            acc[r] += s.x * w0 + s.y * w1 + s.z * w2 + s.w * w3;
        }
    }
    float* mod = (float*)(p.ws + OFF_MOD);
    const float bb = p.b_ada[l * 3072 + col];
#pragma unroll
    for (int r = 0; r < 17; ++r) mod[((size_t)l * NROWB + rg * 17 + r) * 3072 + col] = acc[r] + bb;
}

constexpr int N_TR_IN = (NPAD / 64) * 16;
constexpr int N_TR_SQ = 16 * 16;
constexpr int N_TR_LAYER = N_TR_IN + 3 * N_TR_SQ;
constexpr int N_P0_TR = DEPTH * N_TR_LAYER;
constexpr int N_P0_MOD = DEPTH * 12 * 8;

__device__ __forceinline__ void phase0(const Params& p, char* smem) {
    for (int it = blockIdx.x; it < N_P0_TR + N_P0_MOD; it += gridDim.x) {
        if (it < N_P0_TR) {
            const int l = it / N_TR_LAYER;
            int r = it % N_TR_LAYER;
            if (r < N_TR_IN) {
                transpose_item(p.w_in + (size_t)l * 1024 * PIN, PIN, true, (bf16_t*)(p.ws + OFF_WT_IN) + (size_t)l * NPAD * 1024, r & 15, r >> 4, smem);
            } else {
                r -= N_TR_IN;
                const int which = r / N_TR_SQ;
                r %= N_TR_SQ;
                const float* src = (which == 0 ? p.w_pa : which == 1 ? p.w_pb : p.w_o) + (size_t)l * 1024 * 1024;
                bf16_t* dst = (bf16_t*)(p.ws + (which == 0 ? OFF_WT_PA : which == 1 ? OFF_WT_PB : OFF_WT_O)) + (size_t)l * 1024 * 1024;
                transpose_item(src, 1024, false, dst, r & 15, r >> 4, smem);
            }
        } else {
            mod_item(p, it - N_P0_TR, smem);
        }
    }
}

__device__ __forceinline__ void phase_rows(const Params& p, int l) {
    const int tid = opaque_tid();
    const int lane = tid & 63;
    const int gw = blockIdx.x * 4 + (tid >> 6), nw = gridDim.x * 4;
    float* X = (float*)(p.ws + OFF_X);
    const float* TT = (const float*)(p.ws + OFF_TT);
    bf16_t* H = (bf16_t*)(p.ws + OFF_H);
    const float* mod = (const float*)(p.ws + OFF_MOD);
    for (int row = gw; row < T; row += nw) {
        float v[16];
        if (l == 0) {
            const float* src = row < TP ? p.x_prompt + (size_t)row * 1024 : p.x_sample + (size_t)(row - TP) * 1024;
#pragma unroll
            for (int j = 0; j < 4; ++j) {
                const float4 t = *(const float4*)(src + j * 256 + lane * 4);
                v[j * 4 + 0] = t.x; v[j * 4 + 1] = t.y; v[j * 4 + 2] = t.z; v[j * 4 + 3] = t.w;
            }
        } else {
            const float* src = TT + (size_t)row * 1024;
            float s = 0.f;
#pragma unroll
            for (int j = 0; j < 4; ++j) {
                const float4 t = *(const float4*)(src + j * 256 + lane * 4);
                v[j * 4 + 0] = t.x; v[j * 4 + 1] = t.y; v[j * 4 + 2] = t.z; v[j * 4 + 3] = t.w;
                s += t.x + t.y + t.z + t.w;
            }
            const float mean = wave_sum(s) * (1.f / 1024.f);
            float q = 0.f;
#pragma unroll
            for (int e = 0; e < 16; ++e) { v[e] -= mean; q += v[e] * v[e]; }
            const float rstd = rsqrtf(wave_sum(q) * (1.f / 1024.f) + LN_EPS);
            const float* g = p.ln_g + (l - 1) * 1024;
            const float* bb = p.ln_b + (l - 1) * 1024;
#pragma unroll
            for (int j = 0; j < 4; ++j) {
                const float4 gg = *(const float4*)(g + j * 256 + lane * 4);
                const float4 be = *(const float4*)(bb + j * 256 + lane * 4);
                v[j * 4 + 0] = v[j * 4 + 0] * rstd * gg.x + be.x;
                v[j * 4 + 1] = v[j * 4 + 1] * rstd * gg.y + be.y;
                v[j * 4 + 2] = v[j * 4 + 2] * rstd * gg.z + be.z;
                v[j * 4 + 3] = v[j * 4 + 3] * rstd * gg.w + be.w;
            }
        }
        if (l == DEPTH) {
            float* dst = row < TP ? p.out + O_Y_P + (size_t)row * 1024 : p.out + O_Y_S + (size_t)(row - TP) * 1024;
#pragma unroll
            for (int j = 0; j < 4; ++j) *(float4*)(dst + j * 256 + lane * 4) = make_float4(v[j * 4], v[j * 4 + 1], v[j * 4 + 2], v[j * 4 + 3]);
            continue;
        }
        if (lane == 0) *(float2*)((float*)(p.ws + OFF_STATS) + (size_t)row * 2) = make_float2(0.f, 0.f);
        {
            float* dst = X + (size_t)row * 1024;
            float s = 0.f;
#pragma unroll
            for (int j = 0; j < 4; ++j) {
                *(float4*)(dst + j * 256 + lane * 4) = make_float4(v[j * 4], v[j * 4 + 1], v[j * 4 + 2], v[j * 4 + 3]);
                s += v[j * 4] + v[j * 4 + 1] + v[j * 4 + 2] + v[j * 4 + 3];
            }
            const float mean = wave_sum(s) * (1.f / 1024.f);
            float q = 0.f;
#pragma unroll
            for (int e = 0; e < 16; ++e) { v[e] -= mean; q += v[e] * v[e]; }
            const float rstd = rsqrtf(wave_sum(q) * (1.f / 1024.f) + LN_EPS);
            const float* mrow = mod + ((size_t)l * NROWB + cond_row(row)) * 3072;
#pragma unroll
            for (int j = 0; j < 4; ++j) {
                const float4 sh = *(const float4*)(mrow + j * 256 + lane * 4);
                const float4 scl = *(const float4*)(mrow + 1024 + j * 256 + lane * 4);
                const float h0 = v[j * 4 + 0] * rstd * (1.f + scl.x) + sh.x;
                const float h1 = v[j * 4 + 1] * rstd * (1.f + scl.y) + sh.y;
                const float h2 = v[j * 4 + 2] * rstd * (1.f + scl.z) + sh.z;
                const float h3 = v[j * 4 + 3] * rstd * (1.f + scl.w) + sh.w;
                *(uint2*)(H + (size_t)row * 1024 + j * 256 + lane * 4) = make_uint2(pack2(h0, h1), pack2(h2, h3));
            }
        }
    }
}

__device__ __forceinline__ void phase_inproj(const Params& p, int l, char* smem) {
    const bf16_t* H = (const bf16_t*)(p.ws + OFF_H);
    const bf16_t* Wt = (const bf16_t*)(p.ws + OFF_WT_IN) + (size_t)l * NPAD * 1024;
    bf16_t* P = (bf16_t*)(p.ws + OFF_P);
    float* BETA = (float*)(p.ws + OFF_BETA);
    float* GLOG = (float*)(p.ws + OFF_GLOG);
    constexpr int nM = T / 128, nN = NPAD / 128, ntiles = nM * nN;
    for (int L = blockIdx.x; L < ntiles; L += gridDim.x) {
        const int tid = opaque_tid();
        const int lane = tid & 63, wid = tid >> 6, wr = wid >> 1, wc = wid & 1, fr = lane & 15, fq = lane >> 4;
        int tm, tn;
        tile_map(L, ntiles, nM, nN, tm, tn);
        f32x4 acc[4][4];
#pragma unroll
        for (int m = 0; m < 4; ++m)
#pragma unroll
            for (int n = 0; n < 4; ++n) acc[m][n] = (f32x4){0.f, 0.f, 0.f, 0.f};
        gemm_core<4>(H + (size_t)tm * 128 * 1024, Wt + (size_t)tn * 128 * 1024, 1024, acc, smem, tid);
        if (tn == 72) {
            if (wc == 0) {
#pragma unroll
                for (int m = 0; m < 4; ++m) {
                    const int row = tm * 128 + wr * 64 + m * 16 + fr;
#pragma unroll
                    for (int r = 0; r < 4; ++r) {
                        const float a = acc[m][0][r];
                        if (fq < 2) {
                            BETA[(size_t)row * 8 + fq * 4 + r] = sigmoid_f(a);
                        } else {
                            const int h = (fq - 2) * 4 + r;
                            GLOG[(size_t)row * 8 + h] = -__expf(p.a_log[l * 8 + h]) * softplus_f(a + p.dt_bias[l * 8 + h]);
                        }
                    }
                }
            }
        } else {
            const int kind = tn < 16 ? 0 : tn < 24 ? 1 : tn < 48 ? 2 : tn < 56 ? 1 : 3;
            char* st = smem + opaque_zero();
#pragma unroll
            for (int m = 0; m < 4; ++m) {
                const int rl = wr * 64 + m * 16 + fr;
#pragma unroll
                for (int n = 0; n < 4; ++n) {
                    const int cl = wc * 64 + n * 16 + fq * 4;
                    float a[4];
#pragma unroll
                    for (int r = 0; r < 4; ++r) {
                        const float x = acc[m][n][r];
                        a[r] = kind == 0 ? gelu_f(x) : kind == 1 ? silu_f(x) : kind == 2 ? x : sigmoid_f(x);
                    }
                    *(uint2*)(st + rl * 272 + cl * 2) = make_uint2(pack2(a[0], a[1]), pack2(a[2], a[3]));
                }
            }
            __syncthreads();
#pragma unroll
            for (int i = 0; i < 8; ++i) {
                const int rl = (tid >> 4) + 16 * i, sg = tid & 15;
                const u32x4 v = *(const u32x4*)(st + rl * 272 + sg * 16);
                *(u32x4*)(P + (size_t)(tm * 128 + rl) * PC + tn * 128 + sg * 8) = v;
                if (tn >= 8 && tn < 16) {
                    const float a0 = lo_bf(v[0]), a1 = hi_bf(v[0]), a2 = lo_bf(v[1]), a3 = hi_bf(v[1]), a4 = lo_bf(v[2]), a5 = hi_bf(v[2]), a6 = lo_bf(v[3]), a7 = hi_bf(v[3]);
                    float sm = ((a0 + a1) + (a2 + a3)) + ((a4 + a5) + (a6 + a7));
                    float sq = ((a0 * a0 + a1 * a1) + (a2 * a2 + a3 * a3)) + ((a4 * a4 + a5 * a5) + (a6 * a6 + a7 * a7));
#pragma unroll
                    for (int o = 1; o < 16; o <<= 1) { sm += __shfl_xor(sm, o); sq += __shfl_xor(sq, o); }
                    if (sg == 0) {
                        float* stp = (float*)(p.ws + OFF_STATS) + (size_t)(tm * 128 + rl) * 2;
                        atomicAdd(stp, sm);
                        atomicAdd(stp + 1, sq);
                    }
                }
            }
        }
    }
}

constexpr int T2_A = 256 * 64, T2_B = 128 * 64, T2_STAGE = T2_A + T2_B;
__device__ __forceinline__ void gemm_core256(const bf16_t* __restrict__ A, const bf16_t* __restrict__ B, const int K,
                                             f32x4 (&acc)[8][4], char* smem, const int tid) {
    const int lane = tid & 63, wid = tid >> 6, wr = wid >> 1, wc = wid & 1, fr = lane & 15, fq = lane >> 4;
    const int srow = tid >> 2, sseg = (tid & 3) ^ ((tid >> 3) & 3);
    const bf16_t* ag = A + (size_t)srow * K + sseg * 8;
    const bf16_t* bg = B + (size_t)srow * K + sseg * 8;
    const int sw = (fq ^ ((fr >> 1) & 3)) << 4;
    const int aoff = (wr * 128 + fr) * 64 + sw;
    const int boff = T2_A + (wc * 64 + fr) * 64 + sw;
    const int nk = K >> 5;
#define STAGE2(BUF, KT) do { char* d_ = smem + (BUF) * T2_STAGE + tid * 16; \
        _Pragma("unroll") for (int i = 0; i < 4; ++i) __builtin_amdgcn_global_load_lds((const unsigned*)(ag + (size_t)(64 * i) * K + (KT) * 32), (__attribute__((address_space(3))) unsigned*)(d_ + i * 4096), 16, 0, 0); \
        _Pragma("unroll") for (int i = 0; i < 2; ++i) __builtin_amdgcn_global_load_lds((const unsigned*)(bg + (size_t)(64 * i) * K + (KT) * 32), (__attribute__((address_space(3))) unsigned*)(d_ + T2_A + i * 4096), 16, 0, 0); } while (0)
    __syncthreads();
    STAGE2(0, 0);
    STAGE2(1, 1);
    asm volatile("s_waitcnt vmcnt(6)" ::: "memory");
    __builtin_amdgcn_s_barrier();
    asm volatile("" ::: "memory");
    int cb = 0, nb = 2;
    for (int kt = 0; kt < nk; ++kt) {
        if (kt + 2 < nk) STAGE2(nb, kt + 2);
        const char* cur = smem + cb * T2_STAGE;
        bf16x8 bfr[4], af[8];
#pragma unroll
        for (int n = 0; n < 4; ++n) bfr[n] = *(const bf16x8*)(cur + boff + n * 16 * 64);
#pragma unroll
        for (int m = 0; m < 8; ++m) af[m] = *(const bf16x8*)(cur + aoff + m * 16 * 64);
        __builtin_amdgcn_sched_barrier(0);
#pragma unroll
        for (int m = 0; m < 8; ++m)
#pragma unroll
            for (int n = 0; n < 4; ++n) acc[m][n] = mfma16(bfr[n], af[m], acc[m][n]);
        if (kt + 2 < nk) asm volatile("s_waitcnt vmcnt(6)" ::: "memory");
        else asm volatile("s_waitcnt vmcnt(0)" ::: "memory");
        __builtin_amdgcn_s_barrier();
        asm volatile("" ::: "memory");
        cb = cb == 2 ? 0 : cb + 1;
        nb = nb == 2 ? 0 : nb + 1;
    }
#undef STAGE2
    __syncthreads();
}

__device__ __forceinline__ void phase_inproj256(const Params& p, int l, char* smem) {
    const bf16_t* H = (const bf16_t*)(p.ws + OFF_H);
    const bf16_t* Wt = (const bf16_t*)(p.ws + OFF_WT_IN) + (size_t)l * NPAD * 1024;
    bf16_t* P = (bf16_t*)(p.ws + OFF_P);
    float* BETA = (float*)(p.ws + OFF_BETA);
    float* GLOG = (float*)(p.ws + OFF_GLOG);
    constexpr int nM = T / 256, nN = NPAD / 128, ntiles = nM * nN;
    for (int L = blockIdx.x; L < ntiles; L += gridDim.x) {
        const int tid = opaque_tid();
        const int lane = tid & 63, wid = tid >> 6, wr = wid >> 1, wc = wid & 1, fr = lane & 15, fq = lane >> 4;
        int tm, tn;
        tile_map<4>(L, ntiles, nM, nN, tm, tn);
        f32x4 acc[8][4];
#pragma unroll
        for (int m = 0; m < 8; ++m)
#pragma unroll
            for (int n = 0; n < 4; ++n) acc[m][n] = (f32x4){0.f, 0.f, 0.f, 0.f};
        gemm_core256(H + (size_t)tm * 256 * 1024, Wt + (size_t)tn * 128 * 1024, 1024, acc, smem, tid);
        if (tn == 72) {
            if (wc == 0) {
#pragma unroll
                for (int m = 0; m < 8; ++m) {
                    const int row = tm * 256 + wr * 128 + m * 16 + fr;
#pragma unroll
                    for (int r = 0; r < 4; ++r) {
                        const float a = acc[m][0][r];
                        if (fq < 2) {
                            BETA[(size_t)row * 8 + fq * 4 + r] = sigmoid_f(a);
                        } else {
                            const int h = (fq - 2) * 4 + r;
                            GLOG[(size_t)row * 8 + h] = -__expf(p.a_log[l * 8 + h]) * softplus_f(a + p.dt_bias[l * 8 + h]);
                        }
                    }
                }
            }
        } else {
            const int kind = tn < 16 ? 0 : tn < 24 ? 1 : tn < 48 ? 2 : tn < 56 ? 1 : 3;
            char* st = smem + opaque_zero();
#pragma unroll
            for (int m = 0; m < 8; ++m) {
                const int rl = wr * 128 + m * 16 + fr;
#pragma unroll
                for (int n = 0; n < 4; ++n) {
                    const int cl = wc * 64 + n * 16 + fq * 4;
                    float a[4];
#pragma unroll
                    for (int r = 0; r < 4; ++r) {
                        const float x = acc[m][n][r];
                        a[r] = kind == 0 ? gelu_f(x) : kind == 1 ? silu_f(x) : kind == 2 ? x : sigmoid_f(x);
                    }
                    *(uint2*)(st + rl * 272 + cl * 2) = make_uint2(pack2(a[0], a[1]), pack2(a[2], a[3]));
                }
            }
            __syncthreads();
#pragma unroll 4
            for (int i = 0; i < 16; ++i) {
                const int rl = (tid >> 4) + 16 * i, sg = tid & 15;
                const u32x4 v = *(const u32x4*)(st + rl * 272 + sg * 16);
                *(u32x4*)(P + (size_t)(tm * 256 + rl) * PC + tn * 128 + sg * 8) = v;
                if (tn >= 8 && tn < 16) {
                    const float a0 = lo_bf(v[0]), a1 = hi_bf(v[0]), a2 = lo_bf(v[1]), a3 = hi_bf(v[1]), a4 = lo_bf(v[2]), a5 = hi_bf(v[2]), a6 = lo_bf(v[3]), a7 = hi_bf(v[3]);
                    float sm = ((a0 + a1) + (a2 + a3)) + ((a4 + a5) + (a6 + a7));
                    float sq = ((a0 * a0 + a1 * a1) + (a2 * a2 + a3 * a3)) + ((a4 * a4 + a5 * a5) + (a6 * a6 + a7 * a7));
#pragma unroll
                    for (int o = 1; o < 16; o <<= 1) { sm += __shfl_xor(sm, o); sq += __shfl_xor(sq, o); }
                    if (sg == 0) {
                        float* stp = (float*)(p.ws + OFF_STATS) + (size_t)(tm * 256 + rl) * 2;
                        atomicAdd(stp, sm);
                        atomicAdd(stp + 1, sq);
                    }
                }
            }
        }
    }
}

__device__ __forceinline__ void phase_merge(const Params& p, int l, char* smem) {
    const bf16_t* YA = (const bf16_t*)(p.ws + OFF_YA);
    const bf16_t* YB = (const bf16_t*)(p.ws + OFF_YB);
    const bf16_t* Wa = (const bf16_t*)(p.ws + OFF_WT_PA) + (size_t)l * 1024 * 1024;
    const bf16_t* Wb = (const bf16_t*)(p.ws + OFF_WT_PB) + (size_t)l * 1024 * 1024;
    const bf16_t* P = (const bf16_t*)(p.ws + OFF_P);
    bf16_t* MM = (bf16_t*)(p.ws + OFF_MM);
    constexpr int RT = 96, MT = 3;
    constexpr int nM = T / RT, nN = 8, ntiles = nM * nN;
    for (int L = blockIdx.x; L < ntiles; L += gridDim.x) {
        const int tid = opaque_tid();
        const int lane = tid & 63, wid = tid >> 6, wr = wid >> 1, wc = wid & 1, fr = lane & 15, fq = lane >> 4;
        int tm, tn;
        tile_map(L, ntiles, nM, nN, tm, tn);
        f32x4 acc[MT][4];
#pragma unroll
        for (int m = 0; m < MT; ++m)
#pragma unroll
            for (int n = 0; n < 4; ++n) acc[m][n] = (f32x4){0.f, 0.f, 0.f, 0.f};
        gemm_core<MT>(YA + (size_t)tm * RT * 1024, Wa + (size_t)tn * 128 * 1024, 1024, acc, smem, tid);
        uint2* park = (uint2*)(p.ws + OFF_PARK) + (size_t)blockIdx.x * 4096 + tid;
#pragma unroll
        for (int m = 0; m < MT; ++m) {
            const int row = tm * RT + wr * 16 * MT + m * 16 + fr;
#pragma unroll
            for (int n = 0; n < 4; ++n) {
                const int col = tn * 128 + wc * 64 + n * 16 + fq * 4;
                const uint2 g = *(const uint2*)(P + (size_t)row * PC + C_GA + col);
                park[(m * 4 + n) * 256] = make_uint2(pack2(acc[m][n][0] * lo_bf(g.x), acc[m][n][1] * hi_bf(g.x)),
                                                     pack2(acc[m][n][2] * lo_bf(g.y), acc[m][n][3] * hi_bf(g.y)));
                acc[m][n] = (f32x4){0.f, 0.f, 0.f, 0.f};
            }
            __builtin_amdgcn_sched_barrier(0);
        }
        gemm_core<MT>(YB + (size_t)tm * RT * 1024, Wb + (size_t)tn * 128 * 1024, 1024, acc, smem, tid);
        char* st = smem + opaque_zero();
#pragma unroll
        for (int m = 0; m < MT; ++m) {
            const int rl = wr * 16 * MT + m * 16 + fr;
            const int row = tm * RT + rl;
#pragma unroll
            for (int n = 0; n < 4; ++n) {
                const int cl = wc * 64 + n * 16 + fq * 4;
                const uint2 g = *(const uint2*)(P + (size_t)row * PC + C_GB + tn * 128 + cl);
                const uint2 pm = park[(m * 4 + n) * 256];
                const float a0 = lo_bf(pm.x) + acc[m][n][0] * lo_bf(g.x);
                const float a1 = hi_bf(pm.x) + acc[m][n][1] * hi_bf(g.x);
                const float a2 = lo_bf(pm.y) + acc[m][n][2] * lo_bf(g.y);
                const float a3 = hi_bf(pm.y) + acc[m][n][3] * hi_bf(g.y);
                *(uint2*)(st + rl * 272 + cl * 2) = make_uint2(pack2(a0, a1), pack2(a2, a3));
            }
            __builtin_amdgcn_sched_barrier(0);
        }
        __syncthreads();
#pragma unroll
        for (int i = 0; i < RT / 16; ++i) {
            const int rl = (tid >> 4) + 16 * i, sg = tid & 15;
            const u32x4 v = *(const u32x4*)(st + rl * 272 + sg * 16);
            *(u32x4*)(MM + (size_t)(tm * RT + rl) * 1024 + tn * 128 + sg * 8) = v;
        }
    }
}

__device__ __forceinline__ void phase_outproj(const Params& p, int l, char* smem) {
    const bf16_t* MM = (const bf16_t*)(p.ws + OFF_MM);
    const bf16_t* Wo = (const bf16_t*)(p.ws + OFF_WT_O) + (size_t)l * 1024 * 1024;
    const float* X = (const float*)(p.ws + OFF_X);
    float* TT = (float*)(p.ws + OFF_TT);
    const float* mod = (const float*)(p.ws + OFF_MOD);
    constexpr int RT = 96, MT = 3;
    constexpr int nM = T / RT, nN = 8, ntiles = nM * nN;
    for (int L = blockIdx.x; L < ntiles; L += gridDim.x) {
        const int tid = opaque_tid();
        const int lane = tid & 63, wid = tid >> 6, wr = wid >> 1, wc = wid & 1, fr = lane & 15, fq = lane >> 4;
        int tm, tn;
        tile_map(L, ntiles, nM, nN, tm, tn);
        f32x4 acc[MT][4];
#pragma unroll
        for (int m = 0; m < MT; ++m)
#pragma unroll
            for (int n = 0; n < 4; ++n) acc[m][n] = (f32x4){0.f, 0.f, 0.f, 0.f};
        gemm_core<MT>(MM + (size_t)tm * RT * 1024, Wo + (size_t)tn * 128 * 1024, 1024, acc, smem, tid);
        float* st = (float*)(smem + opaque_zero());
#pragma unroll
        for (int m = 0; m < MT; ++m)
#pragma unroll
            for (int n = 0; n < 4; ++n) *(f32x4*)(st + (wr * 16 * MT + m * 16 + fr) * 132 + wc * 64 + n * 16 + fq * 4) = acc[m][n];
        __syncthreads();
#pragma unroll 4
        for (int i = 0; i < RT / 8; ++i) {
            const int rl = (tid >> 5) + 8 * i, c4 = (tid & 31) * 4;
            const int row = tm * RT + rl, col = tn * 128 + c4;
            const f32x4 a = *(const f32x4*)(st + rl * 132 + c4);
            const float4 x = *(const float4*)(X + (size_t)row * 1024 + col);
            const float4 g = *(const float4*)(mod + ((size_t)l * NROWB + cond_row(row)) * 3072 + 2048 + col);
            *(float4*)(TT + (size_t)row * 1024 + col) = make_float4(ALPHA_DN * x.x + g.x * a[0], ALPHA_DN * x.y + g.y * a[1],
                                                                    ALPHA_DN * x.z + g.z * a[2], ALPHA_DN * x.w + g.w * a[3]);
        }
    }
}

__device__ __forceinline__ void gmlp_prompt_item(const Params& p, int l, int it, char* smem) {
    smem += opaque_zero();
    const int tid = opaque_tid(), lane = tid & 63, wid = tid >> 6, wr = wid >> 1, wc = wid & 1, fr = lane & 15, fq = lane >> 4;
    const int h = it & 7, n = (it >> 3) & 15, b = it >> 7;
    const int tok0 = b * SEQ + n * 128;
    const bf16_t* P = (const bf16_t*)(p.ws + OFF_P);
    bf16_t* YA = (bf16_t*)(p.ws + OFF_YA);
    bf16_t* Wt = (bf16_t*)smem;
    bf16_t* VnT = Wt + 128 * 136;
    float* mu = (float*)(smem + 2 * 34816);
    float* rs = mu + 128;
    __syncthreads();
    {
        const int t = tid >> 1, half = tid & 1;
        const float* wsrc = p.w_s + ((size_t)(l * 8 + h) * 128 + t) * 128 + half * 64;
#pragma unroll
        for (int i = 0; i < 8; ++i) {
            const float4 w0 = *(const float4*)(wsrc + i * 8);
            const float4 w1 = *(const float4*)(wsrc + i * 8 + 4);
            const int s0 = half * 64 + i * 8;
            const float e0 = s0 + 0 <= t ? w0.x : 0.f, e1 = s0 + 1 <= t ? w0.y : 0.f, e2 = s0 + 2 <= t ? w0.z : 0.f, e3 = s0 + 3 <= t ? w0.w : 0.f;
            const float e4 = s0 + 4 <= t ? w1.x : 0.f, e5 = s0 + 5 <= t ? w1.y : 0.f, e6 = s0 + 6 <= t ? w1.z : 0.f, e7 = s0 + 7 <= t ? w1.w : 0.f;
            *(uint4*)(Wt + t * 136 + s0) = make_uint4(pack2(e0, e1), pack2(e2, e3), pack2(e4, e5), pack2(e6, e7));
        }
        if (half == 0) {
            const float2 sv = *(const float2*)((const float*)(p.ws + OFF_STATS) + (size_t)(tok0 + t) * 2);
            const float mean = sv.x * (1.f / 1024.f);
            const float var = fmaxf(sv.y * (1.f / 1024.f) - mean * mean, 0.f);
            mu[t] = mean;
            rs[t] = rsqrtf(var + LN_EPS);
        }
    }
    __syncthreads();
    {
        const int c = tid & 127, sg = tid >> 7;
        const float gam = p.lnv_g[l * 1024 + h * 128 + c], bet = p.lnv_b[l * 1024 + h * 128 + c];
        const bf16_t* src = P + (size_t)tok0 * PC + C_VA + h * 128 + c;
        float* cv = p.out + O_CV_P + ((size_t)(l * NB + b) * 128) * 1024 + h * 128 + c;
        bf16_t rw[64];
#pragma unroll
        for (int q = 0; q < 64; ++q) rw[q] = src[(size_t)(sg * 64 + q) * PC];
        __builtin_amdgcn_sched_barrier(0);
#pragma unroll
        for (int oct = 0; oct < 8; ++oct) {
            const int s0 = sg * 64 + oct * 8;
            float e[8];
#pragma unroll
            for (int j = 0; j < 8; ++j) {
                const float x = bf2f(rw[oct * 8 + j]);
                e[j] = (x - mu[s0 + j]) * rs[s0 + j] * gam + bet;
            }
            if (n == 15) {
#pragma unroll
                for (int j = 0; j < 8; ++j) cv[(size_t)(s0 + j) * 1024] = e[j];
            }
            *(uint4*)(VnT + c * 136 + s0) = make_uint4(pack2(e[0], e[1]), pack2(e[2], e[3]), pack2(e[4], e[5]), pack2(e[6], e[7]));
        }
    }
    __syncthreads();
    f32x4 acc[4][4];
#pragma unroll
    for (int m = 0; m < 4; ++m)
#pragma unroll
        for (int nn = 0; nn < 4; ++nn) acc[m][nn] = (f32x4){0.f, 0.f, 0.f, 0.f};
#pragma unroll
    for (int ks = 0; ks < 4; ++ks) {
        bf16x8 af[4], bfr[4];
#pragma unroll
        for (int m = 0; m < 4; ++m) af[m] = *(const bf16x8*)(Wt + (wr * 64 + m * 16 + fr) * 136 + ks * 32 + fq * 8);
#pragma unroll
        for (int nn = 0; nn < 4; ++nn) bfr[nn] = *(const bf16x8*)(VnT + (wc * 64 + nn * 16 + fr) * 136 + ks * 32 + fq * 8);
#pragma unroll
        for (int m = 0; m < 4; ++m)
#pragma unroll
            for (int nn = 0; nn < 4; ++nn) acc[m][nn] = mfma16(bfr[nn], af[m], acc[m][nn]);
    }
#pragma unroll
    for (int m = 0; m < 4; ++m) {
        const int t = wr * 64 + m * 16 + fr;
        const float bs = p.b_s[(l * 8 + h) * 128 + t];
        const bf16_t* prow = P + (size_t)(tok0 + t) * PC + h * 128;
#pragma unroll
        for (int nn = 0; nn < 4; ++nn) {
            const int c = wc * 64 + nn * 16 + fq * 4;
            const uint2 u = *(const uint2*)(prow + C_UA + c);
            const uint2 z = *(const uint2*)(prow + C_ZA + c);
            const float y0 = lo_bf(u.x) * (acc[m][nn][0] + bs) * lo_bf(z.x);
            const float y1 = hi_bf(u.x) * (acc[m][nn][1] + bs) * hi_bf(z.x);
            const float y2 = lo_bf(u.y) * (acc[m][nn][2] + bs) * lo_bf(z.y);
            const float y3 = hi_bf(u.y) * (acc[m][nn][3] + bs) * hi_bf(z.y);
            *(uint2*)(YA + (size_t)(tok0 + t) * 1024 + h * 128 + c) = make_uint2(pack2(y0, y1), pack2(y2, y3));
        }
    }
}

__device__ __forceinline__ void gmlp_sample_item(const Params& p, int l, int b, char* smem) {
    smem += opaque_zero();
    const int tid = opaque_tid(), lane = tid & 63, wid = tid >> 6;
    const int tok0 = TP + b * DSQ;
    const bf16_t* P = (const bf16_t*)(p.ws + OFF_P);
    bf16_t* YA = (bf16_t*)(p.ws + OFF_YA);
    float* red = (float*)smem;
    __syncthreads();
    const int c4 = tid * 4;
    float x[4][4];
    float s[4], ss[4];
#pragma unroll
    for (int t = 0; t < 4; ++t) {
        const uint2 u = *(const uint2*)(P + (size_t)(tok0 + t) * PC + C_VA + c4);
        x[t][0] = lo_bf(u.x); x[t][1] = hi_bf(u.x); x[t][2] = lo_bf(u.y); x[t][3] = hi_bf(u.y);
        s[t] = wave_sum(x[t][0] + x[t][1] + x[t][2] + x[t][3]);
        ss[t] = wave_sum(x[t][0] * x[t][0] + x[t][1] * x[t][1] + x[t][2] * x[t][2] + x[t][3] * x[t][3]);
    }
    if (lane == 0) {
#pragma unroll
        for (int t = 0; t < 4; ++t) { red[wid * 8 + t] = s[t]; red[wid * 8 + 4 + t] = ss[t]; }
    }
    __syncthreads();
    const float4 gam = *(const float4*)(p.lnv_g + l * 1024 + c4);
    const float4 bet = *(const float4*)(p.lnv_b + l * 1024 + c4);
    float vn[4][4];
#pragma unroll
    for (int t = 0; t < 4; ++t) {
        const float st = red[t] + red[8 + t] + red[16 + t] + red[24 + t];
        const float sst = red[4 + t] + red[12 + t] + red[20 + t] + red[28 + t];
        const float mean = st * (1.f / 1024.f);
        const float rstd = rsqrtf(fmaxf(sst * (1.f / 1024.f) - mean * mean, 0.f) + LN_EPS);
        vn[t][0] = (x[t][0] - mean) * rstd * gam.x + bet.x;
        vn[t][1] = (x[t][1] - mean) * rstd * gam.y + bet.y;
        vn[t][2] = (x[t][2] - mean) * rstd * gam.z + bet.z;
        vn[t][3] = (x[t][3] - mean) * rstd * gam.w + bet.w;
        *(float4*)(p.out + O_CV_S + ((size_t)(l * DBT + b) * DSQ + t) * 1024 + c4) = make_float4(vn[t][0], vn[t][1], vn[t][2], vn[t][3]);
    }
    const int h = c4 >> 7;
#pragma unroll
    for (int t = 0; t < 4; ++t) {
        const float bs = p.b_s[(l * 8 + h) * 128 + t];
        float a[4] = {bs, bs, bs, bs};
#pragma unroll
        for (int sidx = 0; sidx <= t; ++sidx) {
            const float w = p.w_s[((size_t)(l * 8 + h) * 128 + t) * 128 + sidx];
#pragma unroll
            for (int e = 0; e < 4; ++e) a[e] += w * vn[sidx][e];
        }
        const uint2 u = *(const uint2*)(P + (size_t)(tok0 + t) * PC + C_UA + c4);
        const uint2 z = *(const uint2*)(P + (size_t)(tok0 + t) * PC + C_ZA + c4);
        const float y0 = lo_bf(u.x) * a[0] * lo_bf(z.x), y1 = hi_bf(u.x) * a[1] * hi_bf(z.x);
        const float y2 = lo_bf(u.y) * a[2] * lo_bf(z.y), y3 = hi_bf(u.y) * a[3] * hi_bf(z.y);
        *(uint2*)(YA + (size_t)(tok0 + t) * 1024 + c4) = make_uint2(pack2(y0, y1), pack2(y2, y3));
    }
}

__device__ __forceinline__ void conv_state_item(const Params& p, int l, int it) {
    const bf16_t* P = (const bf16_t*)(p.ws + OFF_P);
    const bool pr = it < NB;
    const int b = pr ? it : it - NB;
    const int tokb = pr ? b * SEQ + SEQ - 3 : TP + b * DSQ + 1;
    float* dst = pr ? p.out + O_CONV_P + (size_t)(l * NB + b) * 3 * 3072 : p.out + O_CONV_S + (size_t)(l * DBT + b) * 3 * 3072;
    for (int idx = opaque_tid(); idx < 3 * 768; idx += 256) {
        const int j = idx / 768, c = (idx % 768) * 4;
        const uint2 u = *(const uint2*)(P + (size_t)(tokb + j) * PC + C_Q + c);
        *(float4*)(dst + j * 3072 + c) = make_float4(lo_bf(u.x), hi_bf(u.x), lo_bf(u.y), hi_bf(u.y));
    }
}

__device__ __forceinline__ void gdn_sample_item(const Params& p, int l, int it, char* smem) {
    smem += opaque_zero();
    const int tid = opaque_tid(), lane = tid & 63, wid = tid >> 6;
    const int b = it >> 3, h = it & 7;
    const int tok0 = TP + b * DSQ;
    const bf16_t* P = (const bf16_t*)(p.ws + OFF_P);
    const float* BETA = (const float*)(p.ws + OFF_BETA);
    const float* GLOG = (const float*)(p.ws + OFF_GLOG);
    bf16_t* YB = (bf16_t*)(p.ws + OFF_YB);
    float* qs = (float*)smem;
    float* ks = qs + 512;
    float* vs = ks + 512;
    float* red = vs + 512;
    float* part = red + 16;
    float* opart = part + 1024;
    float* red2 = opart + 1024;
    __syncthreads();
    const int j = tid & 127;
    const bool isk = tid >= 128;
    float y1[4], y2[4];
    {
        const int cq = (isk ? 1024 : 0) + h * 128 + j;
        const float* sc = p.state_conv + (size_t)(l * DBT + b) * 3 * 3072;
        const float* cw = p.conv_w + (size_t)l * 4 * 3072;
        float xr[7];
#pragma unroll
        for (int r = 0; r < 3; ++r) xr[r] = sc[r * 3072 + cq];
#pragma unroll
        for (int t = 0; t < 4; ++t) xr[3 + t] = bf2f(P[(size_t)(tok0 + t) * PC + C_Q + cq]);
        const float w0 = cw[cq], w1 = cw[3072 + cq], w2 = cw[2 * 3072 + cq], w3 = cw[3 * 3072 + cq];
#pragma unroll
        for (int t = 0; t < 4; ++t) y1[t] = silu_f(w0 * xr[t] + w1 * xr[t + 1] + w2 * xr[t + 2] + w3 * xr[t + 3]);
        if (!isk) {
            const int cv = 2048 + h * 128 + j;
#pragma unroll
            for (int r = 0; r < 3; ++r) xr[r] = sc[r * 3072 + cv];
#pragma unroll
            for (int t = 0; t < 4; ++t) xr[3 + t] = bf2f(P[(size_t)(tok0 + t) * PC + C_Q + cv]);
            const float v0 = cw[cv], v1 = cw[3072 + cv], v2 = cw[2 * 3072 + cv], v3 = cw[3 * 3072 + cv];
#pragma unroll
            for (int t = 0; t < 4; ++t) y2[t] = silu_f(v0 * xr[t] + v1 * xr[t + 1] + v2 * xr[t + 2] + v3 * xr[t + 3]);
        }
    }
#pragma unroll
    for (int t = 0; t < 4; ++t) {
        const float s = wave_sum(y1[t] * y1[t]);
        if (lane == 0) red[wid * 4 + t] = s;
    }
    __syncthreads();
#pragma unroll
    for (int t = 0; t < 4; ++t) {
        const float tot = isk ? red[8 + t] + red[12 + t] : red[t] + red[4 + t];
        const float rn = rsqrtf(tot + NORM_EPS);
        if (isk) ks[t * 128 + j] = y1[t] * rn;
        else { qs[t * 128 + j] = y1[t] * rn * 0.08838834764831845f; vs[t * 128 + j] = y2[t]; }
    }
    __syncthreads();
    const int vcol = j, kh = tid >> 7;
    float S[64];
    const float* s0 = p.state_ssm + ((size_t)(l * DBT + b) * 8 + h) * 16384 + (size_t)(kh * 64) * 128 + vcol;
#pragma unroll
    for (int kk = 0; kk < 64; ++kk) S[kk] = s0[kk * 128];
#pragma unroll
    for (int t = 0; t < 4; ++t) {
        const float a = __expf(GLOG[(size_t)(tok0 + t) * 8 + h]);
        const float bt = BETA[(size_t)(tok0 + t) * 8 + h];
        float r0 = 0.f, r1 = 0.f;
#pragma unroll
        for (int kk = 0; kk < 64; kk += 4) {
            const float4 kv = *(const float4*)&ks[t * 128 + kh * 64 + kk];
            r0 += S[kk] * kv.x + S[kk + 2] * kv.z;
            r1 += S[kk + 1] * kv.y + S[kk + 3] * kv.w;
        }
        part[(t * 2 + kh) * 128 + vcol] = r0 + r1;
        __syncthreads();
        const float dlt = bt * (vs[t * 128 + vcol] - a * (part[(t * 2) * 128 + vcol] + part[(t * 2 + 1) * 128 + vcol]));
        float o0 = 0.f, o1 = 0.f;
#pragma unroll
        for (int kk = 0; kk < 64; kk += 4) {
            const float4 kv = *(const float4*)&ks[t * 128 + kh * 64 + kk];
            const float4 qv = *(const float4*)&qs[t * 128 + kh * 64 + kk];
            S[kk] = a * S[kk] + kv.x * dlt;
            S[kk + 1] = a * S[kk + 1] + kv.y * dlt;
            S[kk + 2] = a * S[kk + 2] + kv.z * dlt;
            S[kk + 3] = a * S[kk + 3] + kv.w * dlt;
            o0 += S[kk] * qv.x + S[kk + 2] * qv.z;
            o1 += S[kk + 1] * qv.y + S[kk + 3] * qv.w;
        }
        opart[(t * 2 + kh) * 128 + vcol] = o0 + o1;
    }
    float* sout = p.out + O_SSM_S + ((size_t)(l * DBT + b) * 8 + h) * 16384 + (size_t)(kh * 64) * 128 + vcol;
#pragma unroll
    for (int kk = 0; kk < 64; ++kk) sout[kk * 128] = S[kk];
    __syncthreads();
    float o[4];
    if (tid < 128) {
#pragma unroll
        for (int t = 0; t < 4; ++t) {
            o[t] = opart[(t * 2) * 128 + vcol] + opart[(t * 2 + 1) * 128 + vcol];
            const float s = wave_sum(o[t] * o[t]);
            if (lane == 0) red2[wid * 4 + t] = s;
        }
    }
    __syncthreads();
    if (tid < 128) {
        const float gn = p.onorm_g[l * 128 + vcol];
#pragma unroll
        for (int t = 0; t < 4; ++t) {
            const float rinv = rsqrtf((red2[t] + red2[4 + t]) * (1.f / 128.f) + NORM_EPS);
            const float zs = bf2f(P[(size_t)(tok0 + t) * PC + C_ZB + h * 128 + vcol]);
            YB[(size_t)(tok0 + t) * 1024 + h * 128 + vcol] = f2bf(o[t] * rinv * gn * zs);
        }
    }
}

__device__ __forceinline__ void gdn_prep_item(const Params& p, int l, int it, char* smem) {
    smem += opaque_zero();
    const int tid = opaque_tid(), lane = tid & 63, wid = tid >> 6, fr = lane & 15, fq = lane >> 4;
    const int n = it & 31, h = (it >> 5) & 7, b = it >> 8;
    const int tok0 = b * SEQ + n * 64;
    const bf16_t* P = (const bf16_t*)(p.ws + OFF_P);
    const float* BETA = (const float*)(p.ws + OFF_BETA);
    const float* GLOG = (const float*)(p.ws + OFF_GLOG);
    float* Ug = (float*)(p.ws + OFF_U) + (size_t)it * 8192;
    bf16_t* Wg = (bf16_t*)(p.ws + OFF_WG) + (size_t)it * 8192;
    bf16_t* QGg = (bf16_t*)(p.ws + OFF_QG) + (size_t)it * 8192;
    bf16_t* KDTg = (bf16_t*)(p.ws + OFF_KDT) + (size_t)it * 8192;
    bf16_t* QKg = (bf16_t*)(p.ws + OFF_QK) + (size_t)it * 4096;
    float* EGg = (float*)(p.ws + OFF_EG);
    bf16_t* Qs = (bf16_t*)smem;
    bf16_t* Ks = Qs + 64 * 136;
    bf16_t* Kbs = Ks + 64 * 136;
    float* Am = (float*)(smem + 3 * 17408);
    float* gcs = Am + 64 * 68;
    float* betas = gcs + 64;
    float* red = betas + 64;
    __syncthreads();
    if (tid < 64) {
        float g = GLOG[(size_t)(tok0 + tid) * 8 + h];
#pragma unroll
        for (int o = 1; o < 64; o <<= 1) {
            const float t = __shfl_up(g, o);
            if (lane >= o) g += t;
        }
        gcs[tid] = g;
        betas[tid] = BETA[(size_t)(tok0 + tid) * 8 + h];
    }
    const int j = tid & 127;
    const bool isk = tid >= 128;
    float val[64];
    char* R1 = smem + 2 * 17408;
    char* R2 = smem + 3 * 17408;
    {
        const bf16_t* pb = P + ((ptrdiff_t)tok0 - 3) * PC + C_Q + h * 128;
#pragma unroll
        for (int it9 = 0; it9 < 9; ++it9) {
            const int c = tid + 256 * it9;
            if (c < 67 * 32) {
                const int r = c >> 5, sg = c & 31;
                u32x4 v = (u32x4){0u, 0u, 0u, 0u};
                if (n > 0 || r >= 3) v = *(const u32x4*)(pb + (ptrdiff_t)r * PC + (sg >> 4) * 1024 + (sg & 15) * 8);
                *(u32x4*)(R1 + r * 512 + sg * 16) = v;
            }
        }
    }
    __syncthreads();
    {
        const int cq = (isk ? 1024 : 0) + h * 128 + j;
        const float* cw = p.conv_w + (size_t)l * 4 * 3072;
        const float w0 = cw[cq], w1 = cw[3072 + cq], w2 = cw[2 * 3072 + cq], w3 = cw[3 * 3072 + cq];
        const bf16_t* col = (const bf16_t*)(R1 + (isk ? 256 : 0)) + j;
        float x3 = bf2f(col[0]), x2 = bf2f(col[256]), x1 = bf2f(col[512]);
#pragma unroll
        for (int i = 0; i < 64; ++i) {
            const float x0 = bf2f(col[(i + 3) * 256]);
            val[i] = silu_f(w0 * x3 + w1 * x2 + w2 * x1 + w3 * x0);
            x3 = x2; x2 = x1; x1 = x0;
            if ((i & 15) == 15) __builtin_amdgcn_sched_barrier(0);
        }
    }
#pragma unroll
    for (int i = 0; i < 64; ++i) {
        const float s = wave_sum(val[i] * val[i]);
        if (lane == 0) red[wid * 64 + i] = s;
        if ((i & 7) == 7) __builtin_amdgcn_sched_barrier(0);
    }
    __syncthreads();
    const float glast = gcs[63];
    {
        const bf16_t* pb = P + ((ptrdiff_t)tok0 - 3) * PC + C_Q + 2048 + h * 128;
#pragma unroll
        for (int it5 = 0; it5 < 5; ++it5) {
            const int c = tid + 256 * it5;
            if (c < 67 * 16) {
                const int r = c >> 4, sg = c & 15;
                u32x4 v = (u32x4){0u, 0u, 0u, 0u};
                if (n > 0 || r >= 3) v = *(const u32x4*)(pb + (ptrdiff_t)r * PC + sg * 8);
                *(u32x4*)(R2 + r * 256 + sg * 16) = v;
            }
        }
    }
    if (!isk) {
#pragma unroll
        for (int i = 0; i < 64; ++i) {
            const float rn = rsqrtf(red[i] + red[64 + i] + NORM_EPS);
            const float qv = val[i] * rn * 0.08838834764831845f;
            Qs[i * 136 + j] = f2bf(qv);
            QGg[i * 128 + perm32(j)] = f2bf(qv * __expf(gcs[i]));
            if ((i & 7) == 7) __builtin_amdgcn_sched_barrier(0);
        }
    } else {
        unsigned pk[32];
#pragma unroll
        for (int i = 0; i < 64; ++i) {
            const float rn = rsqrtf(red[128 + i] + red[192 + i] + NORM_EPS);
            const float kv = val[i] * rn;
            const float gi = gcs[i], bi = betas[i];
            Ks[i * 136 + j] = f2bf(kv);
            Kbs[i * 136 + j] = f2bf(kv * bi);
            const bf16_t kd = f2bf(kv * __expf(glast - gi));
            if (i & 1) pk[perm32(i) >> 1] |= ((unsigned)kd) << 16; else pk[perm32(i) >> 1] = kd;
            val[i] = kv * bi * __expf(gi);
            if ((i & 7) == 7) __builtin_amdgcn_sched_barrier(0);
        }
#pragma unroll
        for (int i = 0; i < 8; ++i) *(uint4*)(KDTg + j * 64 + i * 8) = make_uint4(pk[i * 4], pk[i * 4 + 1], pk[i * 4 + 2], pk[i * 4 + 3]);
    }
    __syncthreads();
    if (!isk) {
        const int cv = 2048 + h * 128 + j;
        const float* cw = p.conv_w + (size_t)l * 4 * 3072;
        const float w0 = cw[cv], w1 = cw[3072 + cv], w2 = cw[2 * 3072 + cv], w3 = cw[3 * 3072 + cv];
        const bf16_t* col = (const bf16_t*)R2 + j;
        float x3 = bf2f(col[0]), x2 = bf2f(col[128]), x1 = bf2f(col[256]);
#pragma unroll
        for (int i = 0; i < 64; ++i) {
            const float x0 = bf2f(col[(i + 3) * 128]);
            val[i] = silu_f(w0 * x3 + w1 * x2 + w2 * x1 + w3 * x0) * betas[i];
            x3 = x2; x2 = x1; x1 = x0;
            if ((i & 15) == 15) __builtin_amdgcn_sched_barrier(0);
        }
    }
    __syncthreads();
    {
        f32x4 aA[4], aQ[4];
#pragma unroll
        for (int nt = 0; nt < 4; ++nt) { aA[nt] = (f32x4){0.f, 0.f, 0.f, 0.f}; aQ[nt] = (f32x4){0.f, 0.f, 0.f, 0.f}; }
#pragma unroll
        for (int ksi = 0; ksi < 4; ++ksi) {
            const bf16x8 fa = *(const bf16x8*)(Kbs + (wid * 16 + fr) * 136 + ksi * 32 + fq * 8);
            const bf16x8 fqv = *(const bf16x8*)(Qs + (wid * 16 + fr) * 136 + ksi * 32 + fq * 8);
#pragma unroll
            for (int nt = 0; nt < 4; ++nt) {
                const bf16x8 fb = *(const bf16x8*)(Ks + (nt * 16 + fr) * 136 + ksi * 32 + fq * 8);
                aA[nt] = mfma16(fa, fb, aA[nt]);
                aQ[nt] = mfma16(fqv, fb, aQ[nt]);
            }
        }
#pragma unroll
        for (int nt = 0; nt < 4; ++nt) {
            const int jc = nt * 16 + fr;
            const float gj = gcs[jc];
#pragma unroll
            for (int r = 0; r < 4; ++r) {
                const int i = wid * 16 + fq * 4 + r;
                const float dec = jc <= i ? __expf(gcs[i] - gj) : 0.f;
                Am[i * 68 + jc] = jc < i ? aA[nt][r] * dec : 0.f;
                QKg[i * 64 + perm32(jc)] = f2bf(aQ[nt][r] * dec);
            }
        }
    }
    __syncthreads();
#pragma unroll
    for (int i = 1; i < 64; ++i) {
        float s0 = 0.f, s1 = 0.f, s2 = 0.f, s3 = 0.f;
#pragma unroll
        for (int j4 = 0; j4 < (i + 3) / 4; ++j4) {
            const float4 a = *(const float4*)&Am[i * 68 + j4 * 4];
            s0 += a.x * val[j4 * 4];
            s1 += a.y * val[j4 * 4 + 1];
            s2 += a.z * val[j4 * 4 + 2];
            s3 += a.w * val[j4 * 4 + 3];
        }
        val[i] -= (s0 + s1) + (s2 + s3);
        if ((i & 3) == 3) __builtin_amdgcn_sched_barrier(0);
    }
    if (!isk) {
#pragma unroll
        for (int i = 0; i < 64; i += 4)
            *(float4*)(Ug + (((i >> 4) * 8 + (j >> 4)) * 64 + ((i >> 2) & 3) * 16 + (j & 15)) * 4) = make_float4(val[i], val[i + 1], val[i + 2], val[i + 3]);
    } else {
        const int pj = perm32(j);
#pragma unroll
        for (int i = 0; i < 64; ++i) Wg[i * 128 + pj] = f2bf(val[i]);
    }
    if (tid == 0) EGg[it] = __expf(glast);
}

__device__ __forceinline__ void gdn_scan_item(const Params& p, int l, int bh, char* smem) {
    smem += opaque_zero();
    const int tid0 = opaque_tid();
    const int b = bh >> 3, h = bh & 7;
    constexpr int WBY = 64 * 272, BUFB = WBY + 128 * 128;
    const float* EGg = (const float*)(p.ws + OFF_EG);
    f32x4 S[8][2];
#pragma unroll
    for (int mt = 0; mt < 8; ++mt) { S[mt][0] = (f32x4){0.f, 0.f, 0.f, 0.f}; S[mt][1] = (f32x4){0.f, 0.f, 0.f, 0.f}; }
    u32x4 stg[8];
    f32x4 ucur[4][2];
    {
        const size_t item = (size_t)bh * 32;
        const bf16_t* Wp = (const bf16_t*)(p.ws + OFF_WG) + item * 8192;
        const bf16_t* KDTp = (const bf16_t*)(p.ws + OFF_KDT) + item * 8192;
        const float* Up = (const float*)(p.ws + OFF_U) + item * 8192;
        const int lane = tid0 & 63, w = tid0 >> 6, fr = lane & 15, fq = lane >> 4;
#pragma unroll
        for (int i = 0; i < 4; ++i) {
            stg[i] = ldg_b<u32x4>(Wp, 16u * (unsigned)(tid0 + 256 * i));
            stg[4 + i] = ldg_b<u32x4>(KDTp, 16u * (unsigned)(tid0 + 256 * i));
        }
#pragma unroll
        for (int mt = 0; mt < 4; ++mt)
#pragma unroll
            for (int nt = 0; nt < 2; ++nt) ucur[mt][nt] = ldg_b<f32x4>(Up, 16u * (unsigned)((mt * 8 + w * 2 + nt) * 64 + lane));
        __syncthreads();
#pragma unroll
        for (int i = 0; i < 4; ++i) {
            const int c = tid0 + 256 * i;
            *(u32x4*)(smem + (c >> 4) * 272 + (c & 15) * 16) = stg[i];
            *(u32x4*)(smem + WBY + (c >> 3) * 128 + ((((c & 7) ^ ((c >> 3) & 7))) << 4)) = stg[4 + i];
        }
        __syncthreads();
    }
    for (int n = 0; n < 32; ++n) {
        int tid = tid0;
        asm volatile("" : "+v"(tid));
        const int lane = tid & 63, w = tid >> 6, fr = lane & 15, fq = lane >> 4;
        const char* cur = smem + (n & 1) * BUFB;
        const size_t item = (size_t)bh * 32 + n;
        const float eg = EGg[item];
        bf16_t* SBp = (bf16_t*)(p.ws + OFF_SB) + item * 16384;
        bf16_t* VNp = (bf16_t*)(p.ws + OFF_VN) + item * 8192;
        if (n + 1 < 32) {
            const bf16_t* Wp = (const bf16_t*)(p.ws + OFF_WG) + (item + 1) * 8192;
            const bf16_t* KDTp = (const bf16_t*)(p.ws + OFF_KDT) + (item + 1) * 8192;
#pragma unroll
            for (int i = 0; i < 4; ++i) {
                stg[i] = ldg_b<u32x4>(Wp, 16u * (unsigned)(tid + 256 * i));
                stg[4 + i] = ldg_b<u32x4>(KDTp, 16u * (unsigned)(tid + 256 * i));
            }
        }
        bf16x8 sf[4][2];
#pragma unroll
        for (int pp = 0; pp < 4; ++pp)
#pragma unroll
            for (int nt = 0; nt < 2; ++nt) {
                u32x4 t;
                t[0] = pack2(S[2 * pp][nt][0], S[2 * pp][nt][1]);
                t[1] = pack2(S[2 * pp][nt][2], S[2 * pp][nt][3]);
                t[2] = pack2(S[2 * pp + 1][nt][0], S[2 * pp + 1][nt][1]);
                t[3] = pack2(S[2 * pp + 1][nt][2], S[2 * pp + 1][nt][3]);
                stg_b<u32x4>(SBp, 16u * (unsigned)((pp * 8 + w * 2 + nt) * 64 + lane), t);
                sf[pp][nt] = (bf16x8)t;
            }
        bf16x8 vf[2][2];
#pragma unroll
        for (int q = 0; q < 2; ++q) {
            u32x4 t0, t1;
#pragma unroll
            for (int hh = 0; hh < 2; ++hh) {
                const int mt = 2 * q + hh;
                f32x4 a0 = (f32x4){0.f, 0.f, 0.f, 0.f}, a1 = a0;
#pragma unroll
                for (int pp = 0; pp < 4; ++pp) {
                    const bf16x8 wf = *(const bf16x8*)(cur + (mt * 16 + fr) * 272 + pp * 64 + fq * 16);
                    a0 = mfma16(wf, sf[pp][0], a0);
                    a1 = mfma16(wf, sf[pp][1], a1);
                }
                const f32x4 v0 = ucur[mt][0] - a0, v1 = ucur[mt][1] - a1;
                t0[2 * hh] = pack2(v0[0], v0[1]); t0[2 * hh + 1] = pack2(v0[2], v0[3]);
                t1[2 * hh] = pack2(v1[0], v1[1]); t1[2 * hh + 1] = pack2(v1[2], v1[3]);
            }
            stg_b<u32x4>(VNp, 16u * (unsigned)((q * 8 + w * 2) * 64 + lane), t0);
            stg_b<u32x4>(VNp, 16u * (unsigned)((q * 8 + w * 2 + 1) * 64 + lane), t1);
            vf[q][0] = (bf16x8)t0;
            vf[q][1] = (bf16x8)t1;
        }
        if (n + 1 < 32) {
            const float* Up = (const float*)(p.ws + OFF_U) + (item + 1) * 8192;
#pragma unroll
            for (int mt = 0; mt < 4; ++mt)
#pragma unroll
                for (int nt = 0; nt < 2; ++nt) ucur[mt][nt] = ldg_b<f32x4>(Up, 16u * (unsigned)((mt * 8 + w * 2 + nt) * 64 + lane));
        }
#pragma unroll
        for (int mt = 0; mt < 8; ++mt) {
            S[mt][0] *= eg;
            S[mt][1] *= eg;
#pragma unroll
            for (int q = 0; q < 2; ++q) {
                const bf16x8 kf = *(const bf16x8*)(cur + WBY + (mt * 16 + fr) * 128 + (((q * 4 + fq) ^ (fr & 7)) << 4));
                S[mt][0] = mfma16(kf, vf[q][0], S[mt][0]);
                S[mt][1] = mfma16(kf, vf[q][1], S[mt][1]);
            }
        }
        if (n + 1 < 32) {
            char* nxt = smem + ((n + 1) & 1) * BUFB;
#pragma unroll
            for (int i = 0; i < 4; ++i) {
                const int c = tid + 256 * i;
                *(u32x4*)(nxt + (c >> 4) * 272 + (c & 15) * 16) = stg[i];
                *(u32x4*)(nxt + WBY + (c >> 3) * 128 + ((((c & 7) ^ ((c >> 3) & 7))) << 4)) = stg[4 + i];
            }
        }
        __syncthreads();
    }
    const int lane = tid0 & 63, w = tid0 >> 6, fr = lane & 15, fq = lane >> 4;
    float* so = p.out + O_SSM_P + ((size_t)(l * NB + b) * 8 + h) * 16384;
#pragma unroll
    for (int mt = 0; mt < 8; ++mt)
#pragma unroll
        for (int nt = 0; nt < 2; ++nt)
#pragma unroll
            for (int r = 0; r < 4; ++r) so[(mt * 16 + fq * 4 + r) * 128 + w * 32 + nt * 16 + fr] = S[mt][nt][r];
}

__device__ __forceinline__ void gdn_out_item(const Params& p, int l, int it) {
    const int tid = opaque_tid(), lane = tid & 63, w = tid >> 6, fr = lane & 15, fq = lane >> 4;
    const int n = it & 31, h = (it >> 5) & 7, b = it >> 8;
    const bf16_t* QGp = (const bf16_t*)(p.ws + OFF_QG) + (size_t)it * 8192;
    const bf16_t* QKp = (const bf16_t*)(p.ws + OFF_QK) + (size_t)it * 4096;
    const bf16_t* SBp = (const bf16_t*)(p.ws + OFF_SB) + (size_t)it * 16384;
    const bf16_t* VNp = (const bf16_t*)(p.ws + OFF_VN) + (size_t)it * 8192;
    const bf16_t* P = (const bf16_t*)(p.ws + OFF_P);
    bf16_t* YB = (bf16_t*)(p.ws + OFF_YB);
    bf16x8 qg[4], qk[2];
#pragma unroll
    for (int pp = 0; pp < 4; ++pp) qg[pp] = ldg_b<bf16x8>(QGp, 2u * (unsigned)((w * 16 + fr) * 128 + pp * 32 + fq * 8));
#pragma unroll
    for (int q = 0; q < 2; ++q) qk[q] = ldg_b<bf16x8>(QKp, 2u * (unsigned)((w * 16 + fr) * 64 + q * 32 + fq * 8));
    f32x4 acc[8];
    float ss = 0.f;
    const size_t tok = (size_t)b * SEQ + n * 64 + w * 16 + fr;
    uint2 zz[8];
#pragma unroll
    for (int nt = 0; nt < 8; ++nt) zz[nt] = *(const uint2*)(P + tok * PC + C_ZB + h * 128 + nt * 16 + fq * 4);
#pragma unroll
    for (int g = 0; g < 2; ++g) {
        bf16x8 sb[4][4], vn[4][2];
#pragma unroll
        for (int t = 0; t < 4; ++t) {
#pragma unroll
            for (int pp = 0; pp < 4; ++pp) sb[t][pp] = ldg_b<bf16x8>(SBp, 16u * (unsigned)((pp * 8 + g * 4 + t) * 64 + lane));
#pragma unroll
            for (int q = 0; q < 2; ++q) vn[t][q] = ldg_b<bf16x8>(VNp, 16u * (unsigned)((q * 8 + g * 4 + t) * 64 + lane));
        }
        __builtin_amdgcn_sched_barrier(0);
#pragma unroll
        for (int t = 0; t < 4; ++t) {
            f32x4 a = (f32x4){0.f, 0.f, 0.f, 0.f};
#pragma unroll
            for (int pp = 0; pp < 4; ++pp) a = mfma16(sb[t][pp], qg[pp], a);
#pragma unroll
            for (int q = 0; q < 2; ++q) a = mfma16(vn[t][q], qk[q], a);
            acc[g * 4 + t] = a;
            ss += a[0] * a[0] + a[1] * a[1] + a[2] * a[2] + a[3] * a[3];
        }
        __builtin_amdgcn_sched_barrier(0);
    }
    ss += __shfl_xor(ss, 16);
    ss += __shfl_xor(ss, 32);
    const float rinv = rsqrtf(ss * (1.f / 128.f) + NORM_EPS);
#pragma unroll
    for (int nt = 0; nt < 8; ++nt) {
        const int v0 = nt * 16 + fq * 4;
        const float4 g = *(const float4*)(p.onorm_g + l * 128 + v0);
        const uint2 z = zz[nt];
        const float y0 = acc[nt][0] * rinv * g.x * lo_bf(z.x), y1 = acc[nt][1] * rinv * g.y * hi_bf(z.x);
        const float y2 = acc[nt][2] * rinv * g.z * lo_bf(z.y), y3 = acc[nt][3] * rinv * g.w * hi_bf(z.y);
        *(uint2*)(YB + tok * 1024 + h * 128 + v0) = make_uint2(pack2(y0, y1), pack2(y2, y3));
    }
}

constexpr int N_GMLP_P = NB * 16 * 8;
constexpr int N_GDN_S = DBT * 8;
constexpr int N_GMLP_S = DBT;
constexpr int N_CONV = NB + DBT;
constexpr int N_OTHER = N_GMLP_P + N_GDN_S + N_GMLP_S + N_CONV;

__device__ __forceinline__ void other_item(const Params& p, int l, int it, char* smem) {
    if (it < N_GMLP_P) gmlp_prompt_item(p, l, it, smem);
    else if (it < N_GMLP_P + N_GDN_S) gdn_sample_item(p, l, it - N_GMLP_P, smem);
    else if (it < N_GMLP_P + N_GDN_S + N_GMLP_S) gmlp_sample_item(p, l, it - N_GMLP_P - N_GDN_S, smem);
    else conv_state_item(p, l, it - N_GMLP_P - N_GDN_S - N_GMLP_S);
}

__device__ __forceinline__ void phase_mixb(const Params& p, int l, char* smem) {
    const int G = gridDim.x;
    if (G >= 128) {
        if (blockIdx.x < 64) gdn_scan_item(p, l, blockIdx.x, smem);
        else for (int it = blockIdx.x - 64; it < N_OTHER; it += G - 64) other_item(p, l, it, smem);
    } else {
        for (int it = blockIdx.x; it < 64; it += G) gdn_scan_item(p, l, it, smem);
        for (int it = blockIdx.x; it < N_OTHER; it += G) other_item(p, l, it, smem);
    }
}

#define FRESH(q) const Params& q = p
#define XB_TMO      128
#define XB_XCNT(j)  (256  + 64 * (j))
#define XB_XSUB(j)  (1280 + 64 * (j))
#define XB_XGEN(j)  (2304 + 64 * (j))
#define XB_TOP      3328
#define XB_TOPGEN   3392
#define XCD_BAR_WORDS 3456
#define XB_SPIN_CAP (1u << 22)
#define LAS __attribute__((address_space(3)))
__device__ __forceinline__ unsigned xb_ld(unsigned* p) { return __hip_atomic_load(p, __ATOMIC_RELAXED, __HIP_MEMORY_SCOPE_AGENT); }
__device__ __forceinline__ unsigned xb_add(unsigned* p, unsigned v) { return __hip_atomic_fetch_add(p, v, __ATOMIC_RELAXED, __HIP_MEMORY_SCOPE_AGENT); }
__device__ __forceinline__ unsigned xb_xcc_id() { return (unsigned)__builtin_amdgcn_s_getreg((3 << 11) | 20) & 0xFu; }
#define XB_SPIN(cond, bar) do { unsigned _sp = 0; while (cond) { __builtin_amdgcn_s_sleep(1); \
    if ((++_sp & 255u) == 0u) { if (xb_ld(&(bar)[XB_TMO])) break; if (_sp > XB_SPIN_CAP) { atomicAdd(&(bar)[XB_TMO], 1u); break; } } } } while (0)
struct XcdBarrier { unsigned* bar; unsigned x; volatile LAS unsigned* st; };
__device__ __forceinline__ XcdBarrier xcd_barrier_post(unsigned* bar, volatile LAS unsigned* st) {
    XcdBarrier b; b.bar = bar; b.x = xb_xcc_id(); b.st = st;
    if (threadIdx.x == 0) (void)xb_add(&bar[XB_XCNT(b.x)], 1u);
    return b;
}
__device__ __forceinline__ void xcd_barrier_complete(unsigned* bar, unsigned x, unsigned& nloc, unsigned& nx) {
    const unsigned G = gridDim.x * gridDim.y * gridDim.z;
    unsigned sum, cnt, mine, sp = 0u;
    for (;;) {
        sum = 0u; cnt = 0u; mine = 0u;
#pragma unroll
        for (unsigned j = 0; j < 16; ++j) { const unsigned c = xb_ld(&bar[XB_XCNT(j)]); sum += c; cnt += (c > 0u) ? 1u : 0u; mine = (j == x) ? c : mine; }
        if (sum == G) break;
        __builtin_amdgcn_s_sleep(1);
        if ((++sp & 255u) == 0u) { if (xb_ld(&bar[XB_TMO])) break; if (sp > XB_SPIN_CAP) { atomicAdd(&bar[XB_TMO], 1u); break; } }
    }
    nloc = mine > 0u ? mine : 1u; nx = cnt > 0u ? cnt : 1u;
}
__device__ __forceinline__ void xcd_barrier(const XcdBarrier& b) {
    asm volatile("s_waitcnt vmcnt(0)" ::: "memory");
    __syncthreads();
    if (threadIdx.x == 0) {
        unsigned* bar = b.bar;
        __builtin_amdgcn_s_waitcnt(0);
        unsigned nloc = b.st[0], nx = b.st[1];
        if (nloc == 0u) { xcd_barrier_complete(bar, b.x, nloc, nx); b.st[0] = nloc; b.st[1] = nx; }
        const unsigned old = xb_add(&bar[XB_XSUB(b.x)], 1u);
        const unsigned gen = old / nloc;
        if (old + 1u == (gen + 1u) * nloc) {
            __builtin_amdgcn_fence(__ATOMIC_RELEASE, "agent");
            asm volatile("s_waitcnt vmcnt(0)" ::: "memory");
            const unsigned og = xb_add(&bar[XB_TOP], 1u);
            const unsigned tg = og / nx;
            if (og + 1u == (tg + 1u) * nx) xb_add(&bar[XB_TOPGEN], 1u);
            else XB_SPIN(xb_ld(&bar[XB_TOPGEN]) == tg, bar);
            __builtin_amdgcn_fence(__ATOMIC_ACQUIRE, "agent");
            xb_add(&bar[XB_XGEN(b.x)], 1u);
            asm volatile("s_waitcnt vmcnt(0)" ::: "memory");
        } else {
            XB_SPIN(xb_ld(&bar[XB_XGEN(b.x)]) == gen, bar);
            __builtin_amdgcn_fence(__ATOMIC_ACQUIRE, "agent");
            asm volatile("s_waitcnt vmcnt(0)" ::: "memory");
        }
    }
    __syncthreads();
}

__global__ void __launch_bounds__(256, 2) fwd_megakernel(Params p) {
    extern __shared__ __attribute__((aligned(16))) char smem[];
    __shared__ uint4 xb_words;
    cg::grid_group grid = cg::this_grid();
    unsigned* bar = (unsigned*)(p.ws + OFF_BAR);
    if (blockIdx.x == 0) for (int i = threadIdx.x; i < XCD_BAR_WORDS; i += 256) __hip_atomic_store(bar + i, 0u, __ATOMIC_RELAXED, __HIP_MEMORY_SCOPE_AGENT);
    if (threadIdx.x == 0) xb_words = make_uint4(0u, 0u, 0u, 0u);
    { FRESH(q); phase0(q, smem); }
    grid.sync();
    const XcdBarrier xb = xcd_barrier_post(bar, (volatile LAS unsigned*)&xb_words);
#define GBAR() xcd_barrier(xb)
    for (int l = 0; l < DEPTH; ++l) {
        { FRESH(q); phase_rows(q, l); }
        GBAR();
        { FRESH(q); phase_inproj256(q, l, smem); }
        GBAR();
        { FRESH(q); for (int it = blockIdx.x; it < NCHK; it += gridDim.x) gdn_prep_item(q, l, it, smem); }
        GBAR();
        { FRESH(q); phase_mixb(q, l, smem); }
        GBAR();
        { FRESH(q); for (int it = blockIdx.x; it < NCHK; it += gridDim.x) gdn_out_item(q, l, it); }
        GBAR();
        { FRESH(q); phase_merge(q, l, smem); }
        GBAR();
        { FRESH(q); phase_outproj(q, l, smem); }
        GBAR();
    }
    { FRESH(q); phase_rows(q, DEPTH); }
}

extern "C" void kernel_launch(void* const* d_in, const int* in_sizes, int n_in, void* d_out, int out_size, void* d_ws, size_t ws_size,
                              hipStream_t stream) {
    static int grid_blocks = 0;
    if (!grid_blocks) {
        int dev = 0, cus = 0, per_cu = 0;
        hipGetDevice(&dev);
        hipDeviceGetAttribute(&cus, hipDeviceAttributeMultiprocessorCount, dev);
        hipFuncSetAttribute((const void*)fwd_megakernel, hipFuncAttributeMaxDynamicSharedMemorySize, SMEM_BYTES);
        hipOccupancyMaxActiveBlocksPerMultiprocessor(&per_cu, fwd_megakernel, 256, SMEM_BYTES);
        if (per_cu > 2) per_cu = 2;
        if (per_cu < 1) per_cu = 1;
        grid_blocks = cus * per_cu;
    }
    if (ws_size < WS_NEED) {
        fprintf(stderr, "workspace too small: %zu < %zu\n", ws_size, (size_t)WS_NEED);
        return;
    }
    Params p{};
    const float** f = (const float**)&p;
    for (int i = 0; i < 22; ++i) f[i] = (const float*)d_in[i];
    p.out = (float*)d_out;
    p.ws = (char*)d_ws;
    void* args[] = {&p};
    hipError_t e = hipLaunchCooperativeKernel((const void*)fwd_megakernel, dim3(grid_blocks), dim3(256), args, SMEM_BYTES, stream);
    if (e != hipSuccess) fprintf(stderr, "cooperative launch failed: %s (grid %d)\n", hipGetErrorString(e), grid_blocks);
}
```

```cpp
#include <hip/hip_runtime.h>
#include <hip/hip_cooperative_groups.h>
#include <cstdio>
namespace cg = cooperative_groups;

typedef unsigned short bf16_t;
typedef short bf16x8 __attribute__((ext_vector_type(8)));
typedef float f32x4 __attribute__((ext_vector_type(4)));
typedef unsigned u32x4 __attribute__((ext_vector_type(4)));

constexpr int D = 1024;
constexpr int NB = 8, SEQ = 2048, DEPTH = 4, DBT = 128, DSQ = 4;
constexpr int TP = NB * SEQ;
constexpr int TS = DBT * DSQ;
constexpr int T = TP + TS;
constexpr int PIN = 9232;
constexpr int PC = 9216;
constexpr int NPAD = 9344;
constexpr int NROWB = NB + DBT;
constexpr float ALPHA_DN = 1.681792830507429f;
constexpr float LN_EPS = 1e-5f, NORM_EPS = 1e-6f;
constexpr int C_UA = 0, C_VA = 1024, C_ZA = 2048, C_Q = 3072, C_ZB = 6144, C_GA = 7168, C_GB = 8192;

constexpr size_t O_Y_P = 0, O_Y_S = 16777216, O_CONV_P = 17301504, O_SSM_P = 17596416, O_CV_P = 21790720,
                 O_CONV_S = 25985024, O_SSM_S = 30703616, O_CV_S = 97812480;

constexpr size_t SZ_WT_IN = (size_t)DEPTH * NPAD * 1024 * 2;
constexpr size_t SZ_WT_SQ = (size_t)DEPTH * 1024 * 1024 * 2;
constexpr size_t OFF_WT_IN = 0;
constexpr size_t OFF_WT_PA = OFF_WT_IN + SZ_WT_IN;
constexpr size_t OFF_WT_PB = OFF_WT_PA + SZ_WT_SQ;
constexpr size_t OFF_WT_O = OFF_WT_PB + SZ_WT_SQ;
constexpr size_t OFF_MOD = OFF_WT_O + SZ_WT_SQ;
constexpr size_t OFF_X = OFF_MOD + (size_t)DEPTH * NROWB * 3072 * 4;
constexpr size_t OFF_TT = OFF_X + (size_t)T * 1024 * 4;
constexpr size_t OFF_H = OFF_TT + (size_t)T * 1024 * 4;
constexpr size_t OFF_YA = OFF_H + (size_t)T * 1024 * 2;
constexpr size_t OFF_YB = OFF_YA + (size_t)T * 1024 * 2;
constexpr size_t OFF_MM = OFF_YB + (size_t)T * 1024 * 2;
constexpr size_t OFF_P = OFF_MM + (size_t)T * 1024 * 2;
constexpr size_t OFF_BETA = OFF_P + (size_t)T * PC * 2;
constexpr size_t OFF_GLOG = OFF_BETA + (size_t)T * 8 * 4;
constexpr int NCHK = 2048;
constexpr size_t OFF_U = OFF_GLOG + (size_t)T * 8 * 4;
constexpr size_t OFF_WG = OFF_U + (size_t)NCHK * 8192 * 4;
constexpr size_t OFF_QG = OFF_WG + (size_t)NCHK * 8192 * 2;
constexpr size_t OFF_KDT = OFF_QG + (size_t)NCHK * 8192 * 2;
constexpr size_t OFF_QK = OFF_KDT + (size_t)NCHK * 8192 * 2;
constexpr size_t OFF_EG = OFF_QK + (size_t)NCHK * 4096 * 2;
constexpr size_t OFF_SB = OFF_EG + (size_t)NCHK * 4;
constexpr size_t OFF_VN = OFF_SB + (size_t)NCHK * 16384 * 2;
constexpr size_t OFF_PARK = OFF_VN + (size_t)NCHK * 8192 * 2;
constexpr size_t OFF_STATS = OFF_PARK + (size_t)1024 * 32768;
constexpr size_t OFF_BAR = OFF_STATS + (size_t)T * 2 * 4;
constexpr size_t WS_NEED = OFF_BAR + 16384;

constexpr int SMEM_BYTES = 73728;
constexpr int TILE_BYTES = 128 * 128;

struct Params {
    const float *x_prompt, *x_sample, *state_conv, *state_ssm, *c_prompt, *c_sample, *w_ada, *b_ada, *w_in, *w_s, *b_s,
        *lnv_g, *lnv_b, *conv_w, *a_log, *dt_bias, *onorm_g, *w_pa, *w_pb, *w_o, *ln_g, *ln_b;
    float* out;
    char* ws;
};

__device__ __forceinline__ unsigned pack2(float a, float b) {
    unsigned r;
    asm("v_cvt_pk_bf16_f32 %0, %1, %2" : "=v"(r) : "v"(a), "v"(b));
    return r;
}
__device__ __forceinline__ bf16_t f2bf(float f) { return (bf16_t)(pack2(f, 0.f) & 0xffffu); }
__device__ __forceinline__ float bf2f(bf16_t h) { return __uint_as_float(((unsigned)h) << 16); }
__device__ __forceinline__ float lo_bf(unsigned u) { return __uint_as_float(u << 16); }
__device__ __forceinline__ float hi_bf(unsigned u) { return __uint_as_float(u & 0xffff0000u); }
__device__ __forceinline__ float sigmoid_f(float x) { return __builtin_amdgcn_rcpf(1.f + __builtin_amdgcn_exp2f(-1.4426950408889634f * x)); }
__device__ __forceinline__ float silu_f(float x) { return x * sigmoid_f(x); }
__device__ __forceinline__ float gelu_f(float x) {
    const float y2 = x * (1.5957691216057308f + 0.0713548162726f * x * x);
    return x * __builtin_amdgcn_rcpf(1.f + __builtin_amdgcn_exp2f(-1.4426950408889634f * y2));
}
__device__ __forceinline__ float softplus_f(float x) { return fmaxf(x, 0.f) + log1pf(__expf(-fabsf(x))); }
__device__ __forceinline__ float wave_sum(float v) {
#pragma unroll
    for (int o = 32; o >= 1; o >>= 1) v += __shfl_xor(v, o);
    return v;
}
__device__ __forceinline__ f32x4 mfma16(bf16x8 a, bf16x8 b, f32x4 c) { return __builtin_amdgcn_mfma_f32_16x16x32_bf16(a, b, c, 0, 0, 0); }
template <class Tp> __device__ __forceinline__ Tp ldg_b(const void* base, unsigned boff) { return *(const Tp*)((const char*)base + boff); }
template <class Tp> __device__ __forceinline__ void stg_b(void* base, unsigned boff, Tp v) { *(Tp*)((char*)base + boff) = v; }
__host__ __device__ constexpr int perm32(int k) { return (k & ~31) | (((k >> 2) & 3) << 3) | (((k >> 4) & 1) << 2) | (k & 3); }
__device__ __forceinline__ int opaque_tid() { int t = threadIdx.x; asm volatile("" : "+v"(t)); return t; }
__device__ __forceinline__ int opaque_zero() { int z = 0; asm volatile("" : "+v"(z)); return z; }
__device__ __forceinline__ int cond_row(int row) { return row < TP ? (row >> 11) : (NB + ((row - TP) >> 2)); }

template <int WGM = 8>
__device__ __forceinline__ void tile_map(int L, int ntiles, int nM, int nN, int& tm, int& tn) {
    const int q = ntiles / 8, r = ntiles % 8, xcd = L % 8, off = L / 8;
    const int g = (xcd < r ? xcd * (q + 1) : r * (q + 1) + (xcd - r) * q) + off;
    const int nig = WGM * nN, gid = g / nig, fm = gid * WGM, gsz = (nM - fm) < WGM ? (nM - fm) : WGM;
    tm = fm + (g % nig) % gsz;
    tn = (g % nig) / gsz;
}

template <int MT>
__device__ __forceinline__ void gemm_core(const bf16_t* __restrict__ A, const bf16_t* __restrict__ B, const int K,
                                          f32x4 (&acc)[MT][4], char* smem, const int tid) {
    const int lane = tid & 63, wid = tid >> 6, wr = wid >> 1, wc = wid & 1;
    const int srow = tid >> 3, sseg = (tid & 7) ^ ((tid >> 3) & 7);
    const bf16_t* ag = A + (size_t)srow * K + sseg * 8;
    const bf16_t* bg = B + (size_t)srow * K + sseg * 8;
    const int nk = K >> 6;
#define STAGE(BUF, KT) do { char* d_ = smem + (BUF) * 2 * TILE_BYTES + tid * 16; \
        _Pragma("unroll") for (int i = 0; i < MT; ++i) __builtin_amdgcn_global_load_lds((const unsigned*)(ag + (size_t)(32 * i) * K + (KT) * 64), (__attribute__((address_space(3))) unsigned*)(d_ + i * 4096), 16, 0, 0); \
        _Pragma("unroll") for (int i = 0; i < 4; ++i) __builtin_amdgcn_global_load_lds((const unsigned*)(bg + (size_t)(32 * i) * K + (KT) * 64), (__attribute__((address_space(3))) unsigned*)(d_ + TILE_BYTES + i * 4096), 16, 0, 0); } while (0)
#define COMPUTE(BUF) do { const char* cur = smem + (BUF) * 2 * TILE_BYTES; _Pragma("unroll") for (int kk = 0; kk < 2; ++kk) { \
        bf16x8 af[MT], bfr[4]; const int ko = kk ? kx1 : kx0; \
        _Pragma("unroll") for (int m = 0; m < MT; ++m) af[m] = *(const bf16x8*)(cur + aoff + m * 16 * 128 + ko); \
        _Pragma("unroll") for (int n = 0; n < 4; ++n) bfr[n] = *(const bf16x8*)(cur + boff + n * 16 * 128 + ko); \
        _Pragma("unroll") for (int m = 0; m < MT; ++m) _Pragma("unroll") for (int n = 0; n < 4; ++n) acc[m][n] = mfma16(bfr[n], af[m], acc[m][n]); } } while (0)
    const int fr = lane & 15, fq = lane >> 4;
    const int aoff = (wr * 16 * MT + fr) * 128;
    const int boff = TILE_BYTES + (wc * 64 + fr) * 128;
    const int kx0 = (fq ^ (fr & 7)) << 4, kx1 = ((4 + fq) ^ (fr & 7)) << 4;
    __syncthreads();
    STAGE(0, 0);
    asm volatile("s_waitcnt vmcnt(0)" ::: "memory");
    __syncthreads();
    for (int kt = 0; kt < nk; ++kt) {
        if (kt + 1 < nk) STAGE((kt + 1) & 1, kt + 1);
        COMPUTE(kt & 1);
        asm volatile("s_waitcnt vmcnt(0)" ::: "memory");
        __syncthreads();
    }
#undef STAGE
#undef COMPUTE
}

__device__ __forceinline__ int win_src_col(int np) {
    if (np < 7168) return np;
    if (np < 9216) return np + 16;
    if (np < 9232) return np - 9216 + 7168;
    return -1;
}
__device__ __forceinline__ void transpose_item(const float* __restrict__ src, int ld, bool is_win, bf16_t* __restrict__ dst, int kt, int nt, char* smem) {
    smem += opaque_zero();
    float* tile = (float*)smem;
    const int tid = opaque_tid();
    __syncthreads();
    const int nn = tid & 63, kq = tid >> 6;
    const int np = nt * 64 + nn;
    const int oc = is_win ? win_src_col(np) : np;
#pragma unroll
    for (int i = 0; i < 16; ++i) {
        const int kk = kq + 4 * i;
        tile[kk * 65 + nn] = oc >= 0 ? src[(size_t)(kt * 64 + kk) * ld + oc] : 0.f;
    }
    __syncthreads();
    const int r = tid >> 2, seg = tid & 3;
    unsigned pk[8];
#pragma unroll
    for (int j = 0; j < 8; ++j) pk[j] = pack2(tile[(seg * 16 + 2 * j) * 65 + r], tile[(seg * 16 + 2 * j + 1) * 65 + r]);
    uint4* d = (uint4*)(dst + (size_t)(nt * 64 + r) * 1024 + kt * 64 + seg * 16);
    d[0] = make_uint4(pk[0], pk[1], pk[2], pk[3]);
    d[1] = make_uint4(pk[4], pk[5], pk[6], pk[7]);
}

__device__ __forceinline__ void mod_item(const Params& p, int it, char* smem) {
    smem += opaque_zero();
    float* sc = (float*)smem;
    const int tid = opaque_tid();
    const int rg = it & 7, cb = (it >> 3) % 12, l = it / 96;
    __syncthreads();
    for (int idx = tid; idx < 17 * 1024; idx += 256) {
        const int r = idx >> 10, k = idx & 1023, row = rg * 17 + r;
        const float c = row < NB ? p.c_prompt[row * 1024 + k] : p.c_sample[(row - NB) * 1024 + k];
        sc[idx] = silu_f(c);
    }
    __syncthreads();
    const int col = cb * 256 + tid;
    float acc[17];
#pragma unroll
    for (int r = 0; r < 17; ++r) acc[r] = 0.f;
    const float* wp = p.w_ada + (size_t)l * 1024 * 3072 + col;
    for (int k = 0; k < 1024; k += 4) {
        const float w0 = wp[(size_t)(k + 0) * 3072], w1 = wp[(size_t)(k + 1) * 3072], w2 = wp[(size_t)(k + 2) * 3072], w3 = wp[(size_t)(k + 3) * 3072];
#pragma unroll
        for (int r = 0; r < 17; ++r) {
            const float4 s = *(const float4*)&sc[r * 1024 + k];
            acc[r] += s.x * w0 + s.y * w1 + s.z * w2 + s.w * w3;
        }
    }
    float* mod = (float*)(p.ws + OFF_MOD);
    const float bb = p.b_ada[l * 3072 + col];
#pragma unroll
    for (int r = 0; r < 17; ++r) mod[((size_t)l * NROWB + rg * 17 + r) * 3072 + col] = acc[r] + bb;
}

constexpr int N_TR_IN = (NPAD / 64) * 16;
constexpr int N_TR_SQ = 16 * 16;
constexpr int N_TR_LAYER = N_TR_IN + 3 * N_TR_SQ;
constexpr int N_P0_TR = DEPTH * N_TR_LAYER;
constexpr int N_P0_MOD = DEPTH * 12 * 8;

__device__ __forceinline__ void phase0(const Params& p, char* smem) {
    for (int it = blockIdx.x; it < N_P0_TR + N_P0_MOD; it += gridDim.x) {
        if (it < N_P0_TR) {
            const int l = it / N_TR_LAYER;
            int r = it % N_TR_LAYER;
            if (r < N_TR_IN) {
                transpose_item(p.w_in + (size_t)l * 1024 * PIN, PIN, true, (bf16_t*)(p.ws + OFF_WT_IN) + (size_t)l * NPAD * 1024, r & 15, r >> 4, smem);
            } else {
                r -= N_TR_IN;
                const int which = r / N_TR_SQ;
                r %= N_TR_SQ;
                const float* src = (which == 0 ? p.w_pa : which == 1 ? p.w_pb : p.w_o) + (size_t)l * 1024 * 1024;
                bf16_t* dst = (bf16_t*)(p.ws + (which == 0 ? OFF_WT_PA : which == 1 ? OFF_WT_PB : OFF_WT_O)) + (size_t)l * 1024 * 1024;
                transpose_item(src, 1024, false, dst, r & 15, r >> 4, smem);
            }
        } else {
            mod_item(p, it - N_P0_TR, smem);
        }
    }
}

__device__ __forceinline__ void phase_rows(const Params& p, int l) {
    const int tid = opaque_tid();
    const int lane = tid & 63;
    const int gw = blockIdx.x * 4 + (tid >> 6), nw = gridDim.x * 4;
    float* X = (float*)(p.ws + OFF_X);
    const float* TT = (const float*)(p.ws + OFF_TT);
    bf16_t* H = (bf16_t*)(p.ws + OFF_H);
    const float* mod = (const float*)(p.ws + OFF_MOD);
    for (int row = gw; row < T; row += nw) {
        float v[16];
        if (l == 0) {
            const float* src = row < TP ? p.x_prompt + (size_t)row * 1024 : p.x_sample + (size_t)(row - TP) * 1024;
#pragma unroll
            for (int j = 0; j < 4; ++j) {
                const float4 t = *(const float4*)(src + j * 256 + lane * 4);
                v[j * 4 + 0] = t.x; v[j * 4 + 1] = t.y; v[j * 4 + 2] = t.z; v[j * 4 + 3] = t.w;
            }
        } else {
            const float* src = TT + (size_t)row * 1024;
            float s = 0.f;
#pragma unroll
            for (int j = 0; j < 4; ++j) {
                const float4 t = *(const float4*)(src + j * 256 + lane * 4);
                v[j * 4 + 0] = t.x; v[j * 4 + 1] = t.y; v[j * 4 + 2] = t.z; v[j * 4 + 3] = t.w;
                s += t.x + t.y + t.z + t.w;
            }
            const float mean = wave_sum(s) * (1.f / 1024.f);
            float q = 0.f;
#pragma unroll
            for (int e = 0; e < 16; ++e) { v[e] -= mean; q += v[e] * v[e]; }
            const float rstd = rsqrtf(wave_sum(q) * (1.f / 1024.f) + LN_EPS);
            const float* g = p.ln_g + (l - 1) * 1024;
            const float* bb = p.ln_b + (l - 1) * 1024;
#pragma unroll
            for (int j = 0; j < 4; ++j) {
                const float4 gg = *(const float4*)(g + j * 256 + lane * 4);
                const float4 be = *(const float4*)(bb + j * 256 + lane * 4);
                v[j * 4 + 0] = v[j * 4 + 0] * rstd * gg.x + be.x;
                v[j * 4 + 1] = v[j * 4 + 1] * rstd * gg.y + be.y;
                v[j * 4 + 2] = v[j * 4 + 2] * rstd * gg.z + be.z;
                v[j * 4 + 3] = v[j * 4 + 3] * rstd * gg.w + be.w;
            }
        }
        if (l == DEPTH) {
            float* dst = row < TP ? p.out + O_Y_P + (size_t)row * 1024 : p.out + O_Y_S + (size_t)(row - TP) * 1024;
#pragma unroll
            for (int j = 0; j < 4; ++j) *(float4*)(dst + j * 256 + lane * 4) = make_float4(v[j * 4], v[j * 4 + 1], v[j * 4 + 2], v[j * 4 + 3]);
            continue;
        }
        if (lane == 0) *(float2*)((float*)(p.ws + OFF_STATS) + (size_t)row * 2) = make_float2(0.f, 0.f);
        {
            float* dst = X + (size_t)row * 1024;
            float s = 0.f;
#pragma unroll
            for (int j = 0; j < 4; ++j) {
                *(float4*)(dst + j * 256 + lane * 4) = make_float4(v[j * 4], v[j * 4 + 1], v[j * 4 + 2], v[j * 4 + 3]);
                s += v[j * 4] + v[j * 4 + 1] + v[j * 4 + 2] + v[j * 4 + 3];
            }
            const float mean = wave_sum(s) * (1.f / 1024.f);
            float q = 0.f;
#pragma unroll
            for (int e = 0; e < 16; ++e) { v[e] -= mean; q += v[e] * v[e]; }
            const float rstd = rsqrtf(wave_sum(q) * (1.f / 1024.f) + LN_EPS);
            const float* mrow = mod + ((size_t)l * NROWB + cond_row(row)) * 3072;
#pragma unroll
            for (int j = 0; j < 4; ++j) {
                const float4 sh = *(const float4*)(mrow + j * 256 + lane * 4);
                const float4 scl = *(const float4*)(mrow + 1024 + j * 256 + lane * 4);
                const float h0 = v[j * 4 + 0] * rstd * (1.f + scl.x) + sh.x;
                const float h1 = v[j * 4 + 1] * rstd * (1.f + scl.y) + sh.y;
                const float h2 = v[j * 4 + 2] * rstd * (1.f + scl.z) + sh.z;
                const float h3 = v[j * 4 + 3] * rstd * (1.f + scl.w) + sh.w;
                *(uint2*)(H + (size_t)row * 1024 + j * 256 + lane * 4) = make_uint2(pack2(h0, h1), pack2(h2, h3));
            }
        }
    }
}

__device__ __forceinline__ void phase_inproj(const Params& p, int l, char* smem) {
    const bf16_t* H = (const bf16_t*)(p.ws + OFF_H);
    const bf16_t* Wt = (const bf16_t*)(p.ws + OFF_WT_IN) + (size_t)l * NPAD * 1024;
    bf16_t* P = (bf16_t*)(p.ws + OFF_P);
    float* BETA = (float*)(p.ws + OFF_BETA);
    float* GLOG = (float*)(p.ws + OFF_GLOG);
    constexpr int nM = T / 128, nN = NPAD / 128, ntiles = nM * nN;
    for (int L = blockIdx.x; L < ntiles; L += gridDim.x) {
        const int tid = opaque_tid();
        const int lane = tid & 63, wid = tid >> 6, wr = wid >> 1, wc = wid & 1, fr = lane & 15, fq = lane >> 4;
        int tm, tn;
        tile_map(L, ntiles, nM, nN, tm, tn);
        f32x4 acc[4][4];
#pragma unroll
        for (int m = 0; m < 4; ++m)
#pragma unroll
            for (int n = 0; n < 4; ++n) acc[m][n] = (f32x4){0.f, 0.f, 0.f, 0.f};
        gemm_core<4>(H + (size_t)tm * 128 * 1024, Wt + (size_t)tn * 128 * 1024, 1024, acc, smem, tid);
        if (tn == 72) {
            if (wc == 0) {
#pragma unroll
                for (int m = 0; m < 4; ++m) {
                    const int row = tm * 128 + wr * 64 + m * 16 + fr;
#pragma unroll
                    for (int r = 0; r < 4; ++r) {
                        const float a = acc[m][0][r];
                        if (fq < 2) {
                            BETA[(size_t)row * 8 + fq * 4 + r] = sigmoid_f(a);
                        } else {
                            const int h = (fq - 2) * 4 + r;
                            GLOG[(size_t)row * 8 + h] = -__expf(p.a_log[l * 8 + h]) * softplus_f(a + p.dt_bias[l * 8 + h]);
                        }
                    }
                }
            }
        } else {
            const int kind = tn < 16 ? 0 : tn < 24 ? 1 : tn < 48 ? 2 : tn < 56 ? 1 : 3;
            char* st = smem + opaque_zero();
#pragma unroll
            for (int m = 0; m < 4; ++m) {
                const int rl = wr * 64 + m * 16 + fr;
#pragma unroll
                for (int n = 0; n < 4; ++n) {
                    const int cl = wc * 64 + n * 16 + fq * 4;
                    float a[4];
#pragma unroll
                    for (int r = 0; r < 4; ++r) {
                        const float x = acc[m][n][r];
                        a[r] = kind == 0 ? gelu_f(x) : kind == 1 ? silu_f(x) : kind == 2 ? x : sigmoid_f(x);
                    }
                    *(uint2*)(st + rl * 272 + cl * 2) = make_uint2(pack2(a[0], a[1]), pack2(a[2], a[3]));
                }
            }
            __syncthreads();
#pragma unroll
            for (int i = 0; i < 8; ++i) {
                const int rl = (tid >> 4) + 16 * i, sg = tid & 15;
                const u32x4 v = *(const u32x4*)(st + rl * 272 + sg * 16);
                *(u32x4*)(P + (size_t)(tm * 128 + rl) * PC + tn * 128 + sg * 8) = v;
                if (tn >= 8 && tn < 16) {
                    const float a0 = lo_bf(v[0]), a1 = hi_bf(v[0]), a2 = lo_bf(v[1]), a3 = hi_bf(v[1]), a4 = lo_bf(v[2]), a5 = hi_bf(v[2]), a6 = lo_bf(v[3]), a7 = hi_bf(v[3]);
                    float sm = ((a0 + a1) + (a2 + a3)) + ((a4 + a5) + (a6 + a7));
                    float sq = ((a0 * a0 + a1 * a1) + (a2 * a2 + a3 * a3)) + ((a4 * a4 + a5 * a5) + (a6 * a6 + a7 * a7));
#pragma unroll
                    for (int o = 1; o < 16; o <<= 1) { sm += __shfl_xor(sm, o); sq += __shfl_xor(sq, o); }
                    if (sg == 0) {
                        float* stp = (float*)(p.ws + OFF_STATS) + (size_t)(tm * 128 + rl) * 2;
                        atomicAdd(stp, sm);
                        atomicAdd(stp + 1, sq);
                    }
                }
            }
        }
    }
}

constexpr int T2_A = 256 * 64, T2_B = 128 * 64, T2_STAGE = T2_A + T2_B;
__device__ __forceinline__ void gemm_core256(const bf16_t* __restrict__ A, const bf16_t* __restrict__ B, const int K,
                                             f32x4 (&acc)[8][4], char* smem, const int tid) {
    const int lane = tid & 63, wid = tid >> 6, wr = wid >> 1, wc = wid & 1, fr = lane & 15, fq = lane >> 4;
    const int srow = tid >> 2, sseg = (tid & 3) ^ ((tid >> 3) & 3);
    const bf16_t* ag = A + (size_t)srow * K + sseg * 8;
    const bf16_t* bg = B + (size_t)srow * K + sseg * 8;
    const int sw = (fq ^ ((fr >> 1) & 3)) << 4;
    const int aoff = (wr * 128 + fr) * 64 + sw;
    const int boff = T2_A + (wc * 64 + fr) * 64 + sw;
    const int nk = K >> 5;
#define STAGE2(BUF, KT) do { char* d_ = smem + (BUF) * T2_STAGE + tid * 16; \
        _Pragma("unroll") for (int i = 0; i < 4; ++i) __builtin_amdgcn_global_load_lds((const unsigned*)(ag + (size_t)(64 * i) * K + (KT) * 32), (__attribute__((address_space(3))) unsigned*)(d_ + i * 4096), 16, 0, 0); \
        _Pragma("unroll") for (int i = 0; i < 2; ++i) __builtin_amdgcn_global_load_lds((const unsigned*)(bg + (size_t)(64 * i) * K + (KT) * 32), (__attribute__((address_space(3))) unsigned*)(d_ + T2_A + i * 4096), 16, 0, 0); } while (0)
    __syncthreads();
    STAGE2(0, 0);
    STAGE2(1, 1);
    asm volatile("s_waitcnt vmcnt(6)" ::: "memory");
    __builtin_amdgcn_s_barrier();
    asm volatile("" ::: "memory");
    int cb = 0, nb = 2;
    for (int kt = 0; kt < nk; ++kt) {
        if (kt + 2 < nk) STAGE2(nb, kt + 2);
        const char* cur = smem + cb * T2_STAGE;
        bf16x8 bfr[4], af[8];
#pragma unroll
        for (int n = 0; n < 4; ++n) bfr[n] = *(const bf16x8*)(cur + boff + n * 16 * 64);
#pragma unroll
        for (int m = 0; m < 8; ++m) af[m] = *(const bf16x8*)(cur + aoff + m * 16 * 64);
        __builtin_amdgcn_sched_barrier(0);
#pragma unroll
        for (int m = 0; m < 8; ++m)
#pragma unroll
            for (int n = 0; n < 4; ++n) acc[m][n] = mfma16(bfr[n], af[m], acc[m][n]);
        if (kt + 2 < nk) asm volatile("s_waitcnt vmcnt(6)" ::: "memory");
        else asm volatile("s_waitcnt vmcnt(0)" ::: "memory");
        __builtin_amdgcn_s_barrier();
        asm volatile("" ::: "memory");
        cb = cb == 2 ? 0 : cb + 1;
        nb = nb == 2 ? 0 : nb + 1;
    }
#undef STAGE2
    __syncthreads();
}

__device__ __forceinline__ void phase_inproj256(const Params& p, int l, char* smem) {
    const bf16_t* H = (const bf16_t*)(p.ws + OFF_H);
    const bf16_t* Wt = (const bf16_t*)(p.ws + OFF_WT_IN) + (size_t)l * NPAD * 1024;
    bf16_t* P = (bf16_t*)(p.ws + OFF_P);
    float* BETA = (float*)(p.ws + OFF_BETA);
    float* GLOG = (float*)(p.ws + OFF_GLOG);
    constexpr int nM = T / 256, nN = NPAD / 128, ntiles = nM * nN;
    for (int L = blockIdx.x; L < ntiles; L += gridDim.x) {
        const int tid = opaque_tid();
        const int lane = tid & 63, wid = tid >> 6, wr = wid >> 1, wc = wid & 1, fr = lane & 15, fq = lane >> 4;
        int tm, tn;
        tile_map<4>(L, ntiles, nM, nN, tm, tn);
        f32x4 acc[8][4];
#pragma unroll
        for (int m = 0; m < 8; ++m)
#pragma unroll
            for (int n = 0; n < 4; ++n) acc[m][n] = (f32x4){0.f, 0.f, 0.f, 0.f};
        gemm_core256(H + (size_t)tm * 256 * 1024, Wt + (size_t)tn * 128 * 1024, 1024, acc, smem, tid);
        if (tn == 72) {
            if (wc == 0) {
#pragma unroll
                for (int m = 0; m < 8; ++m) {
                    const int row = tm * 256 + wr * 128 + m * 16 + fr;
#pragma unroll
                    for (int r = 0; r < 4; ++r) {
                        const float a = acc[m][0][r];
                        if (fq < 2) {
                            BETA[(size_t)row * 8 + fq * 4 + r] = sigmoid_f(a);
                        } else {
                            const int h = (fq - 2) * 4 + r;
                            GLOG[(size_t)row * 8 + h] = -__expf(p.a_log[l * 8 + h]) * softplus_f(a + p.dt_bias[l * 8 + h]);
                        }
                    }
                }
            }
        } else {
            const int kind = tn < 16 ? 0 : tn < 24 ? 1 : tn < 48 ? 2 : tn < 56 ? 1 : 3;
            char* st = smem + opaque_zero();
#pragma unroll
            for (int m = 0; m < 8; ++m) {
                const int rl = wr * 128 + m * 16 + fr;
#pragma unroll
                for (int n = 0; n < 4; ++n) {
                    const int cl = wc * 64 + n * 16 + fq * 4;
                    float a[4];
#pragma unroll
                    for (int r = 0; r < 4; ++r) {
                        const float x = acc[m][n][r];
                        a[r] = kind == 0 ? gelu_f(x) : kind == 1 ? silu_f(x) : kind == 2 ? x : sigmoid_f(x);
                    }
                    *(uint2*)(st + rl * 272 + cl * 2) = make_uint2(pack2(a[0], a[1]), pack2(a[2], a[3]));
                }
            }
            __syncthreads();
#pragma unroll 4
            for (int i = 0; i < 16; ++i) {
                const int rl = (tid >> 4) + 16 * i, sg = tid & 15;
                const u32x4 v = *(const u32x4*)(st + rl * 272 + sg * 16);
                *(u32x4*)(P + (size_t)(tm * 256 + rl) * PC + tn * 128 + sg * 8) = v;
                if (tn >= 8 && tn < 16) {
                    const float a0 = lo_bf(v[0]), a1 = hi_bf(v[0]), a2 = lo_bf(v[1]), a3 = hi_bf(v[1]), a4 = lo_bf(v[2]), a5 = hi_bf(v[2]), a6 = lo_bf(v[3]), a7 = hi_bf(v[3]);
                    float sm = ((a0 + a1) + (a2 + a3)) + ((a4 + a5) + (a6 + a7));
                    float sq = ((a0 * a0 + a1 * a1) + (a2 * a2 + a3 * a3)) + ((a4 * a4 + a5 * a5) + (a6 * a6 + a7 * a7));
#pragma unroll
                    for (int o = 1; o < 16; o <<= 1) { sm += __shfl_xor(sm, o); sq += __shfl_xor(sq, o); }
                    if (sg == 0) {
                        float* stp = (float*)(p.ws + OFF_STATS) + (size_t)(tm * 256 + rl) * 2;
                        atomicAdd(stp, sm);
                        atomicAdd(stp + 1, sq);
                    }
                }
            }
        }
    }
}

__device__ __forceinline__ void phase_merge(const Params& p, int l, char* smem) {
    const bf16_t* YA = (const bf16_t*)(p.ws + OFF_YA);
    const bf16_t* YB = (const bf16_t*)(p.ws + OFF_YB);
    const bf16_t* Wa = (const bf16_t*)(p.ws + OFF_WT_PA) + (size_t)l * 1024 * 1024;
    const bf16_t* Wb = (const bf16_t*)(p.ws + OFF_WT_PB) + (size_t)l * 1024 * 1024;
    const bf16_t* P = (const bf16_t*)(p.ws + OFF_P);
    bf16_t* MM = (bf16_t*)(p.ws + OFF_MM);
    constexpr int RT = 96, MT = 3;
    constexpr int nM = T / RT, nN = 8, ntiles = nM * nN;
    for (int L = blockIdx.x; L < ntiles; L += gridDim.x) {
        const int tid = opaque_tid();
        const int lane = tid & 63, wid = tid >> 6, wr = wid >> 1, wc = wid & 1, fr = lane & 15, fq = lane >> 4;
        int tm, tn;
        tile_map(L, ntiles, nM, nN, tm, tn);
        f32x4 acc[MT][4];
#pragma unroll
        for (int m = 0; m < MT; ++m)
#pragma unroll
            for (int n = 0; n < 4; ++n) acc[m][n] = (f32x4){0.f, 0.f, 0.f, 0.f};
        gemm_core<MT>(YA + (size_t)tm * RT * 1024, Wa + (size_t)tn * 128 * 1024, 1024, acc, smem, tid);
        uint2* park = (uint2*)(p.ws + OFF_PARK) + (size_t)blockIdx.x * 4096 + tid;
#pragma unroll
        for (int m = 0; m < MT; ++m) {
            const int row = tm * RT + wr * 16 * MT + m * 16 + fr;
#pragma unroll
            for (int n = 0; n < 4; ++n) {
                const int col = tn * 128 + wc * 64 + n * 16 + fq * 4;
                const uint2 g = *(const uint2*)(P + (size_t)row * PC + C_GA + col);
                park[(m * 4 + n) * 256] = make_uint2(pack2(acc[m][n][0] * lo_bf(g.x), acc[m][n][1] * hi_bf(g.x)),
                                                     pack2(acc[m][n][2] * lo_bf(g.y), acc[m][n][3] * hi_bf(g.y)));
                acc[m][n] = (f32x4){0.f, 0.f, 0.f, 0.f};
            }
            __builtin_amdgcn_sched_barrier(0);
        }
        gemm_core<MT>(YB + (size_t)tm * RT * 1024, Wb + (size_t)tn * 128 * 1024, 1024, acc, smem, tid);
        char* st = smem + opaque_zero();
#pragma unroll
        for (int m = 0; m < MT; ++m) {
            const int rl = wr * 16 * MT + m * 16 + fr;
            const int row = tm * RT + rl;
#pragma unroll
            for (int n = 0; n < 4; ++n) {
                const int cl = wc * 64 + n * 16 + fq * 4;
                const uint2 g = *(const uint2*)(P + (size_t)row * PC + C_GB + tn * 128 + cl);
                const uint2 pm = park[(m * 4 + n) * 256];
                const float a0 = lo_bf(pm.x) + acc[m][n][0] * lo_bf(g.x);
                const float a1 = hi_bf(pm.x) + acc[m][n][1] * hi_bf(g.x);
                const float a2 = lo_bf(pm.y) + acc[m][n][2] * lo_bf(g.y);
                const float a3 = hi_bf(pm.y) + acc[m][n][3] * hi_bf(g.y);
                *(uint2*)(st + rl * 272 + cl * 2) = make_uint2(pack2(a0, a1), pack2(a2, a3));
            }
            __builtin_amdgcn_sched_barrier(0);
        }
        __syncthreads();
#pragma unroll
        for (int i = 0; i < RT / 16; ++i) {
            const int rl = (tid >> 4) + 16 * i, sg = tid & 15;
            const u32x4 v = *(const u32x4*)(st + rl * 272 + sg * 16);
            *(u32x4*)(MM + (size_t)(tm * RT + rl) * 1024 + tn * 128 + sg * 8) = v;
        }
    }
}

__device__ __forceinline__ void phase_outproj(const Params& p, int l, char* smem) {
    const bf16_t* MM = (const bf16_t*)(p.ws + OFF_MM);
    const bf16_t* Wo = (const bf16_t*)(p.ws + OFF_WT_O) + (size_t)l * 1024 * 1024;
    const float* X = (const float*)(p.ws + OFF_X);
    float* TT = (float*)(p.ws + OFF_TT);
    const float* mod = (const float*)(p.ws + OFF_MOD);
    constexpr int RT = 96, MT = 3;
    constexpr int nM = T / RT, nN = 8, ntiles = nM * nN;
    for (int L = blockIdx.x; L < ntiles; L += gridDim.x) {
        const int tid = opaque_tid();
        const int lane = tid & 63, wid = tid >> 6, wr = wid >> 1, wc = wid & 1, fr = lane & 15, fq = lane >> 4;
        int tm, tn;
        tile_map(L, ntiles, nM, nN, tm, tn);
        f32x4 acc[MT][4];
#pragma unroll
        for (int m = 0; m < MT; ++m)
#pragma unroll
            for (int n = 0; n < 4; ++n) acc[m][n] = (f32x4){0.f, 0.f, 0.f, 0.f};
        gemm_core<MT>(MM + (size_t)tm * RT * 1024, Wo + (size_t)tn * 128 * 1024, 1024, acc, smem, tid);
        float* st = (float*)(smem + opaque_zero());
#pragma unroll
        for (int m = 0; m < MT; ++m)
#pragma unroll
            for (int n = 0; n < 4; ++n) *(f32x4*)(st + (wr * 16 * MT + m * 16 + fr) * 132 + wc * 64 + n * 16 + fq * 4) = acc[m][n];
        __syncthreads();
#pragma unroll 4
        for (int i = 0; i < RT / 8; ++i) {
            const int rl = (tid >> 5) + 8 * i, c4 = (tid & 31) * 4;
            const int row = tm * RT + rl, col = tn * 128 + c4;
            const f32x4 a = *(const f32x4*)(st + rl * 132 + c4);
            const float4 x = *(const float4*)(X + (size_t)row * 1024 + col);
            const float4 g = *(const float4*)(mod + ((size_t)l * NROWB + cond_row(row)) * 3072 + 2048 + col);
            *(float4*)(TT + (size_t)row * 1024 + col) = make_float4(ALPHA_DN * x.x + g.x * a[0], ALPHA_DN * x.y + g.y * a[1],
                                                                    ALPHA_DN * x.z + g.z * a[2], ALPHA_DN * x.w + g.w * a[3]);
        }
    }
}

__device__ __forceinline__ void gmlp_prompt_item(const Params& p, int l, int it, char* smem) {
    smem += opaque_zero();
    const int tid = opaque_tid(), lane = tid & 63, wid = tid >> 6, wr = wid >> 1, wc = wid & 1, fr = lane & 15, fq = lane >> 4;
    const int h = it & 7, n = (it >> 3) & 15, b = it >> 7;
    const int tok0 = b * SEQ + n * 128;
    const bf16_t* P = (const bf16_t*)(p.ws + OFF_P);
    bf16_t* YA = (bf16_t*)(p.ws + OFF_YA);
    bf16_t* Wt = (bf16_t*)smem;
    bf16_t* VnT = Wt + 128 * 136;
    float* mu = (float*)(smem + 2 * 34816);
    float* rs = mu + 128;
    __syncthreads();
    {
        const int t = tid >> 1, half = tid & 1;
        const float* wsrc = p.w_s + ((size_t)(l * 8 + h) * 128 + t) * 128 + half * 64;
#pragma unroll
        for (int i = 0; i < 8; ++i) {
            const float4 w0 = *(const float4*)(wsrc + i * 8);
            const float4 w1 = *(const float4*)(wsrc + i * 8 + 4);
            const int s0 = half * 64 + i * 8;
            const float e0 = s0 + 0 <= t ? w0.x : 0.f, e1 = s0 + 1 <= t ? w0.y : 0.f, e2 = s0 + 2 <= t ? w0.z : 0.f, e3 = s0 + 3 <= t ? w0.w : 0.f;
            const float e4 = s0 + 4 <= t ? w1.x : 0.f, e5 = s0 + 5 <= t ? w1.y : 0.f, e6 = s0 + 6 <= t ? w1.z : 0.f, e7 = s0 + 7 <= t ? w1.w : 0.f;
            *(uint4*)(Wt + t * 136 + s0) = make_uint4(pack2(e0, e1), pack2(e2, e3), pack2(e4, e5), pack2(e6, e7));
        }
        if (half == 0) {
            const float2 sv = *(const float2*)((const float*)(p.ws + OFF_STATS) + (size_t)(tok0 + t) * 2);
            const float mean = sv.x * (1.f / 1024.f);
            const float var = fmaxf(sv.y * (1.f / 1024.f) - mean * mean, 0.f);
            mu[t] = mean;
            rs[t] = rsqrtf(var + LN_EPS);
        }
    }
    __syncthreads();
    {
        const int c = tid & 127, sg = tid >> 7;
        const float gam = p.lnv_g[l * 1024 + h * 128 + c], bet = p.lnv_b[l * 1024 + h * 128 + c];
        const bf16_t* src = P + (size_t)tok0 * PC + C_VA + h * 128 + c;
        float* cv = p.out + O_CV_P + ((size_t)(l * NB + b) * 128) * 1024 + h * 128 + c;
        bf16_t rw[64];
#pragma unroll
        for (int q = 0; q < 64; ++q) rw[q] = src[(size_t)(sg * 64 + q) * PC];
        __builtin_amdgcn_sched_barrier(0);
#pragma unroll
        for (int oct = 0; oct < 8; ++oct) {
            const int s0 = sg * 64 + oct * 8;
            float e[8];
#pragma unroll
            for (int j = 0; j < 8; ++j) {
                const float x = bf2f(rw[oct * 8 + j]);
                e[j] = (x - mu[s0 + j]) * rs[s0 + j] * gam + bet;
            }
            if (n == 15) {
#pragma unroll
                for (int j = 0; j < 8; ++j) cv[(size_t)(s0 + j) * 1024] = e[j];
            }
            *(uint4*)(VnT + c * 136 + s0) = make_uint4(pack2(e[0], e[1]), pack2(e[2], e[3]), pack2(e[4], e[5]), pack2(e[6], e[7]));
        }
    }
    __syncthreads();
    f32x4 acc[4][4];
#pragma unroll
    for (int m = 0; m < 4; ++m)
#pragma unroll
        for (int nn = 0; nn < 4; ++nn) acc[m][nn] = (f32x4){0.f, 0.f, 0.f, 0.f};
#pragma unroll
    for (int ks = 0; ks < 4; ++ks) {
        bf16x8 af[4], bfr[4];
#pragma unroll
        for (int m = 0; m < 4; ++m) af[m] = *(const bf16x8*)(Wt + (wr * 64 + m * 16 + fr) * 136 + ks * 32 + fq * 8);
#pragma unroll
        for (int nn = 0; nn < 4; ++nn) bfr[nn] = *(const bf16x8*)(VnT + (wc * 64 + nn * 16 + fr) * 136 + ks * 32 + fq * 8);
#pragma unroll
        for (int m = 0; m < 4; ++m)
#pragma unroll
            for (int nn = 0; nn < 4; ++nn) acc[m][nn] = mfma16(bfr[nn], af[m], acc[m][nn]);
    }
#pragma unroll
    for (int m = 0; m < 4; ++m) {
        const int t = wr * 64 + m * 16 + fr;
        const float bs = p.b_s[(l * 8 + h) * 128 + t];
        const bf16_t* prow = P + (size_t)(tok0 + t) * PC + h * 128;
#pragma unroll
        for (int nn = 0; nn < 4; ++nn) {
            const int c = wc * 64 + nn * 16 + fq * 4;
            const uint2 u = *(const uint2*)(prow + C_UA + c);
            const uint2 z = *(const uint2*)(prow + C_ZA + c);
            const float y0 = lo_bf(u.x) * (acc[m][nn][0] + bs) * lo_bf(z.x);
            const float y1 = hi_bf(u.x) * (acc[m][nn][1] + bs) * hi_bf(z.x);
            const float y2 = lo_bf(u.y) * (acc[m][nn][2] + bs) * lo_bf(z.y);
            const float y3 = hi_bf(u.y) * (acc[m][nn][3] + bs) * hi_bf(z.y);
            *(uint2*)(YA + (size_t)(tok0 + t) * 1024 + h * 128 + c) = make_uint2(pack2(y0, y1), pack2(y2, y3));
        }
    }
}

__device__ __forceinline__ void gmlp_sample_item(const Params& p, int l, int b, char* smem) {
    smem += opaque_zero();
    const int tid = opaque_tid(), lane = tid & 63, wid = tid >> 6;
    const int tok0 = TP + b * DSQ;
    const bf16_t* P = (const bf16_t*)(p.ws + OFF_P);
    bf16_t* YA = (bf16_t*)(p.ws + OFF_YA);
    float* red = (float*)smem;
    __syncthreads();
    const int c4 = tid * 4;
    float x[4][4];
    float s[4], ss[4];
#pragma unroll
    for (int t = 0; t < 4; ++t) {
        const uint2 u = *(const uint2*)(P + (size_t)(tok0 + t) * PC + C_VA + c4);
        x[t][0] = lo_bf(u.x); x[t][1] = hi_bf(u.x); x[t][2] = lo_bf(u.y); x[t][3] = hi_bf(u.y);
        s[t] = wave_sum(x[t][0] + x[t][1] + x[t][2] + x[t][3]);
        ss[t] = wave_sum(x[t][0] * x[t][0] + x[t][1] * x[t][1] + x[t][2] * x[t][2] + x[t][3] * x[t][3]);
    }
    if (lane == 0) {
#pragma unroll
        for (int t = 0; t < 4; ++t) { red[wid * 8 + t] = s[t]; red[wid * 8 + 4 + t] = ss[t]; }
    }
    __syncthreads();
    const float4 gam = *(const float4*)(p.lnv_g + l * 1024 + c4);
    const float4 bet = *(const float4*)(p.lnv_b + l * 1024 + c4);
    float vn[4][4];
#pragma unroll
    for (int t = 0; t < 4; ++t) {
        const float st = red[t] + red[8 + t] + red[16 + t] + red[24 + t];
        const float sst = red[4 + t] + red[12 + t] + red[20 + t] + red[28 + t];
        const float mean = st * (1.f / 1024.f);
        const float rstd = rsqrtf(fmaxf(sst * (1.f / 1024.f) - mean * mean, 0.f) + LN_EPS);
        vn[t][0] = (x[t][0] - mean) * rstd * gam.x + bet.x;
        vn[t][1] = (x[t][1] - mean) * rstd * gam.y + bet.y;
        vn[t][2] = (x[t][2] - mean) * rstd * gam.z + bet.z;
        vn[t][3] = (x[t][3] - mean) * rstd * gam.w + bet.w;
        *(float4*)(p.out + O_CV_S + ((size_t)(l * DBT + b) * DSQ + t) * 1024 + c4) = make_float4(vn[t][0], vn[t][1], vn[t][2], vn[t][3]);
    }
    const int h = c4 >> 7;
#pragma unroll
    for (int t = 0; t < 4; ++t) {
        const float bs = p.b_s[(l * 8 + h) * 128 + t];
        float a[4] = {bs, bs, bs, bs};
#pragma unroll
        for (int sidx = 0; sidx <= t; ++sidx) {
            const float w = p.w_s[((size_t)(l * 8 + h) * 128 + t) * 128 + sidx];
#pragma unroll
            for (int e = 0; e < 4; ++e) a[e] += w * vn[sidx][e];
        }
        const uint2 u = *(const uint2*)(P + (size_t)(tok0 + t) * PC + C_UA + c4);
        const uint2 z = *(const uint2*)(P + (size_t)(tok0 + t) * PC + C_ZA + c4);
        const float y0 = lo_bf(u.x) * a[0] * lo_bf(z.x), y1 = hi_bf(u.x) * a[1] * hi_bf(z.x);
        const float y2 = lo_bf(u.y) * a[2] * lo_bf(z.y), y3 = hi_bf(u.y) * a[3] * hi_bf(z.y);
        *(uint2*)(YA + (size_t)(tok0 + t) * 1024 + c4) = make_uint2(pack2(y0, y1), pack2(y2, y3));
    }
}

__device__ __forceinline__ void conv_state_item(const Params& p, int l, int it) {
    const bf16_t* P = (const bf16_t*)(p.ws + OFF_P);
    const bool pr = it < NB;
    const int b = pr ? it : it - NB;
    const int tokb = pr ? b * SEQ + SEQ - 3 : TP + b * DSQ + 1;
    float* dst = pr ? p.out + O_CONV_P + (size_t)(l * NB + b) * 3 * 3072 : p.out + O_CONV_S + (size_t)(l * DBT + b) * 3 * 3072;
    for (int idx = opaque_tid(); idx < 3 * 768; idx += 256) {
        const int j = idx / 768, c = (idx % 768) * 4;
        const uint2 u = *(const uint2*)(P + (size_t)(tokb + j) * PC + C_Q + c);
        *(float4*)(dst + j * 3072 + c) = make_float4(lo_bf(u.x), hi_bf(u.x), lo_bf(u.y), hi_bf(u.y));
    }
}

__device__ __forceinline__ void gdn_sample_item(const Params& p, int l, int it, char* smem) {
    smem += opaque_zero();
    const int tid = opaque_tid(), lane = tid & 63, wid = tid >> 6;
    const int b = it >> 3, h = it & 7;
    const int tok0 = TP + b * DSQ;
    const bf16_t* P = (const bf16_t*)(p.ws + OFF_P);
    const float* BETA = (const float*)(p.ws + OFF_BETA);
    const float* GLOG = (const float*)(p.ws + OFF_GLOG);
    bf16_t* YB = (bf16_t*)(p.ws + OFF_YB);
    float* qs = (float*)smem;
    float* ks = qs + 512;
    float* vs = ks + 512;
    float* red = vs + 512;
    float* part = red + 16;
    float* opart = part + 1024;
    float* red2 = opart + 1024;
    __syncthreads();
    const int j = tid & 127;
    const bool isk = tid >= 128;
    float y1[4], y2[4];
    {
        const int cq = (isk ? 1024 : 0) + h * 128 + j;
        const float* sc = p.state_conv + (size_t)(l * DBT + b) * 3 * 3072;
        const float* cw = p.conv_w + (size_t)l * 4 * 3072;
        float xr[7];
#pragma unroll
        for (int r = 0; r < 3; ++r) xr[r] = sc[r * 3072 + cq];
#pragma unroll
        for (int t = 0; t < 4; ++t) xr[3 + t] = bf2f(P[(size_t)(tok0 + t) * PC + C_Q + cq]);
        const float w0 = cw[cq], w1 = cw[3072 + cq], w2 = cw[2 * 3072 + cq], w3 = cw[3 * 3072 + cq];
#pragma unroll
        for (int t = 0; t < 4; ++t) y1[t] = silu_f(w0 * xr[t] + w1 * xr[t + 1] + w2 * xr[t + 2] + w3 * xr[t + 3]);
        if (!isk) {
            const int cv = 2048 + h * 128 + j;
#pragma unroll
            for (int r = 0; r < 3; ++r) xr[r] = sc[r * 3072 + cv];
#pragma unroll
            for (int t = 0; t < 4; ++t) xr[3 + t] = bf2f(P[(size_t)(tok0 + t) * PC + C_Q + cv]);
            const float v0 = cw[cv], v1 = cw[3072 + cv], v2 = cw[2 * 3072 + cv], v3 = cw[3 * 3072 + cv];
#pragma unroll
            for (int t = 0; t < 4; ++t) y2[t] = silu_f(v0 * xr[t] + v1 * xr[t + 1] + v2 * xr[t + 2] + v3 * xr[t + 3]);
        }
    }
#pragma unroll
    for (int t = 0; t < 4; ++t) {
        const float s = wave_sum(y1[t] * y1[t]);
        if (lane == 0) red[wid * 4 + t] = s;
    }
    __syncthreads();
#pragma unroll
    for (int t = 0; t < 4; ++t) {
        const float tot = isk ? red[8 + t] + red[12 + t] : red[t] + red[4 + t];
        const float rn = rsqrtf(tot + NORM_EPS);
        if (isk) ks[t * 128 + j] = y1[t] * rn;
        else { qs[t * 128 + j] = y1[t] * rn * 0.08838834764831845f; vs[t * 128 + j] = y2[t]; }
    }
    __syncthreads();
    const int vcol = j, kh = tid >> 7;
    float S[64];
    const float* s0 = p.state_ssm + ((size_t)(l * DBT + b) * 8 + h) * 16384 + (size_t)(kh * 64) * 128 + vcol;
#pragma unroll
    for (int kk = 0; kk < 64; ++kk) S[kk] = s0[kk * 128];
#pragma unroll
    for (int t = 0; t < 4; ++t) {
        const float a = __expf(GLOG[(size_t)(tok0 + t) * 8 + h]);
        const float bt = BETA[(size_t)(tok0 + t) * 8 + h];
        float r0 = 0.f, r1 = 0.f;
#pragma unroll
        for (int kk = 0; kk < 64; kk += 4) {
            const float4 kv = *(const float4*)&ks[t * 128 + kh * 64 + kk];
            r0 += S[kk] * kv.x + S[kk + 2] * kv.z;
            r1 += S[kk + 1] * kv.y + S[kk + 3] * kv.w;
        }
        part[(t * 2 + kh) * 128 + vcol] = r0 + r1;
        __syncthreads();
        const float dlt = bt * (vs[t * 128 + vcol] - a * (part[(t * 2) * 128 + vcol] + part[(t * 2 + 1) * 128 + vcol]));
        float o0 = 0.f, o1 = 0.f;
#pragma unroll
        for (int kk = 0; kk < 64; kk += 4) {
            const float4 kv = *(const float4*)&ks[t * 128 + kh * 64 + kk];
            const float4 qv = *(const float4*)&qs[t * 128 + kh * 64 + kk];
            S[kk] = a * S[kk] + kv.x * dlt;
            S[kk + 1] = a * S[kk + 1] + kv.y * dlt;
            S[kk + 2] = a * S[kk + 2] + kv.z * dlt;
            S[kk + 3] = a * S[kk + 3] + kv.w * dlt;
            o0 += S[kk] * qv.x + S[kk + 2] * qv.z;
            o1 += S[kk + 1] * qv.y + S[kk + 3] * qv.w;
        }
        opart[(t * 2 + kh) * 128 + vcol] = o0 + o1;
    }
    float* sout = p.out + O_SSM_S + ((size_t)(l * DBT + b) * 8 + h) * 16384 + (size_t)(kh * 64) * 128 + vcol;
#pragma unroll
    for (int kk = 0; kk < 64; ++kk) sout[kk * 128] = S[kk];
    __syncthreads();
    float o[4];
    if (tid < 128) {
#pragma unroll
        for (int t = 0; t < 4; ++t) {
            o[t] = opart[(t * 2) * 128 + vcol] + opart[(t * 2 + 1) * 128 + vcol];
            const float s = wave_sum(o[t] * o[t]);
            if (lane == 0) red2[wid * 4 + t] = s;
        }
    }
    __syncthreads();
    if (tid < 128) {
        const float gn = p.onorm_g[l * 128 + vcol];
#pragma unroll
        for (int t = 0; t < 4; ++t) {
            const float rinv = rsqrtf((red2[t] + red2[4 + t]) * (1.f / 128.f) + NORM_EPS);
            const float zs = bf2f(P[(size_t)(tok0 + t) * PC + C_ZB + h * 128 + vcol]);
            YB[(size_t)(tok0 + t) * 1024 + h * 128 + vcol] = f2bf(o[t] * rinv * gn * zs);
        }
    }
}

__device__ __forceinline__ void gdn_prep_item(const Params& p, int l, int it, char* smem) {
    smem += opaque_zero();
    const int tid = opaque_tid(), lane = tid & 63, wid = tid >> 6, fr = lane & 15, fq = lane >> 4;
    const int n = it & 31, h = (it >> 5) & 7, b = it >> 8;
    const int tok0 = b * SEQ + n * 64;
    const bf16_t* P = (const bf16_t*)(p.ws + OFF_P);
    const float* BETA = (const float*)(p.ws + OFF_BETA);
    const float* GLOG = (const float*)(p.ws + OFF_GLOG);
    float* Ug = (float*)(p.ws + OFF_U) + (size_t)it * 8192;
    bf16_t* Wg = (bf16_t*)(p.ws + OFF_WG) + (size_t)it * 8192;
    bf16_t* QGg = (bf16_t*)(p.ws + OFF_QG) + (size_t)it * 8192;
    bf16_t* KDTg = (bf16_t*)(p.ws + OFF_KDT) + (size_t)it * 8192;
    bf16_t* QKg = (bf16_t*)(p.ws + OFF_QK) + (size_t)it * 4096;
    float* EGg = (float*)(p.ws + OFF_EG);
    bf16_t* Qs = (bf16_t*)smem;
    bf16_t* Ks = Qs + 64 * 136;
    bf16_t* Kbs = Ks + 64 * 136;
    float* Am = (float*)(smem + 3 * 17408);
    float* gcs = Am + 64 * 68;
    float* betas = gcs + 64;
    float* red = betas + 64;
    __syncthreads();
    const int j = tid & 127;
    const bool isk = tid >= 128;
    float val[64];
    char* R1 = smem + 2 * 17408;
    char* R2 = smem + 3 * 17408;
    {
        const bf16_t* pb = P + ((ptrdiff_t)tok0 - 3) * PC + C_Q + h * 128;
        u32x4 tv[9];
#pragma unroll
        for (int it9 = 0; it9 < 9; ++it9) {
            const int c = tid + 256 * it9;
            const int cc = c < 67 * 32 ? c : 67 * 32 - 1;
            const int r = cc >> 5, sg = cc & 31;
            const bool ok = n > 0 || r >= 3;
            const u32x4 v = *(const u32x4*)(pb + (ptrdiff_t)(ok ? r : 3) * PC + (sg >> 4) * 1024 + (sg & 15) * 8);
            tv[it9] = ok ? v : (u32x4){0u, 0u, 0u, 0u};
        }
        __builtin_amdgcn_sched_barrier(0);
        if (tid < 64) {
            float g = GLOG[(size_t)(tok0 + tid) * 8 + h];
    #pragma unroll
            for (int o = 1; o < 64; o <<= 1) {
                const float t = __shfl_up(g, o);
                if (lane >= o) g += t;
            }
            gcs[tid] = g;
            betas[tid] = BETA[(size_t)(tok0 + tid) * 8 + h];
        }
        __builtin_amdgcn_sched_barrier(0);
#pragma unroll
        for (int it9 = 0; it9 < 9; ++it9) {
            const int c = tid + 256 * it9;
            if (c < 67 * 32) *(u32x4*)(R1 + (c >> 5) * 512 + (c & 31) * 16) = tv[it9];
        }
    }
    __syncthreads();
    {
        const int cq = (isk ? 1024 : 0) + h * 128 + j;
        const float* cw = p.conv_w + (size_t)l * 4 * 3072;
        const float w0 = cw[cq], w1 = cw[3072 + cq], w2 = cw[2 * 3072 + cq], w3 = cw[3 * 3072 + cq];
        const bf16_t* col = (const bf16_t*)(R1 + (isk ? 256 : 0)) + j;
        float x3 = bf2f(col[0]), x2 = bf2f(col[256]), x1 = bf2f(col[512]);
#pragma unroll
        for (int i = 0; i < 64; ++i) {
            const float x0 = bf2f(col[(i + 3) * 256]);
            val[i] = silu_f(w0 * x3 + w1 * x2 + w2 * x1 + w3 * x0);
            x3 = x2; x2 = x1; x1 = x0;
            if ((i & 15) == 15) __builtin_amdgcn_sched_barrier(0);
        }
    }
#pragma unroll
    for (int i = 0; i < 64; ++i) {
        const float s = wave_sum(val[i] * val[i]);
        if (lane == 0) red[wid * 64 + i] = s;
        if ((i & 7) == 7) __builtin_amdgcn_sched_barrier(0);
    }
    __syncthreads();
    const float glast = gcs[63];
    {
        const bf16_t* pb = P + ((ptrdiff_t)tok0 - 3) * PC + C_Q + 2048 + h * 128;
        u32x4 tv[5];
#pragma unroll
        for (int it5 = 0; it5 < 5; ++it5) {
            const int c = tid + 256 * it5;
            const int cc = c < 67 * 16 ? c : 67 * 16 - 1;
            const int r = cc >> 4, sg = cc & 15;
            const bool ok = n > 0 || r >= 3;
            const u32x4 v = *(const u32x4*)(pb + (ptrdiff_t)(ok ? r : 3) * PC + sg * 8);
            tv[it5] = ok ? v : (u32x4){0u, 0u, 0u, 0u};
        }
        __builtin_amdgcn_sched_barrier(0);
#pragma unroll
        for (int it5 = 0; it5 < 5; ++it5) {
            const int c = tid + 256 * it5;
            if (c < 67 * 16) *(u32x4*)(R2 + (c >> 4) * 256 + (c & 15) * 16) = tv[it5];
        }
    }
    if (!isk) {
#pragma unroll
        for (int i = 0; i < 64; ++i) {
            const float rn = rsqrtf(red[i] + red[64 + i] + NORM_EPS);
            const float qv = val[i] * rn * 0.08838834764831845f;
            Qs[i * 136 + j] = f2bf(qv);
            QGg[i * 128 + perm32(j)] = f2bf(qv * __expf(gcs[i]));
            if ((i & 7) == 7) __builtin_amdgcn_sched_barrier(0);
        }
    } else {
        unsigned pk[32];
#pragma unroll
        for (int i = 0; i < 64; ++i) {
            const float rn = rsqrtf(red[128 + i] + red[192 + i] + NORM_EPS);
            const float kv = val[i] * rn;
            const float gi = gcs[i], bi = betas[i];
            Ks[i * 136 + j] = f2bf(kv);
            Kbs[i * 136 + j] = f2bf(kv * bi);
            const bf16_t kd = f2bf(kv * __expf(glast - gi));
            if (i & 1) pk[perm32(i) >> 1] |= ((unsigned)kd) << 16; else pk[perm32(i) >> 1] = kd;
            val[i] = kv * bi * __expf(gi);
            if ((i & 7) == 7) __builtin_amdgcn_sched_barrier(0);
        }
#pragma unroll
        for (int i = 0; i < 8; ++i) *(uint4*)(KDTg + j * 64 + i * 8) = make_uint4(pk[i * 4], pk[i * 4 + 1], pk[i * 4 + 2], pk[i * 4 + 3]);
    }
    __syncthreads();
    if (!isk) {
        const int cv = 2048 + h * 128 + j;
        const float* cw = p.conv_w + (size_t)l * 4 * 3072;
        const float w0 = cw[cv], w1 = cw[3072 + cv], w2 = cw[2 * 3072 + cv], w3 = cw[3 * 3072 + cv];
        const bf16_t* col = (const bf16_t*)R2 + j;
        float x3 = bf2f(col[0]), x2 = bf2f(col[128]), x1 = bf2f(col[256]);
#pragma unroll
        for (int i = 0; i < 64; ++i) {
            const float x0 = bf2f(col[(i + 3) * 128]);
            val[i] = silu_f(w0 * x3 + w1 * x2 + w2 * x1 + w3 * x0) * betas[i];
            x3 = x2; x2 = x1; x1 = x0;
            if ((i & 15) == 15) __builtin_amdgcn_sched_barrier(0);
        }
    }
    __syncthreads();
    {
        f32x4 aA[4], aQ[4];
#pragma unroll
        for (int nt = 0; nt < 4; ++nt) { aA[nt] = (f32x4){0.f, 0.f, 0.f, 0.f}; aQ[nt] = (f32x4){0.f, 0.f, 0.f, 0.f}; }
#pragma unroll
        for (int ksi = 0; ksi < 4; ++ksi) {
            const bf16x8 fa = *(const bf16x8*)(Kbs + (wid * 16 + fr) * 136 + ksi * 32 + fq * 8);
            const bf16x8 fqv = *(const bf16x8*)(Qs + (wid * 16 + fr) * 136 + ksi * 32 + fq * 8);
#pragma unroll
            for (int nt = 0; nt < 4; ++nt) {
                const bf16x8 fb = *(const bf16x8*)(Ks + (nt * 16 + fr) * 136 + ksi * 32 + fq * 8);
                aA[nt] = mfma16(fa, fb, aA[nt]);
                aQ[nt] = mfma16(fqv, fb, aQ[nt]);
            }
        }
#pragma unroll
        for (int nt = 0; nt < 4; ++nt) {
            const int jc = nt * 16 + fr;
            const float gj = gcs[jc];
#pragma unroll
            for (int r = 0; r < 4; ++r) {
                const int i = wid * 16 + fq * 4 + r;
                const float dec = jc <= i ? __expf(gcs[i] - gj) : 0.f;
                Am[i * 68 + jc] = jc < i ? aA[nt][r] * dec : 0.f;
                QKg[i * 64 + perm32(jc)] = f2bf(aQ[nt][r] * dec);
            }
        }
    }
    __syncthreads();
#pragma unroll
    for (int i = 1; i < 64; ++i) {
        float s0 = 0.f, s1 = 0.f, s2 = 0.f, s3 = 0.f;
#pragma unroll
        for (int j4 = 0; j4 < (i + 3) / 4; ++j4) {
            const float4 a = *(const float4*)&Am[i * 68 + j4 * 4];
            s0 += a.x * val[j4 * 4];
            s1 += a.y * val[j4 * 4 + 1];
            s2 += a.z * val[j4 * 4 + 2];
            s3 += a.w * val[j4 * 4 + 3];
        }
        val[i] -= (s0 + s1) + (s2 + s3);
        if ((i & 3) == 3) __builtin_amdgcn_sched_barrier(0);
    }
    if (!isk) {
#pragma unroll
        for (int i = 0; i < 64; i += 4)
            *(float4*)(Ug + (((i >> 4) * 8 + (j >> 4)) * 64 + ((i >> 2) & 3) * 16 + (j & 15)) * 4) = make_float4(val[i], val[i + 1], val[i + 2], val[i + 3]);
    } else {
        const int pj = perm32(j);
#pragma unroll
        for (int i = 0; i < 64; ++i) Wg[i * 128 + pj] = f2bf(val[i]);
    }
    if (tid == 0) EGg[it] = __expf(glast);
}

__device__ __forceinline__ void gdn_scan_item(const Params& p, int l, int bh, char* smem) {
    smem += opaque_zero();
    const int tid0 = opaque_tid();
    const int b = bh >> 3, h = bh & 7;
    constexpr int WBY = 64 * 272, BUFB = WBY + 128 * 128;
    const float* EGg = (const float*)(p.ws + OFF_EG);
    f32x4 S[8][2];
#pragma unroll
    for (int mt = 0; mt < 8; ++mt) { S[mt][0] = (f32x4){0.f, 0.f, 0.f, 0.f}; S[mt][1] = (f32x4){0.f, 0.f, 0.f, 0.f}; }
    u32x4 stg[8];
    f32x4 ucur[4][2];
    {
        const size_t item = (size_t)bh * 32;
        const bf16_t* Wp = (const bf16_t*)(p.ws + OFF_WG) + item * 8192;
        const bf16_t* KDTp = (const bf16_t*)(p.ws + OFF_KDT) + item * 8192;
        const float* Up = (const float*)(p.ws + OFF_U) + item * 8192;
        const int lane = tid0 & 63, w = tid0 >> 6, fr = lane & 15, fq = lane >> 4;
#pragma unroll
        for (int i = 0; i < 4; ++i) {
            stg[i] = ldg_b<u32x4>(Wp, 16u * (unsigned)(tid0 + 256 * i));
            stg[4 + i] = ldg_b<u32x4>(KDTp, 16u * (unsigned)(tid0 + 256 * i));
        }
#pragma unroll
        for (int mt = 0; mt < 4; ++mt)
#pragma unroll
            for (int nt = 0; nt < 2; ++nt) ucur[mt][nt] = ldg_b<f32x4>(Up, 16u * (unsigned)((mt * 8 + w * 2 + nt) * 64 + lane));
        __syncthreads();
#pragma unroll
        for (int i = 0; i < 4; ++i) {
            const int c = tid0 + 256 * i;
            *(u32x4*)(smem + (c >> 4) * 272 + (c & 15) * 16) = stg[i];
            *(u32x4*)(smem + WBY + (c >> 3) * 128 + ((((c & 7) ^ ((c >> 3) & 7))) << 4)) = stg[4 + i];
        }
        __syncthreads();
    }
    for (int n = 0; n < 32; ++n) {
        int tid = tid0;
        asm volatile("" : "+v"(tid));
        const int lane = tid & 63, w = tid >> 6, fr = lane & 15, fq = lane >> 4;
        const char* cur = smem + (n & 1) * BUFB;
        const size_t item = (size_t)bh * 32 + n;
        const float eg = EGg[item];
        bf16_t* SBp = (bf16_t*)(p.ws + OFF_SB) + item * 16384;
        bf16_t* VNp = (bf16_t*)(p.ws + OFF_VN) + item * 8192;
        if (n + 1 < 32) {
            const bf16_t* Wp = (const bf16_t*)(p.ws + OFF_WG) + (item + 1) * 8192;
            const bf16_t* KDTp = (const bf16_t*)(p.ws + OFF_KDT) + (item + 1) * 8192;
#pragma unroll
            for (int i = 0; i < 4; ++i) {
                stg[i] = ldg_b<u32x4>(Wp, 16u * (unsigned)(tid + 256 * i));
                stg[4 + i] = ldg_b<u32x4>(KDTp, 16u * (unsigned)(tid + 256 * i));
            }
        }
        bf16x8 sf[4][2];
#pragma unroll
        for (int pp = 0; pp < 4; ++pp)
#pragma unroll
            for (int nt = 0; nt < 2; ++nt) {
                u32x4 t;
                t[0] = pack2(S[2 * pp][nt][0], S[2 * pp][nt][1]);
                t[1] = pack2(S[2 * pp][nt][2], S[2 * pp][nt][3]);
                t[2] = pack2(S[2 * pp + 1][nt][0], S[2 * pp + 1][nt][1]);
                t[3] = pack2(S[2 * pp + 1][nt][2], S[2 * pp + 1][nt][3]);
                stg_b<u32x4>(SBp, 16u * (unsigned)((pp * 8 + w * 2 + nt) * 64 + lane), t);
                sf[pp][nt] = (bf16x8)t;
            }
        bf16x8 vf[2][2];
#pragma unroll
        for (int q = 0; q < 2; ++q) {
            u32x4 t0, t1;
#pragma unroll
            for (int hh = 0; hh < 2; ++hh) {
                const int mt = 2 * q + hh;
                f32x4 a0 = (f32x4){0.f, 0.f, 0.f, 0.f}, a1 = a0;
#pragma unroll
                for (int pp = 0; pp < 4; ++pp) {
                    const bf16x8 wf = *(const bf16x8*)(cur + (mt * 16 + fr) * 272 + pp * 64 + fq * 16);
                    a0 = mfma16(wf, sf[pp][0], a0);
                    a1 = mfma16(wf, sf[pp][1], a1);
                }
                const f32x4 v0 = ucur[mt][0] - a0, v1 = ucur[mt][1] - a1;
                t0[2 * hh] = pack2(v0[0], v0[1]); t0[2 * hh + 1] = pack2(v0[2], v0[3]);
                t1[2 * hh] = pack2(v1[0], v1[1]); t1[2 * hh + 1] = pack2(v1[2], v1[3]);
            }
            stg_b<u32x4>(VNp, 16u * (unsigned)((q * 8 + w * 2) * 64 + lane), t0);
            stg_b<u32x4>(VNp, 16u * (unsigned)((q * 8 + w * 2 + 1) * 64 + lane), t1);
            vf[q][0] = (bf16x8)t0;
            vf[q][1] = (bf16x8)t1;
        }
        if (n + 1 < 32) {
            const float* Up = (const float*)(p.ws + OFF_U) + (item + 1) * 8192;
#pragma unroll
            for (int mt = 0; mt < 4; ++mt)
#pragma unroll
                for (int nt = 0; nt < 2; ++nt) ucur[mt][nt] = ldg_b<f32x4>(Up, 16u * (unsigned)((mt * 8 + w * 2 + nt) * 64 + lane));
        }
#pragma unroll
        for (int mt = 0; mt < 8; ++mt) {
            S[mt][0] *= eg;
            S[mt][1] *= eg;
#pragma unroll
            for (int q = 0; q < 2; ++q) {
                const bf16x8 kf = *(const bf16x8*)(cur + WBY + (mt * 16 + fr) * 128 + (((q * 4 + fq) ^ (fr & 7)) << 4));
                S[mt][0] = mfma16(kf, vf[q][0], S[mt][0]);
                S[mt][1] = mfma16(kf, vf[q][1], S[mt][1]);
            }
        }
        if (n + 1 < 32) {
            char* nxt = smem + ((n + 1) & 1) * BUFB;
#pragma unroll
            for (int i = 0; i < 4; ++i) {
                const int c = tid + 256 * i;
                *(u32x4*)(nxt + (c >> 4) * 272 + (c & 15) * 16) = stg[i];
                *(u32x4*)(nxt + WBY + (c >> 3) * 128 + ((((c & 7) ^ ((c >> 3) & 7))) << 4)) = stg[4 + i];
            }
        }
        __syncthreads();
    }
    const int lane = tid0 & 63, w = tid0 >> 6, fr = lane & 15, fq = lane >> 4;
    float* so = p.out + O_SSM_P + ((size_t)(l * NB + b) * 8 + h) * 16384;
#pragma unroll
    for (int mt = 0; mt < 8; ++mt)
#pragma unroll
        for (int nt = 0; nt < 2; ++nt)
#pragma unroll
            for (int r = 0; r < 4; ++r) so[(mt * 16 + fq * 4 + r) * 128 + w * 32 + nt * 16 + fr] = S[mt][nt][r];
}

__device__ __forceinline__ void gdn_out_item(const Params& p, int l, int it) {
    const int tid = opaque_tid(), lane = tid & 63, w = tid >> 6, fr = lane & 15, fq = lane >> 4;
    const int n = it & 31, h = (it >> 5) & 7, b = it >> 8;
    const bf16_t* QGp = (const bf16_t*)(p.ws + OFF_QG) + (size_t)it * 8192;
    const bf16_t* QKp = (const bf16_t*)(p.ws + OFF_QK) + (size_t)it * 4096;
    const bf16_t* SBp = (const bf16_t*)(p.ws + OFF_SB) + (size_t)it * 16384;
    const bf16_t* VNp = (const bf16_t*)(p.ws + OFF_VN) + (size_t)it * 8192;
    const bf16_t* P = (const bf16_t*)(p.ws + OFF_P);
    bf16_t* YB = (bf16_t*)(p.ws + OFF_YB);
    bf16x8 qg[4], qk[2];
#pragma unroll
    for (int pp = 0; pp < 4; ++pp) qg[pp] = ldg_b<bf16x8>(QGp, 2u * (unsigned)((w * 16 + fr) * 128 + pp * 32 + fq * 8));
#pragma unroll
    for (int q = 0; q < 2; ++q) qk[q] = ldg_b<bf16x8>(QKp, 2u * (unsigned)((w * 16 + fr) * 64 + q * 32 + fq * 8));
    f32x4 acc[8];
    float ss = 0.f;
    const size_t tok = (size_t)b * SEQ + n * 64 + w * 16 + fr;
    uint2 zz[8];
#pragma unroll
    for (int nt = 0; nt < 8; ++nt) zz[nt] = *(const uint2*)(P + tok * PC + C_ZB + h * 128 + nt * 16 + fq * 4);
#pragma unroll
    for (int g = 0; g < 2; ++g) {
        bf16x8 sb[4][4], vn[4][2];
#pragma unroll
        for (int t = 0; t < 4; ++t) {
#pragma unroll
            for (int pp = 0; pp < 4; ++pp) sb[t][pp] = ldg_b<bf16x8>(SBp, 16u * (unsigned)((pp * 8 + g * 4 + t) * 64 + lane));
#pragma unroll
            for (int q = 0; q < 2; ++q) vn[t][q] = ldg_b<bf16x8>(VNp, 16u * (unsigned)((q * 8 + g * 4 + t) * 64 + lane));
        }
        __builtin_amdgcn_sched_barrier(0);
#pragma unroll
        for (int t = 0; t < 4; ++t) {
            f32x4 a = (f32x4){0.f, 0.f, 0.f, 0.f};
#pragma unroll
            for (int pp = 0; pp < 4; ++pp) a = mfma16(sb[t][pp], qg[pp], a);
#pragma unroll
            for (int q = 0; q < 2; ++q) a = mfma16(vn[t][q], qk[q], a);
            acc[g * 4 + t] = a;
            ss += a[0] * a[0] + a[1] * a[1] + a[2] * a[2] + a[3] * a[3];
        }
        __builtin_amdgcn_sched_barrier(0);
    }
    ss += __shfl_xor(ss, 16);
    ss += __shfl_xor(ss, 32);
    const float rinv = rsqrtf(ss * (1.f / 128.f) + NORM_EPS);
#pragma unroll
    for (int nt = 0; nt < 8; ++nt) {
        const int v0 = nt * 16 + fq * 4;
        const float4 g = *(const float4*)(p.onorm_g + l * 128 + v0);
        const uint2 z = zz[nt];
        const float y0 = acc[nt][0] * rinv * g.x * lo_bf(z.x), y1 = acc[nt][1] * rinv * g.y * hi_bf(z.x);
        const float y2 = acc[nt][2] * rinv * g.z * lo_bf(z.y), y3 = acc[nt][3] * rinv * g.w * hi_bf(z.y);
        *(uint2*)(YB + tok * 1024 + h * 128 + v0) = make_uint2(pack2(y0, y1), pack2(y2, y3));
    }
}

constexpr int N_GMLP_P = NB * 16 * 8;
constexpr int N_GDN_S = DBT * 8;
constexpr int N_GMLP_S = DBT;
constexpr int N_CONV = NB + DBT;
constexpr int N_OTHER = N_GMLP_P + N_GDN_S + N_GMLP_S + N_CONV;

__device__ __forceinline__ void other_item(const Params& p, int l, int it, char* smem) {
    if (it < N_GMLP_P) gmlp_prompt_item(p, l, it, smem);
    else if (it < N_GMLP_P + N_GDN_S) gdn_sample_item(p, l, it - N_GMLP_P, smem);
    else if (it < N_GMLP_P + N_GDN_S + N_GMLP_S) gmlp_sample_item(p, l, it - N_GMLP_P - N_GDN_S, smem);
    else conv_state_item(p, l, it - N_GMLP_P - N_GDN_S - N_GMLP_S);
}

__device__ __forceinline__ void phase_mixb(const Params& p, int l, char* smem) {
    const int G = gridDim.x;
    if (G >= 128) {
        if (blockIdx.x < 64) gdn_scan_item(p, l, blockIdx.x, smem);
        else for (int it = blockIdx.x - 64; it < N_OTHER; it += G - 64) other_item(p, l, it, smem);
    } else {
        for (int it = blockIdx.x; it < 64; it += G) gdn_scan_item(p, l, it, smem);
        for (int it = blockIdx.x; it < N_OTHER; it += G) other_item(p, l, it, smem);
    }
}

#define FRESH(q) const Params& q = p
#define XB_TMO      128
#define XB_XCNT(j)  (256  + 64 * (j))
#define XB_XSUB(j)  (1280 + 64 * (j))
#define XB_XGEN(j)  (2304 + 64 * (j))
#define XB_TOP      3328
#define XB_TOPGEN   3392
#define XCD_BAR_WORDS 3456
#define XB_SPIN_CAP (1u << 22)
#define LAS __attribute__((address_space(3)))
__device__ __forceinline__ unsigned xb_ld(unsigned* p) { return __hip_atomic_load(p, __ATOMIC_RELAXED, __HIP_MEMORY_SCOPE_AGENT); }
__device__ __forceinline__ unsigned xb_add(unsigned* p, unsigned v) { return __hip_atomic_fetch_add(p, v, __ATOMIC_RELAXED, __HIP_MEMORY_SCOPE_AGENT); }
__device__ __forceinline__ unsigned xb_xcc_id() { return (unsigned)__builtin_amdgcn_s_getreg((3 << 11) | 20) & 0xFu; }
#define XB_SPIN(cond, bar) do { unsigned _sp = 0; while (cond) { __builtin_amdgcn_s_sleep(1); \
    if ((++_sp & 255u) == 0u) { if (xb_ld(&(bar)[XB_TMO])) break; if (_sp > XB_SPIN_CAP) { atomicAdd(&(bar)[XB_TMO], 1u); break; } } } } while (0)
struct XcdBarrier { unsigned* bar; unsigned x; volatile LAS unsigned* st; };
__device__ __forceinline__ XcdBarrier xcd_barrier_post(unsigned* bar, volatile LAS unsigned* st) {
    XcdBarrier b; b.bar = bar; b.x = xb_xcc_id(); b.st = st;
    if (threadIdx.x == 0) (void)xb_add(&bar[XB_XCNT(b.x)], 1u);
    return b;
}
__device__ __forceinline__ void xcd_barrier_complete(unsigned* bar, unsigned x, unsigned& nloc, unsigned& nx) {
    const unsigned G = gridDim.x * gridDim.y * gridDim.z;
    unsigned sum, cnt, mine, sp = 0u;
    for (;;) {
        sum = 0u; cnt = 0u; mine = 0u;
#pragma unroll
        for (unsigned j = 0; j < 16; ++j) { const unsigned c = xb_ld(&bar[XB_XCNT(j)]); sum += c; cnt += (c > 0u) ? 1u : 0u; mine = (j == x) ? c : mine; }
        if (sum == G) break;
        __builtin_amdgcn_s_sleep(1);
        if ((++sp & 255u) == 0u) { if (xb_ld(&bar[XB_TMO])) break; if (sp > XB_SPIN_CAP) { atomicAdd(&bar[XB_TMO], 1u); break; } }
    }
    nloc = mine > 0u ? mine : 1u; nx = cnt > 0u ? cnt : 1u;
}
__device__ __forceinline__ void xcd_barrier(const XcdBarrier& b) {
    asm volatile("s_waitcnt vmcnt(0)" ::: "memory");
    __syncthreads();
    if (threadIdx.x == 0) {
        unsigned* bar = b.bar;
        __builtin_amdgcn_s_waitcnt(0);
        unsigned nloc = b.st[0], nx = b.st[1];
        if (nloc == 0u) { xcd_barrier_complete(bar, b.x, nloc, nx); b.st[0] = nloc; b.st[1] = nx; }
        const unsigned old = xb_add(&bar[XB_XSUB(b.x)], 1u);
        const unsigned gen = old / nloc;
        if (old + 1u == (gen + 1u) * nloc) {
            __builtin_amdgcn_fence(__ATOMIC_RELEASE, "agent");
            asm volatile("s_waitcnt vmcnt(0)" ::: "memory");
            const unsigned og = xb_add(&bar[XB_TOP], 1u);
            const unsigned tg = og / nx;
            if (og + 1u == (tg + 1u) * nx) xb_add(&bar[XB_TOPGEN], 1u);
            else XB_SPIN(xb_ld(&bar[XB_TOPGEN]) == tg, bar);
            __builtin_amdgcn_fence(__ATOMIC_ACQUIRE, "agent");
            xb_add(&bar[XB_XGEN(b.x)], 1u);
            asm volatile("s_waitcnt vmcnt(0)" ::: "memory");
        } else {
            XB_SPIN(xb_ld(&bar[XB_XGEN(b.x)]) == gen, bar);
            __builtin_amdgcn_fence(__ATOMIC_ACQUIRE, "agent");
            asm volatile("s_waitcnt vmcnt(0)" ::: "memory");
        }
    }
    __syncthreads();
}

__global__ void __launch_bounds__(256, 2) fwd_megakernel(Params p) {
    extern __shared__ __attribute__((aligned(16))) char smem[];
    __shared__ uint4 xb_words;
    cg::grid_group grid = cg::this_grid();
    unsigned* bar = (unsigned*)(p.ws + OFF_BAR);
    if (blockIdx.x == 0) for (int i = threadIdx.x; i < XCD_BAR_WORDS; i += 256) __hip_atomic_store(bar + i, 0u, __ATOMIC_RELAXED, __HIP_MEMORY_SCOPE_AGENT);
    if (threadIdx.x == 0) xb_words = make_uint4(0u, 0u, 0u, 0u);
    { FRESH(q); phase0(q, smem); }
    grid.sync();
    const XcdBarrier xb = xcd_barrier_post(bar, (volatile LAS unsigned*)&xb_words);
#define GBAR() xcd_barrier(xb)
    for (int l = 0; l < DEPTH; ++l) {
        { FRESH(q); phase_rows(q, l); }
        GBAR();
        { FRESH(q); phase_inproj256(q, l, smem); }
        GBAR();
        { FRESH(q); for (int it = blockIdx.x; it < NCHK; it += gridDim.x) gdn_prep_item(q, l, it, smem); }
        GBAR();
        { FRESH(q); phase_mixb(q, l, smem); }
        GBAR();
        { FRESH(q); for (int it = blockIdx.x; it < NCHK; it += gridDim.x) gdn_out_item(q, l, it); }
        GBAR();
        { FRESH(q); phase_merge(q, l, smem); }
        GBAR();
        { FRESH(q); phase_outproj(q, l, smem); }
        GBAR();
    }
    { FRESH(q); phase_rows(q, DEPTH); }
}

extern "C" void kernel_launch(void* const* d_in, const int* in_sizes, int n_in, void* d_out, int out_size, void* d_ws, size_t ws_size,
                              hipStream_t stream) {
    static int grid_blocks = 0;
    if (!grid_blocks) {
        int dev = 0, cus = 0, per_cu = 0;
        hipGetDevice(&dev);
        hipDeviceGetAttribute(&cus, hipDeviceAttributeMultiprocessorCount, dev);
        hipFuncSetAttribute((const void*)fwd_megakernel, hipFuncAttributeMaxDynamicSharedMemorySize, SMEM_BYTES);
        hipOccupancyMaxActiveBlocksPerMultiprocessor(&per_cu, fwd_megakernel, 256, SMEM_BYTES);
        if (per_cu > 2) per_cu = 2;
        if (per_cu < 1) per_cu = 1;
        grid_blocks = cus * per_cu;
    }
    if (ws_size < WS_NEED) {
        fprintf(stderr, "workspace too small: %zu < %zu\n", ws_size, (size_t)WS_NEED);
        return;
    }
    Params p{};
    const float** f = (const float**)&p;
    for (int i = 0; i < 22; ++i) f[i] = (const float*)d_in[i];
    p.out = (float*)d_out;
    p.ws = (char*)d_ws;
    void* args[] = {&p};
    hipError_t e = hipLaunchCooperativeKernel((const void*)fwd_megakernel, dim3(grid_blocks), dim3(256), args, SMEM_BYTES, stream);
    if (e != hipSuccess) fprintf(stderr, "cooperative launch failed: %s (grid %d)\n", hipGetErrorString(e), grid_blocks);
}
```

```cpp
#include <hip/hip_runtime.h>
#include <hip/hip_cooperative_groups.h>
#include <cstdio>
namespace cg = cooperative_groups;

typedef unsigned short bf16_t;
typedef short bf16x8 __attribute__((ext_vector_type(8)));
typedef float f32x4 __attribute__((ext_vector_type(4)));
typedef unsigned u32x4 __attribute__((ext_vector_type(4)));

constexpr int D = 1024;
constexpr int NB = 8, SEQ = 2048, DEPTH = 4, DBT = 128, DSQ = 4;
constexpr int TP = NB * SEQ;
constexpr int TS = DBT * DSQ;
constexpr int T = TP + TS;
constexpr int PIN = 9232;
constexpr int PC = 9216;
constexpr int NPAD = 9344;
constexpr int NROWB = NB + DBT;
constexpr float ALPHA_DN = 1.681792830507429f;
constexpr float LN_EPS = 1e-5f, NORM_EPS = 1e-6f;
constexpr int C_UA = 0, C_VA = 1024, C_ZA = 2048, C_Q = 3072, C_ZB = 6144, C_GA = 7168, C_GB = 8192;

constexpr size_t O_Y_P = 0, O_Y_S = 16777216, O_CONV_P = 17301504, O_SSM_P = 17596416, O_CV_P = 21790720,
                 O_CONV_S = 25985024, O_SSM_S = 30703616, O_CV_S = 97812480;

constexpr size_t SZ_WT_IN = (size_t)DEPTH * NPAD * 1024 * 2;
constexpr size_t SZ_WT_SQ = (size_t)DEPTH * 1024 * 1024 * 2;
constexpr size_t OFF_WT_IN = 0;
constexpr size_t OFF_WT_PA = OFF_WT_IN + SZ_WT_IN;
constexpr size_t OFF_WT_PB = OFF_WT_PA + SZ_WT_SQ;
constexpr size_t OFF_WT_O = OFF_WT_PB + SZ_WT_SQ;
constexpr size_t OFF_MOD = OFF_WT_O + SZ_WT_SQ;
constexpr size_t OFF_X = OFF_MOD + (size_t)DEPTH * NROWB * 3072 * 4;
constexpr size_t OFF_TT = OFF_X + (size_t)T * 1024 * 4;
constexpr size_t OFF_H = OFF_TT + (size_t)T * 1024 * 4;
constexpr size_t OFF_YA = OFF_H + (size_t)T * 1024 * 2;
constexpr size_t OFF_YB = OFF_YA + (size_t)T * 1024 * 2;
constexpr size_t OFF_MM = OFF_YB + (size_t)T * 1024 * 2;
constexpr size_t OFF_P = OFF_MM + (size_t)T * 1024 * 2;
constexpr size_t OFF_BETA = OFF_P + (size_t)T * PC * 2;
constexpr size_t OFF_GLOG = OFF_BETA + (size_t)T * 8 * 4;
constexpr int NCHK = 2048;
constexpr size_t OFF_U = OFF_GLOG + (size_t)T * 8 * 4;
constexpr size_t OFF_WG = OFF_U + (size_t)NCHK * 8192 * 4;
constexpr size_t OFF_QG = OFF_WG + (size_t)NCHK * 8192 * 2;
constexpr size_t OFF_KDT = OFF_QG + (size_t)NCHK * 8192 * 2;
constexpr size_t OFF_QK = OFF_KDT + (size_t)NCHK * 8192 * 2;
constexpr size_t OFF_EG = OFF_QK + (size_t)NCHK * 4096 * 2;
constexpr size_t OFF_SB = OFF_EG + (size_t)NCHK * 4;
constexpr size_t OFF_VN = OFF_SB + (size_t)NCHK * 16384 * 2;
constexpr size_t OFF_PARK = OFF_VN + (size_t)NCHK * 8192 * 2;
constexpr size_t OFF_STATS = OFF_PARK + (size_t)1024 * 32768;
constexpr size_t OFF_BAR = OFF_STATS + (size_t)T * 2 * 4;
constexpr size_t WS_NEED = OFF_BAR + 16384;

constexpr int SMEM_BYTES = 73728;
constexpr int TILE_BYTES = 128 * 128;

struct Params {
    const float *x_prompt, *x_sample, *state_conv, *state_ssm, *c_prompt, *c_sample, *w_ada, *b_ada, *w_in, *w_s, *b_s,
        *lnv_g, *lnv_b, *conv_w, *a_log, *dt_bias, *onorm_g, *w_pa, *w_pb, *w_o, *ln_g, *ln_b;
    float* out;
    char* ws;
};

__device__ __forceinline__ unsigned pack2(float a, float b) {
    unsigned r;
    asm("v_cvt_pk_bf16_f32 %0, %1, %2" : "=v"(r) : "v"(a), "v"(b));
    return r;
}
__device__ __forceinline__ bf16_t f2bf(float f) { return (bf16_t)(pack2(f, 0.f) & 0xffffu); }
__device__ __forceinline__ float bf2f(bf16_t h) { return __uint_as_float(((unsigned)h) << 16); }
__device__ __forceinline__ float lo_bf(unsigned u) { return __uint_as_float(u << 16); }
__device__ __forceinline__ float hi_bf(unsigned u) { return __uint_as_float(u & 0xffff0000u); }
__device__ __forceinline__ float sigmoid_f(float x) { return __builtin_amdgcn_rcpf(1.f + __builtin_amdgcn_exp2f(-1.4426950408889634f * x)); }
__device__ __forceinline__ float silu_f(float x) { return x * sigmoid_f(x); }
__device__ __forceinline__ float gelu_f(float x) {
    const float y2 = x * (1.5957691216057308f + 0.0713548162726f * x * x);
    return x * __builtin_amdgcn_rcpf(1.f + __builtin_amdgcn_exp2f(-1.4426950408889634f * y2));
}
__device__ __forceinline__ float softplus_f(float x) { return fmaxf(x, 0.f) + log1pf(__expf(-fabsf(x))); }
__device__ __forceinline__ float wave_sum(float v) {
#pragma unroll
    for (int o = 32; o >= 1; o >>= 1) v += __shfl_xor(v, o);
    return v;
}
__device__ __forceinline__ f32x4 mfma16(bf16x8 a, bf16x8 b, f32x4 c) { return __builtin_amdgcn_mfma_f32_16x16x32_bf16(a, b, c, 0, 0, 0); }
template <class Tp> __device__ __forceinline__ Tp ldg_b(const void* base, unsigned boff) { return *(const Tp*)((const char*)base + boff); }
template <class Tp> __device__ __forceinline__ void stg_b(void* base, unsigned boff, Tp v) { *(Tp*)((char*)base + boff) = v; }
__host__ __device__ constexpr int perm32(int k) { return (k & ~31) | (((k >> 2) & 3) << 3) | (((k >> 4) & 1) << 2) | (k & 3); }
__device__ __forceinline__ int opaque_tid() { int t = threadIdx.x; asm volatile("" : "+v"(t)); return t; }
__device__ __forceinline__ int opaque_zero() { int z = 0; asm volatile("" : "+v"(z)); return z; }
__device__ __forceinline__ int cond_row(int row) { return row < TP ? (row >> 11) : (NB + ((row - TP) >> 2)); }

template <int WGM = 8>
__device__ __forceinline__ void tile_map(int L, int ntiles, int nM, int nN, int& tm, int& tn) {
    const int q = ntiles / 8, r = ntiles % 8, xcd = L % 8, off = L / 8;
    const int g = (xcd < r ? xcd * (q + 1) : r * (q + 1) + (xcd - r) * q) + off;
    const int nig = WGM * nN, gid = g / nig, fm = gid * WGM, gsz = (nM - fm) < WGM ? (nM - fm) : WGM;
    tm = fm + (g % nig) % gsz;
    tn = (g % nig) / gsz;
}

template <int MT>
__device__ __forceinline__ void gemm_core(const bf16_t* __restrict__ A, const bf16_t* __restrict__ B, const int K,
                                          f32x4 (&acc)[MT][4], char* smem, const int tid) {
    const int lane = tid & 63, wid = tid >> 6, wr = wid >> 1, wc = wid & 1;
    const int srow = tid >> 3, sseg = (tid & 7) ^ ((tid >> 3) & 7);
    const bf16_t* ag = A + (size_t)srow * K + sseg * 8;
    const bf16_t* bg = B + (size_t)srow * K + sseg * 8;
    const int nk = K >> 6;
#define STAGE(BUF, KT) do { char* d_ = smem + (BUF) * 2 * TILE_BYTES + tid * 16; \
        _Pragma("unroll") for (int i = 0; i < MT; ++i) __builtin_amdgcn_global_load_lds((const unsigned*)(ag + (size_t)(32 * i) * K + (KT) * 64), (__attribute__((address_space(3))) unsigned*)(d_ + i * 4096), 16, 0, 0); \
        _Pragma("unroll") for (int i = 0; i < 4; ++i) __builtin_amdgcn_global_load_lds((const unsigned*)(bg + (size_t)(32 * i) * K + (KT) * 64), (__attribute__((address_space(3))) unsigned*)(d_ + TILE_BYTES + i * 4096), 16, 0, 0); } while (0)
#define COMPUTE(BUF) do { const char* cur = smem + (BUF) * 2 * TILE_BYTES; _Pragma("unroll") for (int kk = 0; kk < 2; ++kk) { \
        bf16x8 af[MT], bfr[4]; const int ko = kk ? kx1 : kx0; \
        _Pragma("unroll") for (int m = 0; m < MT; ++m) af[m] = *(const bf16x8*)(cur + aoff + m * 16 * 128 + ko); \
        _Pragma("unroll") for (int n = 0; n < 4; ++n) bfr[n] = *(const bf16x8*)(cur + boff + n * 16 * 128 + ko); \
        _Pragma("unroll") for (int m = 0; m < MT; ++m) _Pragma("unroll") for (int n = 0; n < 4; ++n) acc[m][n] = mfma16(bfr[n], af[m], acc[m][n]); } } while (0)
    const int fr = lane & 15, fq = lane >> 4;
    const int aoff = (wr * 16 * MT + fr) * 128;
    const int boff = TILE_BYTES + (wc * 64 + fr) * 128;
    const int kx0 = (fq ^ (fr & 7)) << 4, kx1 = ((4 + fq) ^ (fr & 7)) << 4;
    __syncthreads();
    STAGE(0, 0);
    asm volatile("s_waitcnt vmcnt(0)" ::: "memory");
    __syncthreads();
    for (int kt = 0; kt < nk; ++kt) {
        if (kt + 1 < nk) STAGE((kt + 1) & 1, kt + 1);
        COMPUTE(kt & 1);
        asm volatile("s_waitcnt vmcnt(0)" ::: "memory");
        __syncthreads();
    }
#undef STAGE
#undef COMPUTE
}

__device__ __forceinline__ int win_src_col(int np) {
    if (np < 7168) return np;
    if (np < 9216) return np + 16;
    if (np < 9232) return np - 9216 + 7168;
    return -1;
}
__device__ __forceinline__ void transpose_item(const float* __restrict__ src, int ld, bool is_win, bf16_t* __restrict__ dst, int kt, int nt, char* smem) {
    smem += opaque_zero();
    float* tile = (float*)smem;
    const int tid = opaque_tid();
    __syncthreads();
    const int nn = tid & 63, kq = tid >> 6;
    const int np = nt * 64 + nn;
    const int oc = is_win ? win_src_col(np) : np;
#pragma unroll
    for (int i = 0; i < 16; ++i) {
        const int kk = kq + 4 * i;
        tile[kk * 65 + nn] = oc >= 0 ? src[(size_t)(kt * 64 + kk) * ld + oc] : 0.f;
    }
    __syncthreads();
    const int r = tid >> 2, seg = tid & 3;
    unsigned pk[8];
#pragma unroll
    for (int j = 0; j < 8; ++j) pk[j] = pack2(tile[(seg * 16 + 2 * j) * 65 + r], tile[(seg * 16 + 2 * j + 1) * 65 + r]);
    uint4* d = (uint4*)(dst + (size_t)(nt * 64 + r) * 1024 + kt * 64 + seg * 16);
    d[0] = make_uint4(pk[0], pk[1], pk[2], pk[3]);
    d[1] = make_uint4(pk[4], pk[5], pk[6], pk[7]);
}

__device__ __forceinline__ void mod_item(const Params& p, int it, char* smem) {
    smem += opaque_zero();
    float* sc = (float*)smem;
    const int tid = opaque_tid();
    const int rg = it & 7, cb = (it >> 3) % 12, l = it / 96;
    __syncthreads();
    for (int idx = tid; idx < 17 * 1024; idx += 256) {
        const int r = idx >> 10, k = idx & 1023, row = rg * 17 + r;
        const float c = row < NB ? p.c_prompt[row * 1024 + k] : p.c_sample[(row - NB) * 1024 + k];
        sc[idx] = silu_f(c);
    }
    __syncthreads();
    const int col = cb * 256 + tid;
    float acc[17];
#pragma unroll
    for (int r = 0; r < 17; ++r) acc[r] = 0.f;
    const float* wp = p.w_ada + (size_t)l * 1024 * 3072 + col;
    for (int k = 0; k < 1024; k += 4) {
        const float w0 = wp[(size_t)(k + 0) * 3072], w1 = wp[(size_t)(k + 1) * 3072], w2 = wp[(size_t)(k + 2) * 3072], w3 = wp[(size_t)(k + 3) * 3072];
#pragma unroll
        for (int r = 0; r < 17; ++r) {
            const float4 s = *(const float4*)&sc[r * 1024 + k];
            acc[r] += s.x * w0 + s.y * w1 + s.z * w2 + s.w * w3;
        }
    }
    float* mod = (float*)(p.ws + OFF_MOD);
    const float bb = p.b_ada[l * 3072 + col];
#pragma unroll
    for (int r = 0; r < 17; ++r) mod[((size_t)l * NROWB + rg * 17 + r) * 3072 + col] = acc[r] + bb;
}

constexpr int N_TR_IN = (NPAD / 64) * 16;
constexpr int N_TR_SQ = 16 * 16;
constexpr int N_TR_LAYER = N_TR_IN + 3 * N_TR_SQ;
constexpr int N_P0_TR = DEPTH * N_TR_LAYER;
constexpr int N_P0_MOD = DEPTH * 12 * 8;

__device__ __forceinline__ void phase0(const Params& p, char* smem) {
    for (int it = blockIdx.x; it < N_P0_TR + N_P0_MOD; it += gridDim.x) {
        if (it < N_P0_TR) {
            const int l = it / N_TR_LAYER;
            int r = it % N_TR_LAYER;
            if (r < N_TR_IN) {
                transpose_item(p.w_in + (size_t)l * 1024 * PIN, PIN, true, (bf16_t*)(p.ws + OFF_WT_IN) + (size_t)l * NPAD * 1024, r & 15, r >> 4, smem);
            } else {
                r -= N_TR_IN;
                const int which = r / N_TR_SQ;
                r %= N_TR_SQ;
                const float* src = (which == 0 ? p.w_pa : which == 1 ? p.w_pb : p.w_o) + (size_t)l * 1024 * 1024;
                bf16_t* dst = (bf16_t*)(p.ws + (which == 0 ? OFF_WT_PA : which == 1 ? OFF_WT_PB : OFF_WT_O)) + (size_t)l * 1024 * 1024;
                transpose_item(src, 1024, false, dst, r & 15, r >> 4, smem);
            }
        } else {
            mod_item(p, it - N_P0_TR, smem);
        }
    }
}

__device__ __forceinline__ void phase_rows(const Params& p, int l) {
    const int tid = opaque_tid();
    const int lane = tid & 63;
    const int gw = blockIdx.x * 4 + (tid >> 6), nw = gridDim.x * 4;
    float* X = (float*)(p.ws + OFF_X);
    const float* TT = (const float*)(p.ws + OFF_TT);
    bf16_t* H = (bf16_t*)(p.ws + OFF_H);
    const float* mod = (const float*)(p.ws + OFF_MOD);
    for (int row = gw; row < T; row += nw) {
        float v[16];
        if (l == 0) {
            const float* src = row < TP ? p.x_prompt + (size_t)row * 1024 : p.x_sample + (size_t)(row - TP) * 1024;
#pragma unroll
            for (int j = 0; j < 4; ++j) {
                const float4 t = *(const float4*)(src + j * 256 + lane * 4);
                v[j * 4 + 0] = t.x; v[j * 4 + 1] = t.y; v[j * 4 + 2] = t.z; v[j * 4 + 3] = t.w;
            }
        } else {
            const float* src = TT + (size_t)row * 1024;
            float s = 0.f;
#pragma unroll
            for (int j = 0; j < 4; ++j) {
                const float4 t = *(const float4*)(src + j * 256 + lane * 4);
                v[j * 4 + 0] = t.x; v[j * 4 + 1] = t.y; v[j * 4 + 2] = t.z; v[j * 4 + 3] = t.w;
                s += t.x + t.y + t.z + t.w;
            }
            const float mean = wave_sum(s) * (1.f / 1024.f);
            float q = 0.f;
#pragma unroll
            for (int e = 0; e < 16; ++e) { v[e] -= mean; q += v[e] * v[e]; }
            const float rstd = rsqrtf(wave_sum(q) * (1.f / 1024.f) + LN_EPS);
            const float* g = p.ln_g + (l - 1) * 1024;
            const float* bb = p.ln_b + (l - 1) * 1024;
#pragma unroll
            for (int j = 0; j < 4; ++j) {
                const float4 gg = *(const float4*)(g + j * 256 + lane * 4);
                const float4 be = *(const float4*)(bb + j * 256 + lane * 4);
                v[j * 4 + 0] = v[j * 4 + 0] * rstd * gg.x + be.x;
                v[j * 4 + 1] = v[j * 4 + 1] * rstd * gg.y + be.y;
                v[j * 4 + 2] = v[j * 4 + 2] * rstd * gg.z + be.z;
                v[j * 4 + 3] = v[j * 4 + 3] * rstd * gg.w + be.w;
            }
        }
        if (l == DEPTH) {
            float* dst = row < TP ? p.out + O_Y_P + (size_t)row * 1024 : p.out + O_Y_S + (size_t)(row - TP) * 1024;
#pragma unroll
            for (int j = 0; j < 4; ++j) *(float4*)(dst + j * 256 + lane * 4) = make_float4(v[j * 4], v[j * 4 + 1], v[j * 4 + 2], v[j * 4 + 3]);
            continue;
        }
        if (lane == 0) *(float2*)((float*)(p.ws + OFF_STATS) + (size_t)row * 2) = make_float2(0.f, 0.f);
        {
            float* dst = X + (size_t)row * 1024;
            float s = 0.f;
#pragma unroll
            for (int j = 0; j < 4; ++j) {
                *(float4*)(dst + j * 256 + lane * 4) = make_float4(v[j * 4], v[j * 4 + 1], v[j * 4 + 2], v[j * 4 + 3]);
                s += v[j * 4] + v[j * 4 + 1] + v[j * 4 + 2] + v[j * 4 + 3];
            }
            const float mean = wave_sum(s) * (1.f / 1024.f);
            float q = 0.f;
#pragma unroll
            for (int e = 0; e < 16; ++e) { v[e] -= mean; q += v[e] * v[e]; }
            const float rstd = rsqrtf(wave_sum(q) * (1.f / 1024.f) + LN_EPS);
            const float* mrow = mod + ((size_t)l * NROWB + cond_row(row)) * 3072;
#pragma unroll
            for (int j = 0; j < 4; ++j) {
                const float4 sh = *(const float4*)(mrow + j * 256 + lane * 4);
                const float4 scl = *(const float4*)(mrow + 1024 + j * 256 + lane * 4);
                const float h0 = v[j * 4 + 0] * rstd * (1.f + scl.x) + sh.x;
                const float h1 = v[j * 4 + 1] * rstd * (1.f + scl.y) + sh.y;
                const float h2 = v[j * 4 + 2] * rstd * (1.f + scl.z) + sh.z;
                const float h3 = v[j * 4 + 3] * rstd * (1.f + scl.w) + sh.w;
                *(uint2*)(H + (size_t)row * 1024 + j * 256 + lane * 4) = make_uint2(pack2(h0, h1), pack2(h2, h3));
            }
        }
    }
}

__device__ __forceinline__ void phase_inproj(const Params& p, int l, char* smem) {
    const bf16_t* H = (const bf16_t*)(p.ws + OFF_H);
    const bf16_t* Wt = (const bf16_t*)(p.ws + OFF_WT_IN) + (size_t)l * NPAD * 1024;
    bf16_t* P = (bf16_t*)(p.ws + OFF_P);
    float* BETA = (float*)(p.ws + OFF_BETA);
    float* GLOG = (float*)(p.ws + OFF_GLOG);
    constexpr int nM = T / 128, nN = NPAD / 128, ntiles = nM * nN;
    for (int L = blockIdx.x; L < ntiles; L += gridDim.x) {
        const int tid = opaque_tid();
        const int lane = tid & 63, wid = tid >> 6, wr = wid >> 1, wc = wid & 1, fr = lane & 15, fq = lane >> 4;
        int tm, tn;
        tile_map(L, ntiles, nM, nN, tm, tn);
        f32x4 acc[4][4];
#pragma unroll
        for (int m = 0; m < 4; ++m)
#pragma unroll
            for (int n = 0; n < 4; ++n) acc[m][n] = (f32x4){0.f, 0.f, 0.f, 0.f};
        gemm_core<4>(H + (size_t)tm * 128 * 1024, Wt + (size_t)tn * 128 * 1024, 1024, acc, smem, tid);
        if (tn == 72) {
            if (wc == 0) {
#pragma unroll
                for (int m = 0; m < 4; ++m) {
                    const int row = tm * 128 + wr * 64 + m * 16 + fr;
#pragma unroll
                    for (int r = 0; r < 4; ++r) {
                        const float a = acc[m][0][r];
                        if (fq < 2) {
                            BETA[(size_t)row * 8 + fq * 4 + r] = sigmoid_f(a);
                        } else {
                            const int h = (fq - 2) * 4 + r;
                            GLOG[(size_t)row * 8 + h] = -__expf(p.a_log[l * 8 + h]) * softplus_f(a + p.dt_bias[l * 8 + h]);
                        }
                    }
                }
            }
        } else {
            const int kind = tn < 16 ? 0 : tn < 24 ? 1 : tn < 48 ? 2 : tn < 56 ? 1 : 3;
            char* st = smem + opaque_zero();
#pragma unroll
            for (int m = 0; m < 4; ++m) {
                const int rl = wr * 64 + m * 16 + fr;
#pragma unroll
                for (int n = 0; n < 4; ++n) {
                    const int cl = wc * 64 + n * 16 + fq * 4;
                    float a[4];
#pragma unroll
                    for (int r = 0; r < 4; ++r) {
                        const float x = acc[m][n][r];
                        a[r] = kind == 0 ? gelu_f(x) : kind == 1 ? silu_f(x) : kind == 2 ? x : sigmoid_f(x);
                    }
                    *(uint2*)(st + rl * 272 + cl * 2) = make_uint2(pack2(a[0], a[1]), pack2(a[2], a[3]));
                }
            }
            __syncthreads();
#pragma unroll
            for (int i = 0; i < 8; ++i) {
                const int rl = (tid >> 4) + 16 * i, sg = tid & 15;
                const u32x4 v = *(const u32x4*)(st + rl * 272 + sg * 16);
                *(u32x4*)(P + (size_t)(tm * 128 + rl) * PC + tn * 128 + sg * 8) = v;
                if (tn >= 8 && tn < 16) {
                    const float a0 = lo_bf(v[0]), a1 = hi_bf(v[0]), a2 = lo_bf(v[1]), a3 = hi_bf(v[1]), a4 = lo_bf(v[2]), a5 = hi_bf(v[2]), a6 = lo_bf(v[3]), a7 = hi_bf(v[3]);
                    float sm = ((a0 + a1) + (a2 + a3)) + ((a4 + a5) + (a6 + a7));
                    float sq = ((a0 * a0 + a1 * a1) + (a2 * a2 + a3 * a3)) + ((a4 * a4 + a5 * a5) + (a6 * a6 + a7 * a7));
#pragma unroll
                    for (int o = 1; o < 16; o <<= 1) { sm += __shfl_xor(sm, o); sq += __shfl_xor(sq, o); }
                    if (sg == 0) {
                        float* stp = (float*)(p.ws + OFF_STATS) + (size_t)(tm * 128 + rl) * 2;
                        atomicAdd(stp, sm);
                        atomicAdd(stp + 1, sq);
                    }
                }
            }
        }
    }
}

constexpr int T2_A = 256 * 64, T2_B = 128 * 64, T2_STAGE = T2_A + T2_B;
__device__ __forceinline__ void gemm_core256(const bf16_t* __restrict__ A, const bf16_t* __restrict__ B, const int K,
                                             f32x4 (&acc)[8][4], char* smem, const int tid) {
    const int lane = tid & 63, wid = tid >> 6, wr = wid >> 1, wc = wid & 1, fr = lane & 15, fq = lane >> 4;
    const int srow = tid >> 2, sseg = (tid & 3) ^ ((tid >> 3) & 3);
    const bf16_t* ag = A + (size_t)srow * K + sseg * 8;
    const bf16_t* bg = B + (size_t)srow * K + sseg * 8;
    const int sw = (fq ^ ((fr >> 1) & 3)) << 4;
    const int aoff = (wr * 128 + fr) * 64 + sw;
    const int boff = T2_A + (wc * 64 + fr) * 64 + sw;
    const int nk = K >> 5;
#define STAGE2(BUF, KT) do { char* d_ = smem + (BUF) * T2_STAGE + tid * 16; \
        _Pragma("unroll") for (int i = 0; i < 4; ++i) __builtin_amdgcn_global_load_lds((const unsigned*)(ag + (size_t)(64 * i) * K + (KT) * 32), (__attribute__((address_space(3))) unsigned*)(d_ + i * 4096), 16, 0, 0); \
        _Pragma("unroll") for (int i = 0; i < 2; ++i) __builtin_amdgcn_global_load_lds((const unsigned*)(bg + (size_t)(64 * i) * K + (KT) * 32), (__attribute__((address_space(3))) unsigned*)(d_ + T2_A + i * 4096), 16, 0, 0); } while (0)
    __syncthreads();
    STAGE2(0, 0);
    STAGE2(1, 1);
    asm volatile("s_waitcnt vmcnt(6)" ::: "memory");
    __builtin_amdgcn_s_barrier();
    asm volatile("" ::: "memory");
    int cb = 0, nb = 2;
    for (int kt = 0; kt < nk; ++kt) {
        if (kt + 2 < nk) STAGE2(nb, kt + 2);
        const char* cur = smem + cb * T2_STAGE;
        bf16x8 bfr[4], af[8];
#pragma unroll
        for (int n = 0; n < 4; ++n) bfr[n] = *(const bf16x8*)(cur + boff + n * 16 * 64);
#pragma unroll
        for (int m = 0; m < 8; ++m) af[m] = *(const bf16x8*)(cur + aoff + m * 16 * 64);
        __builtin_amdgcn_sched_barrier(0);
#pragma unroll
        for (int m = 0; m < 8; ++m)
#pragma unroll
            for (int n = 0; n < 4; ++n) acc[m][n] = mfma16(bfr[n], af[m], acc[m][n]);
        if (kt + 2 < nk) asm volatile("s_waitcnt vmcnt(6)" ::: "memory");
        else asm volatile("s_waitcnt vmcnt(0)" ::: "memory");
        __builtin_amdgcn_s_barrier();
        asm volatile("" ::: "memory");
        cb = cb == 2 ? 0 : cb + 1;
        nb = nb == 2 ? 0 : nb + 1;
    }
#undef STAGE2
    __syncthreads();
}

__device__ __forceinline__ void phase_inproj256(const Params& p, int l, char* smem) {
    const bf16_t* H = (const bf16_t*)(p.ws + OFF_H);
    const bf16_t* Wt = (const bf16_t*)(p.ws + OFF_WT_IN) + (size_t)l * NPAD * 1024;
    bf16_t* P = (bf16_t*)(p.ws + OFF_P);
    float* BETA = (float*)(p.ws + OFF_BETA);
    float* GLOG = (float*)(p.ws + OFF_GLOG);
    constexpr int nM = T / 256, nN = NPAD / 128, ntiles = nM * nN;
    for (int L = blockIdx.x; L < ntiles; L += gridDim.x) {
        const int tid = opaque_tid();
        const int lane = tid & 63, wid = tid >> 6, wr = wid >> 1, wc = wid & 1, fr = lane & 15, fq = lane >> 4;
        int tm, tn;
        tile_map<4>(L, ntiles, nM, nN, tm, tn);
        f32x4 acc[8][4];
#pragma unroll
        for (int m = 0; m < 8; ++m)
#pragma unroll
            for (int n = 0; n < 4; ++n) acc[m][n] = (f32x4){0.f, 0.f, 0.f, 0.f};
        gemm_core256(H + (size_t)tm * 256 * 1024, Wt + (size_t)tn * 128 * 1024, 1024, acc, smem, tid);
        if (tn == 72) {
            if (wc == 0) {
#pragma unroll
                for (int m = 0; m < 8; ++m) {
                    const int row = tm * 256 + wr * 128 + m * 16 + fr;
#pragma unroll
                    for (int r = 0; r < 4; ++r) {
                        const float a = acc[m][0][r];
                        if (fq < 2) {
                            BETA[(size_t)row * 8 + fq * 4 + r] = sigmoid_f(a);
                        } else {
                            const int h = (fq - 2) * 4 + r;
                            GLOG[(size_t)row * 8 + h] = -__expf(p.a_log[l * 8 + h]) * softplus_f(a + p.dt_bias[l * 8 + h]);
                        }
                    }
                }
            }
        } else {
            const int kind = tn < 16 ? 0 : tn < 24 ? 1 : tn < 48 ? 2 : tn < 56 ? 1 : 3;
            char* st = smem + opaque_zero();
#pragma unroll
            for (int m = 0; m < 8; ++m) {
                const int rl = wr * 128 + m * 16 + fr;
#pragma unroll
                for (int n = 0; n < 4; ++n) {
                    const int cl = wc * 64 + n * 16 + fq * 4;
                    float a[4];
#pragma unroll
                    for (int r = 0; r < 4; ++r) {
                        const float x = acc[m][n][r];
                        a[r] = kind == 0 ? gelu_f(x) : kind == 1 ? silu_f(x) : kind == 2 ? x : sigmoid_f(x);
                    }
                    *(uint2*)(st + rl * 272 + cl * 2) = make_uint2(pack2(a[0], a[1]), pack2(a[2], a[3]));
                }
            }
            __syncthreads();
#pragma unroll 4
            for (int i = 0; i < 16; ++i) {
                const int rl = (tid >> 4) + 16 * i, sg = tid & 15;
                const u32x4 v = *(const u32x4*)(st + rl * 272 + sg * 16);
                *(u32x4*)(P + (size_t)(tm * 256 + rl) * PC + tn * 128 + sg * 8) = v;
                if (tn >= 8 && tn < 16) {
                    const float a0 = lo_bf(v[0]), a1 = hi_bf(v[0]), a2 = lo_bf(v[1]), a3 = hi_bf(v[1]), a4 = lo_bf(v[2]), a5 = hi_bf(v[2]), a6 = lo_bf(v[3]), a7 = hi_bf(v[3]);
                    float sm = ((a0 + a1) + (a2 + a3)) + ((a4 + a5) + (a6 + a7));
                    float sq = ((a0 * a0 + a1 * a1) + (a2 * a2 + a3 * a3)) + ((a4 * a4 + a5 * a5) + (a6 * a6 + a7 * a7));
#pragma unroll
                    for (int o = 1; o < 16; o <<= 1) { sm += __shfl_xor(sm, o); sq += __shfl_xor(sq, o); }
                    if (sg == 0) {
                        float* stp = (float*)(p.ws + OFF_STATS) + (size_t)(tm * 256 + rl) * 2;
                        atomicAdd(stp, sm);
                        atomicAdd(stp + 1, sq);
                    }
                }
            }
        }
    }
}

__device__ __forceinline__ void phase_merge(const Params& p, int l, char* smem) {
    const bf16_t* YA = (const bf16_t*)(p.ws + OFF_YA);
    const bf16_t* YB = (const bf16_t*)(p.ws + OFF_YB);
    const bf16_t* Wa = (const bf16_t*)(p.ws + OFF_WT_PA) + (size_t)l * 1024 * 1024;
    const bf16_t* Wb = (const bf16_t*)(p.ws + OFF_WT_PB) + (size_t)l * 1024 * 1024;
    const bf16_t* P = (const bf16_t*)(p.ws + OFF_P);
    bf16_t* MM = (bf16_t*)(p.ws + OFF_MM);
    constexpr int RT = 96, MT = 3;
    constexpr int nM = T / RT, nN = 8, ntiles = nM * nN;
    for (int L = blockIdx.x; L < ntiles; L += gridDim.x) {
        const int tid = opaque_tid();
        const int lane = tid & 63, wid = tid >> 6, wr = wid >> 1, wc = wid & 1, fr = lane & 15, fq = lane >> 4;
        int tm, tn;
        tile_map(L, ntiles, nM, nN, tm, tn);
        f32x4 acc[MT][4];
#pragma unroll
        for (int m = 0; m < MT; ++m)
#pragma unroll
            for (int n = 0; n < 4; ++n) acc[m][n] = (f32x4){0.f, 0.f, 0.f, 0.f};
        gemm_core<MT>(YA + (size_t)tm * RT * 1024, Wa + (size_t)tn * 128 * 1024, 1024, acc, smem, tid);
        uint2* park = (uint2*)(p.ws + OFF_PARK) + (size_t)blockIdx.x * 4096 + tid;
        uint2 gv[MT][4];
#pragma unroll
        for (int m = 0; m < MT; ++m)
#pragma unroll
            for (int n = 0; n < 4; ++n)
                gv[m][n] = *(const uint2*)(P + (size_t)(tm * RT + wr * 16 * MT + m * 16 + fr) * PC + C_GA + tn * 128 + wc * 64 + n * 16 + fq * 4);
        __builtin_amdgcn_sched_barrier(0);
#pragma unroll
        for (int m = 0; m < MT; ++m)
#pragma unroll
            for (int n = 0; n < 4; ++n) {
                const uint2 g = gv[m][n];
                park[(m * 4 + n) * 256] = make_uint2(pack2(acc[m][n][0] * lo_bf(g.x), acc[m][n][1] * hi_bf(g.x)),
                                                     pack2(acc[m][n][2] * lo_bf(g.y), acc[m][n][3] * hi_bf(g.y)));
                acc[m][n] = (f32x4){0.f, 0.f, 0.f, 0.f};
            }
        __builtin_amdgcn_sched_barrier(0);
        gemm_core<MT>(YB + (size_t)tm * RT * 1024, Wb + (size_t)tn * 128 * 1024, 1024, acc, smem, tid);
        char* st = smem + opaque_zero();
        uint2 pv[MT][4];
#pragma unroll
        for (int m = 0; m < MT; ++m)
#pragma unroll
            for (int n = 0; n < 4; ++n) {
                gv[m][n] = *(const uint2*)(P + (size_t)(tm * RT + wr * 16 * MT + m * 16 + fr) * PC + C_GB + tn * 128 + wc * 64 + n * 16 + fq * 4);
                pv[m][n] = park[(m * 4 + n) * 256];
            }
        __builtin_amdgcn_sched_barrier(0);
#pragma unroll
        for (int m = 0; m < MT; ++m) {
            const int rl = wr * 16 * MT + m * 16 + fr;
#pragma unroll
            for (int n = 0; n < 4; ++n) {
                const int cl = wc * 64 + n * 16 + fq * 4;
                const uint2 g = gv[m][n];
                const uint2 pm = pv[m][n];
                const float a0 = lo_bf(pm.x) + acc[m][n][0] * lo_bf(g.x);
                const float a1 = hi_bf(pm.x) + acc[m][n][1] * hi_bf(g.x);
                const float a2 = lo_bf(pm.y) + acc[m][n][2] * lo_bf(g.y);
                const float a3 = hi_bf(pm.y) + acc[m][n][3] * hi_bf(g.y);
                *(uint2*)(st + rl * 272 + cl * 2) = make_uint2(pack2(a0, a1), pack2(a2, a3));
            }
            __builtin_amdgcn_sched_barrier(0);
        }
        __syncthreads();
#pragma unroll
        for (int i = 0; i < RT / 16; ++i) {
            const int rl = (tid >> 4) + 16 * i, sg = tid & 15;
            const u32x4 v = *(const u32x4*)(st + rl * 272 + sg * 16);
            *(u32x4*)(MM + (size_t)(tm * RT + rl) * 1024 + tn * 128 + sg * 8) = v;
        }
    }
}

__device__ __forceinline__ void phase_outproj(const Params& p, int l, char* smem) {
    const bf16_t* MM = (const bf16_t*)(p.ws + OFF_MM);
    const bf16_t* Wo = (const bf16_t*)(p.ws + OFF_WT_O) + (size_t)l * 1024 * 1024;
    const float* X = (const float*)(p.ws + OFF_X);
    float* TT = (float*)(p.ws + OFF_TT);
    const float* mod = (const float*)(p.ws + OFF_MOD);
    constexpr int RT = 96, MT = 3;
    constexpr int nM = T / RT, nN = 8, ntiles = nM * nN;
    for (int L = blockIdx.x; L < ntiles; L += gridDim.x) {
        const int tid = opaque_tid();
        const int lane = tid & 63, wid = tid >> 6, wr = wid >> 1, wc = wid & 1, fr = lane & 15, fq = lane >> 4;
        int tm, tn;
        tile_map(L, ntiles, nM, nN, tm, tn);
        f32x4 acc[MT][4];
#pragma unroll
        for (int m = 0; m < MT; ++m)
#pragma unroll
            for (int n = 0; n < 4; ++n) acc[m][n] = (f32x4){0.f, 0.f, 0.f, 0.f};
        gemm_core<MT>(MM + (size_t)tm * RT * 1024, Wo + (size_t)tn * 128 * 1024, 1024, acc, smem, tid);
        float* st = (float*)(smem + opaque_zero());
#pragma unroll
        for (int m = 0; m < MT; ++m)
#pragma unroll
            for (int n = 0; n < 4; ++n) *(f32x4*)(st + (wr * 16 * MT + m * 16 + fr) * 132 + wc * 64 + n * 16 + fq * 4) = acc[m][n];
        __syncthreads();
#pragma unroll 4
        for (int i = 0; i < RT / 8; ++i) {
            const int rl = (tid >> 5) + 8 * i, c4 = (tid & 31) * 4;
            const int row = tm * RT + rl, col = tn * 128 + c4;
            const f32x4 a = *(const f32x4*)(st + rl * 132 + c4);
            const float4 x = *(const float4*)(X + (size_t)row * 1024 + col);
            const float4 g = *(const float4*)(mod + ((size_t)l * NROWB + cond_row(row)) * 3072 + 2048 + col);
            *(float4*)(TT + (size_t)row * 1024 + col) = make_float4(ALPHA_DN * x.x + g.x * a[0], ALPHA_DN * x.y + g.y * a[1],
                                                                    ALPHA_DN * x.z + g.z * a[2], ALPHA_DN * x.w + g.w * a[3]);
        }
    }
}

__device__ __forceinline__ void gmlp_prompt_item(const Params& p, int l, int it, char* smem) {
    smem += opaque_zero();
    const int tid = opaque_tid(), lane = tid & 63, wid = tid >> 6, wr = wid >> 1, wc = wid & 1, fr = lane & 15, fq = lane >> 4;
    const int h = it & 7, n = (it >> 3) & 15, b = it >> 7;
    const int tok0 = b * SEQ + n * 128;
    const bf16_t* P = (const bf16_t*)(p.ws + OFF_P);
    bf16_t* YA = (bf16_t*)(p.ws + OFF_YA);
    bf16_t* Wt = (bf16_t*)smem;
    bf16_t* VnT = Wt + 128 * 136;
    float* mu = (float*)(smem + 2 * 34816);
    float* rs = mu + 128;
    __syncthreads();
    {
        const int t = tid >> 1, half = tid & 1;
        const float* wsrc = p.w_s + ((size_t)(l * 8 + h) * 128 + t) * 128 + half * 64;
#pragma unroll
        for (int i = 0; i < 8; ++i) {
            const float4 w0 = *(const float4*)(wsrc + i * 8);
            const float4 w1 = *(const float4*)(wsrc + i * 8 + 4);
            const int s0 = half * 64 + i * 8;
            const float e0 = s0 + 0 <= t ? w0.x : 0.f, e1 = s0 + 1 <= t ? w0.y : 0.f, e2 = s0 + 2 <= t ? w0.z : 0.f, e3 = s0 + 3 <= t ? w0.w : 0.f;
            const float e4 = s0 + 4 <= t ? w1.x : 0.f, e5 = s0 + 5 <= t ? w1.y : 0.f, e6 = s0 + 6 <= t ? w1.z : 0.f, e7 = s0 + 7 <= t ? w1.w : 0.f;
            *(uint4*)(Wt + t * 136 + s0) = make_uint4(pack2(e0, e1), pack2(e2, e3), pack2(e4, e5), pack2(e6, e7));
        }
        if (half == 0) {
            const float2 sv = *(const float2*)((const float*)(p.ws + OFF_STATS) + (size_t)(tok0 + t) * 2);
            const float mean = sv.x * (1.f / 1024.f);
            const float var = fmaxf(sv.y * (1.f / 1024.f) - mean * mean, 0.f);
            mu[t] = mean;
            rs[t] = rsqrtf(var + LN_EPS);
        }
    }
    __syncthreads();
    {
        const int c = tid & 127, sg = tid >> 7;
        const float gam = p.lnv_g[l * 1024 + h * 128 + c], bet = p.lnv_b[l * 1024 + h * 128 + c];
        const bf16_t* src = P + (size_t)tok0 * PC + C_VA + h * 128 + c;
        float* cv = p.out + O_CV_P + ((size_t)(l * NB + b) * 128) * 1024 + h * 128 + c;
        bf16_t rw[64];
#pragma unroll
        for (int q = 0; q < 64; ++q) rw[q] = src[(size_t)(sg * 64 + q) * PC];
        __builtin_amdgcn_sched_barrier(0);
#pragma unroll
        for (int oct = 0; oct < 8; ++oct) {
            const int s0 = sg * 64 + oct * 8;
            float e[8];
#pragma unroll
            for (int j = 0; j < 8; ++j) {
                const float x = bf2f(rw[oct * 8 + j]);
                e[j] = (x - mu[s0 + j]) * rs[s0 + j] * gam + bet;
            }
            if (n == 15) {
#pragma unroll
                for (int j = 0; j < 8; ++j) cv[(size_t)(s0 + j) * 1024] = e[j];
            }
            *(uint4*)(VnT + c * 136 + s0) = make_uint4(pack2(e[0], e[1]), pack2(e[2], e[3]), pack2(e[4], e[5]), pack2(e[6], e[7]));
        }
    }
    __syncthreads();
    f32x4 acc[4][4];
#pragma unroll
    for (int m = 0; m < 4; ++m)
#pragma unroll
        for (int nn = 0; nn < 4; ++nn) acc[m][nn] = (f32x4){0.f, 0.f, 0.f, 0.f};
#pragma unroll
    for (int ks = 0; ks < 4; ++ks) {
        bf16x8 af[4], bfr[4];
#pragma unroll
        for (int m = 0; m < 4; ++m) af[m] = *(const bf16x8*)(Wt + (wr * 64 + m * 16 + fr) * 136 + ks * 32 + fq * 8);
#pragma unroll
        for (int nn = 0; nn < 4; ++nn) bfr[nn] = *(const bf16x8*)(VnT + (wc * 64 + nn * 16 + fr) * 136 + ks * 32 + fq * 8);
#pragma unroll
        for (int m = 0; m < 4; ++m)
#pragma unroll
            for (int nn = 0; nn < 4; ++nn) acc[m][nn] = mfma16(bfr[nn], af[m], acc[m][nn]);
    }
#pragma unroll
    for (int m = 0; m < 4; ++m) {
        const int t = wr * 64 + m * 16 + fr;
        const float bs = p.b_s[(l * 8 + h) * 128 + t];
        const bf16_t* prow = P + (size_t)(tok0 + t) * PC + h * 128;
#pragma unroll
        for (int nn = 0; nn < 4; ++nn) {
            const int c = wc * 64 + nn * 16 + fq * 4;
            const uint2 u = *(const uint2*)(prow + C_UA + c);
            const uint2 z = *(const uint2*)(prow + C_ZA + c);
            const float y0 = lo_bf(u.x) * (acc[m][nn][0] + bs) * lo_bf(z.x);
            const float y1 = hi_bf(u.x) * (acc[m][nn][1] + bs) * hi_bf(z.x);
            const float y2 = lo_bf(u.y) * (acc[m][nn][2] + bs) * lo_bf(z.y);
            const float y3 = hi_bf(u.y) * (acc[m][nn][3] + bs) * hi_bf(z.y);
            *(uint2*)(YA + (size_t)(tok0 + t) * 1024 + h * 128 + c) = make_uint2(pack2(y0, y1), pack2(y2, y3));
        }
    }
}

__device__ __forceinline__ void gmlp_sample_item(const Params& p, int l, int b, char* smem) {
    smem += opaque_zero();
    const int tid = opaque_tid(), lane = tid & 63, wid = tid >> 6;
    const int tok0 = TP + b * DSQ;
    const bf16_t* P = (const bf16_t*)(p.ws + OFF_P);
    bf16_t* YA = (bf16_t*)(p.ws + OFF_YA);
    float* red = (float*)smem;
    __syncthreads();
    const int c4 = tid * 4;
    float x[4][4];
    float s[4], ss[4];
#pragma unroll
    for (int t = 0; t < 4; ++t) {
        const uint2 u = *(const uint2*)(P + (size_t)(tok0 + t) * PC + C_VA + c4);
        x[t][0] = lo_bf(u.x); x[t][1] = hi_bf(u.x); x[t][2] = lo_bf(u.y); x[t][3] = hi_bf(u.y);
        s[t] = wave_sum(x[t][0] + x[t][1] + x[t][2] + x[t][3]);
        ss[t] = wave_sum(x[t][0] * x[t][0] + x[t][1] * x[t][1] + x[t][2] * x[t][2] + x[t][3] * x[t][3]);
    }
    if (lane == 0) {
#pragma unroll
        for (int t = 0; t < 4; ++t) { red[wid * 8 + t] = s[t]; red[wid * 8 + 4 + t] = ss[t]; }
    }
    __syncthreads();
    const float4 gam = *(const float4*)(p.lnv_g + l * 1024 + c4);
    const float4 bet = *(const float4*)(p.lnv_b + l * 1024 + c4);
    float vn[4][4];
#pragma unroll
    for (int t = 0; t < 4; ++t) {
        const float st = red[t] + red[8 + t] + red[16 + t] + red[24 + t];
        const float sst = red[4 + t] + red[12 + t] + red[20 + t] + red[28 + t];
        const float mean = st * (1.f / 1024.f);
        const float rstd = rsqrtf(fmaxf(sst * (1.f / 1024.f) - mean * mean, 0.f) + LN_EPS);
        vn[t][0] = (x[t][0] - mean) * rstd * gam.x + bet.x;
        vn[t][1] = (x[t][1] - mean) * rstd * gam.y + bet.y;
        vn[t][2] = (x[t][2] - mean) * rstd * gam.z + bet.z;
        vn[t][3] = (x[t][3] - mean) * rstd * gam.w + bet.w;
        *(float4*)(p.out + O_CV_S + ((size_t)(l * DBT + b) * DSQ + t) * 1024 + c4) = make_float4(vn[t][0], vn[t][1], vn[t][2], vn[t][3]);
    }
    const int h = c4 >> 7;
#pragma unroll
    for (int t = 0; t < 4; ++t) {
        const float bs = p.b_s[(l * 8 + h) * 128 + t];
        float a[4] = {bs, bs, bs, bs};
#pragma unroll
        for (int sidx = 0; sidx <= t; ++sidx) {
            const float w = p.w_s[((size_t)(l * 8 + h) * 128 + t) * 128 + sidx];
#pragma unroll
            for (int e = 0; e < 4; ++e) a[e] += w * vn[sidx][e];
        }
        const uint2 u = *(const uint2*)(P + (size_t)(tok0 + t) * PC + C_UA + c4);
        const uint2 z = *(const uint2*)(P + (size_t)(tok0 + t) * PC + C_ZA + c4);
        const float y0 = lo_bf(u.x) * a[0] * lo_bf(z.x), y1 = hi_bf(u.x) * a[1] * hi_bf(z.x);
        const float y2 = lo_bf(u.y) * a[2] * lo_bf(z.y), y3 = hi_bf(u.y) * a[3] * hi_bf(z.y);
        *(uint2*)(YA + (size_t)(tok0 + t) * 1024 + c4) = make_uint2(pack2(y0, y1), pack2(y2, y3));
    }
}

__device__ __forceinline__ void conv_state_item(const Params& p, int l, int it) {
    const bf16_t* P = (const bf16_t*)(p.ws + OFF_P);
    const bool pr = it < NB;
    const int b = pr ? it : it - NB;
    const int tokb = pr ? b * SEQ + SEQ - 3 : TP + b * DSQ + 1;
    float* dst = pr ? p.out + O_CONV_P + (size_t)(l * NB + b) * 3 * 3072 : p.out + O_CONV_S + (size_t)(l * DBT + b) * 3 * 3072;
    for (int idx = opaque_tid(); idx < 3 * 768; idx += 256) {
        const int j = idx / 768, c = (idx % 768) * 4;
        const uint2 u = *(const uint2*)(P + (size_t)(tokb + j) * PC + C_Q + c);
        *(float4*)(dst + j * 3072 + c) = make_float4(lo_bf(u.x), hi_bf(u.x), lo_bf(u.y), hi_bf(u.y));
    }
}

__device__ __forceinline__ void gdn_sample_item(const Params& p, int l, int it, char* smem) {
    smem += opaque_zero();
    const int tid = opaque_tid(), lane = tid & 63, wid = tid >> 6;
    const int b = it >> 3, h = it & 7;
    const int tok0 = TP + b * DSQ;
    const bf16_t* P = (const bf16_t*)(p.ws + OFF_P);
    const float* BETA = (const float*)(p.ws + OFF_BETA);
    const float* GLOG = (const float*)(p.ws + OFF_GLOG);
    bf16_t* YB = (bf16_t*)(p.ws + OFF_YB);
    float* qs = (float*)smem;
    float* ks = qs + 512;
    float* vs = ks + 512;
    float* red = vs + 512;
    float* part = red + 16;
    float* opart = part + 1024;
    float* red2 = opart + 1024;
    __syncthreads();
    const int j = tid & 127;
    const bool isk = tid >= 128;
    float y1[4], y2[4];
    {
        const int cq = (isk ? 1024 : 0) + h * 128 + j;
        const float* sc = p.state_conv + (size_t)(l * DBT + b) * 3 * 3072;
        const float* cw = p.conv_w + (size_t)l * 4 * 3072;
        float xr[7];
#pragma unroll
        for (int r = 0; r < 3; ++r) xr[r] = sc[r * 3072 + cq];
#pragma unroll
        for (int t = 0; t < 4; ++t) xr[3 + t] = bf2f(P[(size_t)(tok0 + t) * PC + C_Q + cq]);
        const float w0 = cw[cq], w1 = cw[3072 + cq], w2 = cw[2 * 3072 + cq], w3 = cw[3 * 3072 + cq];
#pragma unroll
        for (int t = 0; t < 4; ++t) y1[t] = silu_f(w0 * xr[t] + w1 * xr[t + 1] + w2 * xr[t + 2] + w3 * xr[t + 3]);
        if (!isk) {
            const int cv = 2048 + h * 128 + j;
#pragma unroll
            for (int r = 0; r < 3; ++r) xr[r] = sc[r * 3072 + cv];
#pragma unroll
            for (int t = 0; t < 4; ++t) xr[3 + t] = bf2f(P[(size_t)(tok0 + t) * PC + C_Q + cv]);
            const float v0 = cw[cv], v1 = cw[3072 + cv], v2 = cw[2 * 3072 + cv], v3 = cw[3 * 3072 + cv];
#pragma unroll
            for (int t = 0; t < 4; ++t) y2[t] = silu_f(v0 * xr[t] + v1 * xr[t + 1] + v2 * xr[t + 2] + v3 * xr[t + 3]);
        }
    }
#pragma unroll
    for (int t = 0; t < 4; ++t) {
        const float s = wave_sum(y1[t] * y1[t]);
        if (lane == 0) red[wid * 4 + t] = s;
    }
    __syncthreads();
#pragma unroll
    for (int t = 0; t < 4; ++t) {
        const float tot = isk ? red[8 + t] + red[12 + t] : red[t] + red[4 + t];
        const float rn = rsqrtf(tot + NORM_EPS);
        if (isk) ks[t * 128 + j] = y1[t] * rn;
        else { qs[t * 128 + j] = y1[t] * rn * 0.08838834764831845f; vs[t * 128 + j] = y2[t]; }
    }
    __syncthreads();
    const int vcol = j, kh = tid >> 7;
    float S[64];
    const float* s0 = p.state_ssm + ((size_t)(l * DBT + b) * 8 + h) * 16384 + (size_t)(kh * 64) * 128 + vcol;
#pragma unroll
    for (int kk = 0; kk < 64; ++kk) S[kk] = s0[kk * 128];
#pragma unroll
    for (int t = 0; t < 4; ++t) {
        const float a = __expf(GLOG[(size_t)(tok0 + t) * 8 + h]);
        const float bt = BETA[(size_t)(tok0 + t) * 8 + h];
        float r0 = 0.f, r1 = 0.f;
#pragma unroll
        for (int kk = 0; kk < 64; kk += 4) {
            const float4 kv = *(const float4*)&ks[t * 128 + kh * 64 + kk];
            r0 += S[kk] * kv.x + S[kk + 2] * kv.z;
            r1 += S[kk + 1] * kv.y + S[kk + 3] * kv.w;
        }
        part[(t * 2 + kh) * 128 + vcol] = r0 + r1;
        __syncthreads();
        const float dlt = bt * (vs[t * 128 + vcol] - a * (part[(t * 2) * 128 + vcol] + part[(t * 2 + 1) * 128 + vcol]));
        float o0 = 0.f, o1 = 0.f;
#pragma unroll
        for (int kk = 0; kk < 64; kk += 4) {
            const float4 kv = *(const float4*)&ks[t * 128 + kh * 64 + kk];
            const float4 qv = *(const float4*)&qs[t * 128 + kh * 64 + kk];
            S[kk] = a * S[kk] + kv.x * dlt;
            S[kk + 1] = a * S[kk + 1] + kv.y * dlt;
            S[kk + 2] = a * S[kk + 2] + kv.z * dlt;
            S[kk + 3] = a * S[kk + 3] + kv.w * dlt;
            o0 += S[kk] * qv.x + S[kk + 2] * qv.z;
            o1 += S[kk + 1] * qv.y + S[kk + 3] * qv.w;
        }
        opart[(t * 2 + kh) * 128 + vcol] = o0 + o1;
    }
    float* sout = p.out + O_SSM_S + ((size_t)(l * DBT + b) * 8 + h) * 16384 + (size_t)(kh * 64) * 128 + vcol;
#pragma unroll
    for (int kk = 0; kk < 64; ++kk) sout[kk * 128] = S[kk];
    __syncthreads();
    float o[4];
    if (tid < 128) {
#pragma unroll
        for (int t = 0; t < 4; ++t) {
            o[t] = opart[(t * 2) * 128 + vcol] + opart[(t * 2 + 1) * 128 + vcol];
            const float s = wave_sum(o[t] * o[t]);
            if (lane == 0) red2[wid * 4 + t] = s;
        }
    }
    __syncthreads();
    if (tid < 128) {
        const float gn = p.onorm_g[l * 128 + vcol];
#pragma unroll
        for (int t = 0; t < 4; ++t) {
            const float rinv = rsqrtf((red2[t] + red2[4 + t]) * (1.f / 128.f) + NORM_EPS);
            const float zs = bf2f(P[(size_t)(tok0 + t) * PC + C_ZB + h * 128 + vcol]);
            YB[(size_t)(tok0 + t) * 1024 + h * 128 + vcol] = f2bf(o[t] * rinv * gn * zs);
        }
    }
}

__device__ __forceinline__ void gdn_prep_item(const Params& p, int l, int it, char* smem) {
    smem += opaque_zero();
    const int tid = opaque_tid(), lane = tid & 63, wid = tid >> 6, fr = lane & 15, fq = lane >> 4;
    const int n = it & 31, h = (it >> 5) & 7, b = it >> 8;
    const int tok0 = b * SEQ + n * 64;
    const bf16_t* P = (const bf16_t*)(p.ws + OFF_P);
    const float* BETA = (const float*)(p.ws + OFF_BETA);
    const float* GLOG = (const float*)(p.ws + OFF_GLOG);
    float* Ug = (float*)(p.ws + OFF_U) + (size_t)it * 8192;
    bf16_t* Wg = (bf16_t*)(p.ws + OFF_WG) + (size_t)it * 8192;
    bf16_t* QGg = (bf16_t*)(p.ws + OFF_QG) + (size_t)it * 8192;
    bf16_t* KDTg = (bf16_t*)(p.ws + OFF_KDT) + (size_t)it * 8192;
    bf16_t* QKg = (bf16_t*)(p.ws + OFF_QK) + (size_t)it * 4096;
    float* EGg = (float*)(p.ws + OFF_EG);
    bf16_t* Qs = (bf16_t*)smem;
    bf16_t* Ks = Qs + 64 * 136;
    bf16_t* Kbs = Ks + 64 * 136;
    float* Am = (float*)(smem + 3 * 17408);
    float* gcs = Am + 64 * 68;
    float* betas = gcs + 64;
    float* red = betas + 64;
    __syncthreads();
    const int j = tid & 127;
    const bool isk = tid >= 128;
    float val[64];
    char* R1 = smem + 2 * 17408;
    char* R2 = smem + 3 * 17408;
    {
        const bf16_t* pb = P + ((ptrdiff_t)tok0 - 3) * PC + C_Q + h * 128;
        u32x4 tv[9];
#pragma unroll
        for (int it9 = 0; it9 < 9; ++it9) {
            const int c = tid + 256 * it9;
            const int cc = c < 67 * 32 ? c : 67 * 32 - 1;
            const int r = cc >> 5, sg = cc & 31;
            const bool ok = n > 0 || r >= 3;
            const u32x4 v = *(const u32x4*)(pb + (ptrdiff_t)(ok ? r : 3) * PC + (sg >> 4) * 1024 + (sg & 15) * 8);
            tv[it9] = ok ? v : (u32x4){0u, 0u, 0u, 0u};
        }
        __builtin_amdgcn_sched_barrier(0);
        if (tid < 64) {
            float g = GLOG[(size_t)(tok0 + tid) * 8 + h];
    #pragma unroll
            for (int o = 1; o < 64; o <<= 1) {
                const float t = __shfl_up(g, o);
                if (lane >= o) g += t;
            }
            gcs[tid] = g;
            betas[tid] = BETA[(size_t)(tok0 + tid) * 8 + h];
        }
        __builtin_amdgcn_sched_barrier(0);
#pragma unroll
        for (int it9 = 0; it9 < 9; ++it9) {
            const int c = tid + 256 * it9;
            if (c < 67 * 32) *(u32x4*)(R1 + (c >> 5) * 512 + (c & 31) * 16) = tv[it9];
        }
    }
    __syncthreads();
    {
        const int cq = (isk ? 1024 : 0) + h * 128 + j;
        const float* cw = p.conv_w + (size_t)l * 4 * 3072;
        const float w0 = cw[cq], w1 = cw[3072 + cq], w2 = cw[2 * 3072 + cq], w3 = cw[3 * 3072 + cq];
        const bf16_t* col = (const bf16_t*)(R1 + (isk ? 256 : 0)) + j;
        float x3 = bf2f(col[0]), x2 = bf2f(col[256]), x1 = bf2f(col[512]);
#pragma unroll
        for (int i = 0; i < 64; ++i) {
            const float x0 = bf2f(col[(i + 3) * 256]);
            val[i] = silu_f(w0 * x3 + w1 * x2 + w2 * x1 + w3 * x0);
            x3 = x2; x2 = x1; x1 = x0;
            if ((i & 15) == 15) __builtin_amdgcn_sched_barrier(0);
        }
    }
#pragma unroll
    for (int i = 0; i < 64; ++i) {
        const float s = wave_sum(val[i] * val[i]);
        if (lane == 0) red[wid * 64 + i] = s;
        if ((i & 7) == 7) __builtin_amdgcn_sched_barrier(0);
    }
    __syncthreads();
    const float glast = gcs[63];
    {
        const bf16_t* pb = P + ((ptrdiff_t)tok0 - 3) * PC + C_Q + 2048 + h * 128;
        u32x4 tv[5];
#pragma unroll
        for (int it5 = 0; it5 < 5; ++it5) {
            const int c = tid + 256 * it5;
            const int cc = c < 67 * 16 ? c : 67 * 16 - 1;
            const int r = cc >> 4, sg = cc & 15;
            const bool ok = n > 0 || r >= 3;
            const u32x4 v = *(const u32x4*)(pb + (ptrdiff_t)(ok ? r : 3) * PC + sg * 8);
            tv[it5] = ok ? v : (u32x4){0u, 0u, 0u, 0u};
        }
        __builtin_amdgcn_sched_barrier(0);
#pragma unroll
        for (int it5 = 0; it5 < 5; ++it5) {
            const int c = tid + 256 * it5;
            if (c < 67 * 16) *(u32x4*)(R2 + (c >> 4) * 256 + (c & 15) * 16) = tv[it5];
        }
    }
    if (!isk) {
#pragma unroll
        for (int i = 0; i < 64; ++i) {
            const float rn = rsqrtf(red[i] + red[64 + i] + NORM_EPS);
            const float qv = val[i] * rn * 0.08838834764831845f;
            Qs[i * 136 + j] = f2bf(qv);
            QGg[i * 128 + perm32(j)] = f2bf(qv * __expf(gcs[i]));
            if ((i & 7) == 7) __builtin_amdgcn_sched_barrier(0);
        }
    } else {
        unsigned pk[32];
#pragma unroll
        for (int i = 0; i < 64; ++i) {
            const float rn = rsqrtf(red[128 + i] + red[192 + i] + NORM_EPS);
            const float kv = val[i] * rn;
            const float gi = gcs[i], bi = betas[i];
            Ks[i * 136 + j] = f2bf(kv);
            Kbs[i * 136 + j] = f2bf(kv * bi);
            const bf16_t kd = f2bf(kv * __expf(glast - gi));
            if (i & 1) pk[perm32(i) >> 1] |= ((unsigned)kd) << 16; else pk[perm32(i) >> 1] = kd;
            val[i] = kv * bi * __expf(gi);
            if ((i & 7) == 7) __builtin_amdgcn_sched_barrier(0);
        }
#pragma unroll
        for (int i = 0; i < 8; ++i) *(uint4*)(KDTg + j * 64 + i * 8) = make_uint4(pk[i * 4], pk[i * 4 + 1], pk[i * 4 + 2], pk[i * 4 + 3]);
    }
    __syncthreads();
    if (!isk) {
        const int cv = 2048 + h * 128 + j;
        const float* cw = p.conv_w + (size_t)l * 4 * 3072;
        const float w0 = cw[cv], w1 = cw[3072 + cv], w2 = cw[2 * 3072 + cv], w3 = cw[3 * 3072 + cv];
        const bf16_t* col = (const bf16_t*)R2 + j;
        float x3 = bf2f(col[0]), x2 = bf2f(col[128]), x1 = bf2f(col[256]);
#pragma unroll
        for (int i = 0; i < 64; ++i) {
            const float x0 = bf2f(col[(i + 3) * 128]);
            val[i] = silu_f(w0 * x3 + w1 * x2 + w2 * x1 + w3 * x0) * betas[i];
            x3 = x2; x2 = x1; x1 = x0;
            if ((i & 15) == 15) __builtin_amdgcn_sched_barrier(0);
        }
    }
    __syncthreads();
    {
        f32x4 aA[4], aQ[4];
#pragma unroll
        for (int nt = 0; nt < 4; ++nt) { aA[nt] = (f32x4){0.f, 0.f, 0.f, 0.f}; aQ[nt] = (f32x4){0.f, 0.f, 0.f, 0.f}; }
#pragma unroll
        for (int ksi = 0; ksi < 4; ++ksi) {
            const bf16x8 fa = *(const bf16x8*)(Kbs + (wid * 16 + fr) * 136 + ksi * 32 + fq * 8);
            const bf16x8 fqv = *(const bf16x8*)(Qs + (wid * 16 + fr) * 136 + ksi * 32 + fq * 8);
#pragma unroll
            for (int nt = 0; nt < 4; ++nt) {
                const bf16x8 fb = *(const bf16x8*)(Ks + (nt * 16 + fr) * 136 + ksi * 32 + fq * 8);
                aA[nt] = mfma16(fa, fb, aA[nt]);
                aQ[nt] = mfma16(fqv, fb, aQ[nt]);
            }
        }
#pragma unroll
        for (int nt = 0; nt < 4; ++nt) {
            const int jc = nt * 16 + fr;
            const float gj = gcs[jc];
#pragma unroll
            for (int r = 0; r < 4; ++r) {
                const int i = wid * 16 + fq * 4 + r;
                const float dec = jc <= i ? __expf(gcs[i] - gj) : 0.f;
                Am[i * 68 + jc] = jc < i ? aA[nt][r] * dec : 0.f;
                QKg[i * 64 + perm32(jc)] = f2bf(aQ[nt][r] * dec);
            }
        }
    }
    __syncthreads();
#pragma unroll
    for (int i = 1; i < 64; ++i) {
        float s0 = 0.f, s1 = 0.f, s2 = 0.f, s3 = 0.f;
#pragma unroll
        for (int j4 = 0; j4 < (i + 3) / 4; ++j4) {
            const float4 a = *(const float4*)&Am[i * 68 + j4 * 4];
            s0 += a.x * val[j4 * 4];
            s1 += a.y * val[j4 * 4 + 1];
            s2 += a.z * val[j4 * 4 + 2];
            s3 += a.w * val[j4 * 4 + 3];
        }
        val[i] -= (s0 + s1) + (s2 + s3);
        if ((i & 3) == 3) __builtin_amdgcn_sched_barrier(0);
    }
    if (!isk) {
#pragma unroll
        for (int i = 0; i < 64; i += 4)
            *(float4*)(Ug + (((i >> 4) * 8 + (j >> 4)) * 64 + ((i >> 2) & 3) * 16 + (j & 15)) * 4) = make_float4(val[i], val[i + 1], val[i + 2], val[i + 3]);
    } else {
        const int pj = perm32(j);
#pragma unroll
        for (int i = 0; i < 64; ++i) Wg[i * 128 + pj] = f2bf(val[i]);
    }
    if (tid == 0) EGg[it] = __expf(glast);
}

__device__ __forceinline__ void gdn_scan_item(const Params& p, int l, int bh, char* smem) {
    smem += opaque_zero();
    const int tid0 = opaque_tid();
    const int b = bh >> 3, h = bh & 7;
    constexpr int WBY = 64 * 272, BUFB = WBY + 128 * 128;
    const float* EGg = (const float*)(p.ws + OFF_EG);
    f32x4 S[8][2];
#pragma unroll
    for (int mt = 0; mt < 8; ++mt) { S[mt][0] = (f32x4){0.f, 0.f, 0.f, 0.f}; S[mt][1] = (f32x4){0.f, 0.f, 0.f, 0.f}; }
    u32x4 stg[8];
    f32x4 ucur[4][2];
    {
        const size_t item = (size_t)bh * 32;
        const bf16_t* Wp = (const bf16_t*)(p.ws + OFF_WG) + item * 8192;
        const bf16_t* KDTp = (const bf16_t*)(p.ws + OFF_KDT) + item * 8192;
        const float* Up = (const float*)(p.ws + OFF_U) + item * 8192;
        const int lane = tid0 & 63, w = tid0 >> 6, fr = lane & 15, fq = lane >> 4;
#pragma unroll
        for (int i = 0; i < 4; ++i) {
            stg[i] = ldg_b<u32x4>(Wp, 16u * (unsigned)(tid0 + 256 * i));
            stg[4 + i] = ldg_b<u32x4>(KDTp, 16u * (unsigned)(tid0 + 256 * i));
        }
#pragma unroll
        for (int mt = 0; mt < 4; ++mt)
#pragma unroll
            for (int nt = 0; nt < 2; ++nt) ucur[mt][nt] = ldg_b<f32x4>(Up, 16u * (unsigned)((mt * 8 + w * 2 + nt) * 64 + lane));
        __syncthreads();
#pragma unroll
        for (int i = 0; i < 4; ++i) {
            const int c = tid0 + 256 * i;
            *(u32x4*)(smem + (c >> 4) * 272 + (c & 15) * 16) = stg[i];
            *(u32x4*)(smem + WBY + (c >> 3) * 128 + ((((c & 7) ^ ((c >> 3) & 7))) << 4)) = stg[4 + i];
        }
        __syncthreads();
    }
    for (int n = 0; n < 32; ++n) {
        int tid = tid0;
        asm volatile("" : "+v"(tid));
        const int lane = tid & 63, w = tid >> 6, fr = lane & 15, fq = lane >> 4;
        const char* cur = smem + (n & 1) * BUFB;
        const size_t item = (size_t)bh * 32 + n;
        const float eg = EGg[item];
        bf16_t* SBp = (bf16_t*)(p.ws + OFF_SB) + item * 16384;
        bf16_t* VNp = (bf16_t*)(p.ws + OFF_VN) + item * 8192;
        if (n + 1 < 32) {
            const bf16_t* Wp = (const bf16_t*)(p.ws + OFF_WG) + (item + 1) * 8192;
            const bf16_t* KDTp = (const bf16_t*)(p.ws + OFF_KDT) + (item + 1) * 8192;
#pragma unroll
            for (int i = 0; i < 4; ++i) {
                stg[i] = ldg_b<u32x4>(Wp, 16u * (unsigned)(tid + 256 * i));
                stg[4 + i] = ldg_b<u32x4>(KDTp, 16u * (unsigned)(tid + 256 * i));
            }
        }
        bf16x8 sf[4][2];
#pragma unroll
        for (int pp = 0; pp < 4; ++pp)
#pragma unroll
            for (int nt = 0; nt < 2; ++nt) {
                u32x4 t;
                t[0] = pack2(S[2 * pp][nt][0], S[2 * pp][nt][1]);
                t[1] = pack2(S[2 * pp][nt][2], S[2 * pp][nt][3]);
                t[2] = pack2(S[2 * pp + 1][nt][0], S[2 * pp + 1][nt][1]);
                t[3] = pack2(S[2 * pp + 1][nt][2], S[2 * pp + 1][nt][3]);
                stg_b<u32x4>(SBp, 16u * (unsigned)((pp * 8 + w * 2 + nt) * 64 + lane), t);
                sf[pp][nt] = (bf16x8)t;
            }
        bf16x8 vf[2][2];
#pragma unroll
        for (int q = 0; q < 2; ++q) {
            u32x4 t0, t1;
#pragma unroll
            for (int hh = 0; hh < 2; ++hh) {
                const int mt = 2 * q + hh;
                f32x4 a0 = (f32x4){0.f, 0.f, 0.f, 0.f}, a1 = a0;
#pragma unroll
                for (int pp = 0; pp < 4; ++pp) {
                    const bf16x8 wf = *(const bf16x8*)(cur + (mt * 16 + fr) * 272 + pp * 64 + fq * 16);
                    a0 = mfma16(wf, sf[pp][0], a0);
                    a1 = mfma16(wf, sf[pp][1], a1);
                }
                const f32x4 v0 = ucur[mt][0] - a0, v1 = ucur[mt][1] - a1;
                t0[2 * hh] = pack2(v0[0], v0[1]); t0[2 * hh + 1] = pack2(v0[2], v0[3]);
                t1[2 * hh] = pack2(v1[0], v1[1]); t1[2 * hh + 1] = pack2(v1[2], v1[3]);
            }
            stg_b<u32x4>(VNp, 16u * (unsigned)((q * 8 + w * 2) * 64 + lane), t0);
            stg_b<u32x4>(VNp, 16u * (unsigned)((q * 8 + w * 2 + 1) * 64 + lane), t1);
            vf[q][0] = (bf16x8)t0;
            vf[q][1] = (bf16x8)t1;
        }
        if (n + 1 < 32) {
            const float* Up = (const float*)(p.ws + OFF_U) + (item + 1) * 8192;
#pragma unroll
            for (int mt = 0; mt < 4; ++mt)
#pragma unroll
                for (int nt = 0; nt < 2; ++nt) ucur[mt][nt] = ldg_b<f32x4>(Up, 16u * (unsigned)((mt * 8 + w * 2 + nt) * 64 + lane));
        }
#pragma unroll
        for (int mt = 0; mt < 8; ++mt) {
            S[mt][0] *= eg;
            S[mt][1] *= eg;
#pragma unroll
            for (int q = 0; q < 2; ++q) {
                const bf16x8 kf = *(const bf16x8*)(cur + WBY + (mt * 16 + fr) * 128 + (((q * 4 + fq) ^ (fr & 7)) << 4));
                S[mt][0] = mfma16(kf, vf[q][0], S[mt][0]);
                S[mt][1] = mfma16(kf, vf[q][1], S[mt][1]);
            }
        }
        if (n + 1 < 32) {
            char* nxt = smem + ((n + 1) & 1) * BUFB;
#pragma unroll
            for (int i = 0; i < 4; ++i) {
                const int c = tid + 256 * i;
                *(u32x4*)(nxt + (c >> 4) * 272 + (c & 15) * 16) = stg[i];
                *(u32x4*)(nxt + WBY + (c >> 3) * 128 + ((((c & 7) ^ ((c >> 3) & 7))) << 4)) = stg[4 + i];
            }
        }
        __syncthreads();
    }
    const int lane = tid0 & 63, w = tid0 >> 6, fr = lane & 15, fq = lane >> 4;
    float* so = p.out + O_SSM_P + ((size_t)(l * NB + b) * 8 + h) * 16384;
#pragma unroll
    for (int mt = 0; mt < 8; ++mt)
#pragma unroll
        for (int nt = 0; nt < 2; ++nt)
#pragma unroll
            for (int r = 0; r < 4; ++r) so[(mt * 16 + fq * 4 + r) * 128 + w * 32 + nt * 16 + fr] = S[mt][nt][r];
}

__device__ __forceinline__ void gdn_out_item(const Params& p, int l, int it) {
    const int tid = opaque_tid(), lane = tid & 63, w = tid >> 6, fr = lane & 15, fq = lane >> 4;
    const int n = it & 31, h = (it >> 5) & 7, b = it >> 8;
    const bf16_t* QGp = (const bf16_t*)(p.ws + OFF_QG) + (size_t)it * 8192;
    const bf16_t* QKp = (const bf16_t*)(p.ws + OFF_QK) + (size_t)it * 4096;
    const bf16_t* SBp = (const bf16_t*)(p.ws + OFF_SB) + (size_t)it * 16384;
    const bf16_t* VNp = (const bf16_t*)(p.ws + OFF_VN) + (size_t)it * 8192;
    const bf16_t* P = (const bf16_t*)(p.ws + OFF_P);
    bf16_t* YB = (bf16_t*)(p.ws + OFF_YB);
    bf16x8 qg[4], qk[2];
#pragma unroll
    for (int pp = 0; pp < 4; ++pp) qg[pp] = ldg_b<bf16x8>(QGp, 2u * (unsigned)((w * 16 + fr) * 128 + pp * 32 + fq * 8));
#pragma unroll
    for (int q = 0; q < 2; ++q) qk[q] = ldg_b<bf16x8>(QKp, 2u * (unsigned)((w * 16 + fr) * 64 + q * 32 + fq * 8));
    f32x4 acc[8];
    float ss = 0.f;
    const size_t tok = (size_t)b * SEQ + n * 64 + w * 16 + fr;
    uint2 zz[8];
#pragma unroll
    for (int nt = 0; nt < 8; ++nt) zz[nt] = *(const uint2*)(P + tok * PC + C_ZB + h * 128 + nt * 16 + fq * 4);
#pragma unroll
    for (int g = 0; g < 2; ++g) {
        bf16x8 sb[4][4], vn[4][2];
#pragma unroll
        for (int t = 0; t < 4; ++t) {
#pragma unroll
            for (int pp = 0; pp < 4; ++pp) sb[t][pp] = ldg_b<bf16x8>(SBp, 16u * (unsigned)((pp * 8 + g * 4 + t) * 64 + lane));
#pragma unroll
            for (int q = 0; q < 2; ++q) vn[t][q] = ldg_b<bf16x8>(VNp, 16u * (unsigned)((q * 8 + g * 4 + t) * 64 + lane));
        }
        __builtin_amdgcn_sched_barrier(0);
#pragma unroll
        for (int t = 0; t < 4; ++t) {
            f32x4 a = (f32x4){0.f, 0.f, 0.f, 0.f};
#pragma unroll
            for (int pp = 0; pp < 4; ++pp) a = mfma16(sb[t][pp], qg[pp], a);
#pragma unroll
            for (int q = 0; q < 2; ++q) a = mfma16(vn[t][q], qk[q], a);
            acc[g * 4 + t] = a;
            ss += a[0] * a[0] + a[1] * a[1] + a[2] * a[2] + a[3] * a[3];
        }
        __builtin_amdgcn_sched_barrier(0);
    }
    ss += __shfl_xor(ss, 16);
    ss += __shfl_xor(ss, 32);
    const float rinv = rsqrtf(ss * (1.f / 128.f) + NORM_EPS);
#pragma unroll
    for (int nt = 0; nt < 8; ++nt) {
        const int v0 = nt * 16 + fq * 4;
        const float4 g = *(const float4*)(p.onorm_g + l * 128 + v0);
        const uint2 z = zz[nt];
        const float y0 = acc[nt][0] * rinv * g.x * lo_bf(z.x), y1 = acc[nt][1] * rinv * g.y * hi_bf(z.x);
        const float y2 = acc[nt][2] * rinv * g.z * lo_bf(z.y), y3 = acc[nt][3] * rinv * g.w * hi_bf(z.y);
        *(uint2*)(YB + tok * 1024 + h * 128 + v0) = make_uint2(pack2(y0, y1), pack2(y2, y3));
    }
}

constexpr int N_GMLP_P = NB * 16 * 8;
constexpr int N_GDN_S = DBT * 8;
constexpr int N_GMLP_S = DBT;
constexpr int N_CONV = NB + DBT;
constexpr int N_OTHER = N_GMLP_P + N_GDN_S + N_GMLP_S + N_CONV;

__device__ __forceinline__ void other_item(const Params& p, int l, int it, char* smem) {
    if (it < N_GMLP_P) gmlp_prompt_item(p, l, it, smem);
    else if (it < N_GMLP_P + N_GDN_S) gdn_sample_item(p, l, it - N_GMLP_P, smem);
    else if (it < N_GMLP_P + N_GDN_S + N_GMLP_S) gmlp_sample_item(p, l, it - N_GMLP_P - N_GDN_S, smem);
    else conv_state_item(p, l, it - N_GMLP_P - N_GDN_S - N_GMLP_S);
}

__device__ __forceinline__ void phase_mixb(const Params& p, int l, char* smem) {
    const int G = gridDim.x;
    if (G >= 128) {
        if (blockIdx.x < 64) gdn_scan_item(p, l, blockIdx.x, smem);
        else for (int it = blockIdx.x - 64; it < N_OTHER; it += G - 64) other_item(p, l, it, smem);
    } else {
        for (int it = blockIdx.x; it < 64; it += G) gdn_scan_item(p, l, it, smem);
        for (int it = blockIdx.x; it < N_OTHER; it += G) other_item(p, l, it, smem);
    }
}

#define FRESH(q) const Params& q = p
#define XB_TMO      128
#define XB_XCNT(j)  (256  + 64 * (j))
#define XB_XSUB(j)  (1280 + 64 * (j))
#define XB_XGEN(j)  (2304 + 64 * (j))
#define XB_TOP      3328
#define XB_TOPGEN   3392
#define XCD_BAR_WORDS 3456
#define XB_SPIN_CAP (1u << 22)
#define LAS __attribute__((address_space(3)))
__device__ __forceinline__ unsigned xb_ld(unsigned* p) { return __hip_atomic_load(p, __ATOMIC_RELAXED, __HIP_MEMORY_SCOPE_AGENT); }
__device__ __forceinline__ unsigned xb_add(unsigned* p, unsigned v) { return __hip_atomic_fetch_add(p, v, __ATOMIC_RELAXED, __HIP_MEMORY_SCOPE_AGENT); }
__device__ __forceinline__ unsigned xb_xcc_id() { return (unsigned)__builtin_amdgcn_s_getreg((3 << 11) | 20) & 0xFu; }
#define XB_SPIN(cond, bar) do { unsigned _sp = 0; while (cond) { __builtin_amdgcn_s_sleep(1); \
    if ((++_sp & 255u) == 0u) { if (xb_ld(&(bar)[XB_TMO])) break; if (_sp > XB_SPIN_CAP) { atomicAdd(&(bar)[XB_TMO], 1u); break; } } } } while (0)
struct XcdBarrier { unsigned* bar; unsigned x; volatile LAS unsigned* st; };
__device__ __forceinline__ XcdBarrier xcd_barrier_post(unsigned* bar, volatile LAS unsigned* st) {
    XcdBarrier b; b.bar = bar; b.x = xb_xcc_id(); b.st = st;
    if (threadIdx.x == 0) (void)xb_add(&bar[XB_XCNT(b.x)], 1u);
    return b;
}
__device__ __forceinline__ void xcd_barrier_complete(unsigned* bar, unsigned x, unsigned& nloc, unsigned& nx) {
    const unsigned G = gridDim.x * gridDim.y * gridDim.z;
    unsigned sum, cnt, mine, sp = 0u;
    for (;;) {
        sum = 0u; cnt = 0u; mine = 0u;
#pragma unroll
        for (unsigned j = 0; j < 16; ++j) { const unsigned c = xb_ld(&bar[XB_XCNT(j)]); sum += c; cnt += (c > 0u) ? 1u : 0u; mine = (j == x) ? c : mine; }
        if (sum == G) break;
        __builtin_amdgcn_s_sleep(1);
        if ((++sp & 255u) == 0u) { if (xb_ld(&bar[XB_TMO])) break; if (sp > XB_SPIN_CAP) { atomicAdd(&bar[XB_TMO], 1u); break; } }
    }
    nloc = mine > 0u ? mine : 1u; nx = cnt > 0u ? cnt : 1u;
}
__device__ __forceinline__ void xcd_barrier(const XcdBarrier& b) {
    asm volatile("s_waitcnt vmcnt(0)" ::: "memory");
    __syncthreads();
    if (threadIdx.x == 0) {
        unsigned* bar = b.bar;
        __builtin_amdgcn_s_waitcnt(0);
        unsigned nloc = b.st[0], nx = b.st[1];
        if (nloc == 0u) { xcd_barrier_complete(bar, b.x, nloc, nx); b.st[0] = nloc; b.st[1] = nx; }
        const unsigned old = xb_add(&bar[XB_XSUB(b.x)], 1u);
        const unsigned gen = old / nloc;
        if (old + 1u == (gen + 1u) * nloc) {
            __builtin_amdgcn_fence(__ATOMIC_RELEASE, "agent");
            asm volatile("s_waitcnt vmcnt(0)" ::: "memory");
            const unsigned og = xb_add(&bar[XB_TOP], 1u);
            const unsigned tg = og / nx;
            if (og + 1u == (tg + 1u) * nx) xb_add(&bar[XB_TOPGEN], 1u);
            else XB_SPIN(xb_ld(&bar[XB_TOPGEN]) == tg, bar);
            __builtin_amdgcn_fence(__ATOMIC_ACQUIRE, "agent");
            xb_add(&bar[XB_XGEN(b.x)], 1u);
            asm volatile("s_waitcnt vmcnt(0)" ::: "memory");
        } else {
            XB_SPIN(xb_ld(&bar[XB_XGEN(b.x)]) == gen, bar);
            __builtin_amdgcn_fence(__ATOMIC_ACQUIRE, "agent");
            asm volatile("s_waitcnt vmcnt(0)" ::: "memory");
        }
    }
    __syncthreads();
}

__global__ void __launch_bounds__(256, 2) fwd_megakernel(Params p) {
    extern __shared__ __attribute__((aligned(16))) char smem[];
    __shared__ uint4 xb_words;
    cg::grid_group grid = cg::this_grid();
    unsigned* bar = (unsigned*)(p.ws + OFF_BAR);
    if (blockIdx.x == 0) for (int i = threadIdx.x; i < XCD_BAR_WORDS; i += 256) __hip_atomic_store(bar + i, 0u, __ATOMIC_RELAXED, __HIP_MEMORY_SCOPE_AGENT);
    if (threadIdx.x == 0) xb_words = make_uint4(0u, 0u, 0u, 0u);
    { FRESH(q); phase0(q, smem); }
    grid.sync();
    const XcdBarrier xb = xcd_barrier_post(bar, (volatile LAS unsigned*)&xb_words);
#define GBAR() xcd_barrier(xb)
    for (int l = 0; l < DEPTH; ++l) {
        { FRESH(q); phase_rows(q, l); }
        GBAR();
        { FRESH(q); phase_inproj256(q, l, smem); }
        GBAR();
        { FRESH(q); for (int it = blockIdx.x; it < NCHK; it += gridDim.x) gdn_prep_item(q, l, it, smem); }
        GBAR();
        { FRESH(q); phase_mixb(q, l, smem); }
        GBAR();
        { FRESH(q); for (int it = blockIdx.x; it < NCHK; it += gridDim.x) gdn_out_item(q, l, it); }
        GBAR();
        { FRESH(q); phase_merge(q, l, smem); }
        GBAR();
        { FRESH(q); phase_outproj(q, l, smem); }
        GBAR();
    }
    { FRESH(q); phase_rows(q, DEPTH); }
}

extern "C" void kernel_launch(void* const* d_in, const int* in_sizes, int n_in, void* d_out, int out_size, void* d_ws, size_t ws_size,
                              hipStream_t stream) {
    static int grid_blocks = 0;
    if (!grid_blocks) {
        int dev = 0, cus = 0, per_cu = 0;
        hipGetDevice(&dev);
        hipDeviceGetAttribute(&cus, hipDeviceAttributeMultiprocessorCount, dev);
        hipFuncSetAttribute((const void*)fwd_megakernel, hipFuncAttributeMaxDynamicSharedMemorySize, SMEM_BYTES);
        hipOccupancyMaxActiveBlocksPerMultiprocessor(&per_cu, fwd_megakernel, 256, SMEM_BYTES);
        if (per_cu > 2) per_cu = 2;
        if (per_cu < 1) per_cu = 1;
        grid_blocks = cus * per_cu;
    }
    if (ws_size < WS_NEED) {
        fprintf(stderr, "workspace too small: %zu < %zu\n", ws_size, (size_t)WS_NEED);
        return;
    }
    Params p{};
    const float** f = (const float**)&p;
    for (int i = 0; i < 22; ++i) f[i] = (const float*)d_in[i];
    p.out = (float*)d_out;
    p.ws = (char*)d_ws;
    void* args[] = {&p};
    hipError_t e = hipLaunchCooperativeKernel((const void*)fwd_megakernel, dim3(grid_blocks), dim3(256), args, SMEM_BYTES, stream);
    if (e != hipSuccess) fprintf(stderr, "cooperative launch failed: %s (grid %d)\n", hipGetErrorString(e), grid_blocks);
}
```

```cpp
#include <hip/hip_runtime.h>
#include <hip/hip_cooperative_groups.h>
#include <cstdio>
namespace cg = cooperative_groups;

typedef unsigned short bf16_t;
typedef short bf16x8 __attribute__((ext_vector_type(8)));
typedef float f32x4 __attribute__((ext_vector_type(4)));
typedef unsigned u32x4 __attribute__((ext_vector_type(4)));

constexpr int D = 1024;
constexpr int NB = 8, SEQ = 2048, DEPTH = 4, DBT = 128, DSQ = 4;
constexpr int TP = NB * SEQ;
constexpr int TS = DBT * DSQ;
constexpr int T = TP + TS;
constexpr int PIN = 9232;
constexpr int PC = 9216;
constexpr int NPAD = 9344;
constexpr int NROWB = NB + DBT;
constexpr float ALPHA_DN = 1.681792830507429f;
constexpr float LN_EPS = 1e-5f, NORM_EPS = 1e-6f;
constexpr int C_UA = 0, C_VA = 1024, C_ZA = 2048, C_Q = 3072, C_ZB = 6144, C_GA = 7168, C_GB = 8192;

constexpr size_t O_Y_P = 0, O_Y_S = 16777216, O_CONV_P = 17301504, O_SSM_P = 17596416, O_CV_P = 21790720,
                 O_CONV_S = 25985024, O_SSM_S = 30703616, O_CV_S = 97812480;

constexpr size_t SZ_WT_IN = (size_t)DEPTH * NPAD * 1024 * 2;
constexpr size_t SZ_WT_SQ = (size_t)DEPTH * 1024 * 1024 * 2;
constexpr size_t OFF_WT_IN = 0;
constexpr size_t OFF_WT_PA = OFF_WT_IN + SZ_WT_IN;
constexpr size_t OFF_WT_PB = OFF_WT_PA + SZ_WT_SQ;
constexpr size_t OFF_WT_O = OFF_WT_PB + SZ_WT_SQ;
constexpr size_t OFF_MOD = OFF_WT_O + SZ_WT_SQ;
constexpr size_t OFF_X = OFF_MOD + (size_t)DEPTH * NROWB * 3072 * 4;
constexpr size_t OFF_TT = OFF_X + (size_t)T * 1024 * 4;
constexpr size_t OFF_H = OFF_TT + (size_t)T * 1024 * 4;
constexpr size_t OFF_YA = OFF_H + (size_t)T * 1024 * 2;
constexpr size_t OFF_YB = OFF_YA + (size_t)T * 1024 * 2;
constexpr size_t OFF_MM = OFF_YB + (size_t)T * 1024 * 2;
constexpr size_t OFF_P = OFF_MM + (size_t)T * 1024 * 2;
constexpr size_t OFF_BETA = OFF_P + (size_t)T * PC * 2;
constexpr size_t OFF_GLOG = OFF_BETA + (size_t)T * 8 * 4;
constexpr int NCHK = 2048;
constexpr size_t OFF_U = OFF_GLOG + (size_t)T * 8 * 4;
constexpr size_t OFF_WG = OFF_U + (size_t)NCHK * 8192 * 4;
constexpr size_t OFF_QG = OFF_WG + (size_t)NCHK * 8192 * 2;
constexpr size_t OFF_KDT = OFF_QG + (size_t)NCHK * 8192 * 2;
constexpr size_t OFF_QK = OFF_KDT + (size_t)NCHK * 8192 * 2;
constexpr size_t OFF_EG = OFF_QK + (size_t)NCHK * 4096 * 2;
constexpr size_t OFF_SB = OFF_EG + (size_t)NCHK * 4;
constexpr size_t OFF_VN = OFF_SB + (size_t)NCHK * 16384 * 2;
constexpr size_t OFF_PARK = OFF_VN + (size_t)NCHK * 8192 * 2;
constexpr size_t OFF_STATS = OFF_PARK + (size_t)1024 * 32768;
constexpr size_t OFF_BAR = OFF_STATS + (size_t)T * 2 * 4;
constexpr size_t WS_NEED = OFF_BAR + 16384;

constexpr int SMEM_BYTES = 73728;
constexpr int TILE_BYTES = 128 * 128;

struct Params {
    const float *x_prompt, *x_sample, *state_conv, *state_ssm, *c_prompt, *c_sample, *w_ada, *b_ada, *w_in, *w_s, *b_s,
        *lnv_g, *lnv_b, *conv_w, *a_log, *dt_bias, *onorm_g, *w_pa, *w_pb, *w_o, *ln_g, *ln_b;
    float* out;
    char* ws;
};

__device__ __forceinline__ unsigned pack2(float a, float b) {
    unsigned r;
    asm("v_cvt_pk_bf16_f32 %0, %1, %2" : "=v"(r) : "v"(a), "v"(b));
    return r;
}
__device__ __forceinline__ bf16_t f2bf(float f) { return (bf16_t)(pack2(f, 0.f) & 0xffffu); }
__device__ __forceinline__ float bf2f(bf16_t h) { return __uint_as_float(((unsigned)h) << 16); }
__device__ __forceinline__ float lo_bf(unsigned u) { return __uint_as_float(u << 16); }
__device__ __forceinline__ float hi_bf(unsigned u) { return __uint_as_float(u & 0xffff0000u); }
__device__ __forceinline__ float sigmoid_f(float x) { return __builtin_amdgcn_rcpf(1.f + __builtin_amdgcn_exp2f(-1.4426950408889634f * x)); }
__device__ __forceinline__ float silu_f(float x) { return x * sigmoid_f(x); }
__device__ __forceinline__ float gelu_f(float x) {
    const float y2 = x * (1.5957691216057308f + 0.0713548162726f * x * x);
    return x * __builtin_amdgcn_rcpf(1.f + __builtin_amdgcn_exp2f(-1.4426950408889634f * y2));
}
__device__ __forceinline__ float softplus_f(float x) { return fmaxf(x, 0.f) + log1pf(__expf(-fabsf(x))); }
__device__ __forceinline__ float wave_sum(float v) {
#pragma unroll
    for (int o = 32; o >= 1; o >>= 1) v += __shfl_xor(v, o);
    return v;
}
__device__ __forceinline__ f32x4 mfma16(bf16x8 a, bf16x8 b, f32x4 c) { return __builtin_amdgcn_mfma_f32_16x16x32_bf16(a, b, c, 0, 0, 0); }
template <class Tp> __device__ __forceinline__ Tp ldg_b(const void* base, unsigned boff) { return *(const Tp*)((const char*)base + boff); }
template <class Tp> __device__ __forceinline__ void stg_b(void* base, unsigned boff, Tp v) { *(Tp*)((char*)base + boff) = v; }
__host__ __device__ constexpr int perm32(int k) { return (k & ~31) | (((k >> 2) & 3) << 3) | (((k >> 4) & 1) << 2) | (k & 3); }
__device__ __forceinline__ int opaque_tid() { int t = threadIdx.x; asm volatile("" : "+v"(t)); return t; }
__device__ __forceinline__ int opaque_zero() { int z = 0; asm volatile("" : "+v"(z)); return z; }
__device__ __forceinline__ int cond_row(int row) { return row < TP ? (row >> 11) : (NB + ((row - TP) >> 2)); }

template <int WGM = 8>
__device__ __forceinline__ void tile_map(int L, int ntiles, int nM, int nN, int& tm, int& tn) {
    const int q = ntiles / 8, r = ntiles % 8, xcd = L % 8, off = L / 8;
    const int g = (xcd < r ? xcd * (q + 1) : r * (q + 1) + (xcd - r) * q) + off;
    const int nig = WGM * nN, gid = g / nig, fm = gid * WGM, gsz = (nM - fm) < WGM ? (nM - fm) : WGM;
    tm = fm + (g % nig) % gsz;
    tn = (g % nig) / gsz;
}

template <int MT>
__device__ __forceinline__ void gemm_core(const bf16_t* __restrict__ A, const bf16_t* __restrict__ B, const int K,
                                          f32x4 (&acc)[MT][4], char* smem, const int tid) {
    const int lane = tid & 63, wid = tid >> 6, wr = wid >> 1, wc = wid & 1;
    const int srow = tid >> 3, sseg = (tid & 7) ^ ((tid >> 3) & 7);
    const bf16_t* ag = A + (size_t)srow * K + sseg * 8;
    const bf16_t* bg = B + (size_t)srow * K + sseg * 8;
    const int nk = K >> 6;
#define STAGE(BUF, KT) do { char* d_ = smem + (BUF) * 2 * TILE_BYTES + tid * 16; \
        _Pragma("unroll") for (int i = 0; i < MT; ++i) __builtin_amdgcn_global_load_lds((const unsigned*)(ag + (size_t)(32 * i) * K + (KT) * 64), (__attribute__((address_space(3))) unsigned*)(d_ + i * 4096), 16, 0, 0); \
        _Pragma("unroll") for (int i = 0; i < 4; ++i) __builtin_amdgcn_global_load_lds((const unsigned*)(bg + (size_t)(32 * i) * K + (KT) * 64), (__attribute__((address_space(3))) unsigned*)(d_ + TILE_BYTES + i * 4096), 16, 0, 0); } while (0)
#define COMPUTE(BUF) do { const char* cur = smem + (BUF) * 2 * TILE_BYTES; _Pragma("unroll") for (int kk = 0; kk < 2; ++kk) { \
        bf16x8 af[MT], bfr[4]; const int ko = kk ? kx1 : kx0; \
        _Pragma("unroll") for (int m = 0; m < MT; ++m) af[m] = *(const bf16x8*)(cur + aoff + m * 16 * 128 + ko); \
        _Pragma("unroll") for (int n = 0; n < 4; ++n) bfr[n] = *(const bf16x8*)(cur + boff + n * 16 * 128 + ko); \
        _Pragma("unroll") for (int m = 0; m < MT; ++m) _Pragma("unroll") for (int n = 0; n < 4; ++n) acc[m][n] = mfma16(bfr[n], af[m], acc[m][n]); } } while (0)
    const int fr = lane & 15, fq = lane >> 4;
    const int aoff = (wr * 16 * MT + fr) * 128;
    const int boff = TILE_BYTES + (wc * 64 + fr) * 128;
    const int kx0 = (fq ^ (fr & 7)) << 4, kx1 = ((4 + fq) ^ (fr & 7)) << 4;
    __syncthreads();
    STAGE(0, 0);
    asm volatile("s_waitcnt vmcnt(0)" ::: "memory");
    __syncthreads();
    for (int kt = 0; kt < nk; ++kt) {
        if (kt + 1 < nk) STAGE((kt + 1) & 1, kt + 1);
        COMPUTE(kt & 1);
        asm volatile("s_waitcnt vmcnt(0)" ::: "memory");
        __syncthreads();
    }
#undef STAGE
#undef COMPUTE
}

__device__ __forceinline__ int win_src_col(int np) {
    if (np < 7168) return np;
    if (np < 9216) return np + 16;
    if (np < 9232) return np - 9216 + 7168;
    return -1;
}
__device__ __forceinline__ void transpose_item(const float* __restrict__ src, int ld, bool is_win, bf16_t* __restrict__ dst, int kt, int nt, char* smem) {
    smem += opaque_zero();
    float* tile = (float*)smem;
    const int tid = opaque_tid();
    __syncthreads();
    const int nn = tid & 63, kq = tid >> 6;
    const int np = nt * 64 + nn;
    const int oc = is_win ? win_src_col(np) : np;
#pragma unroll
    for (int i = 0; i < 16; ++i) {
        const int kk = kq + 4 * i;
        tile[kk * 65 + nn] = oc >= 0 ? src[(size_t)(kt * 64 + kk) * ld + oc] : 0.f;
    }
    __syncthreads();
    const int r = tid >> 2, seg = tid & 3;
    unsigned pk[8];
#pragma unroll
    for (int j = 0; j < 8; ++j) pk[j] = pack2(tile[(seg * 16 + 2 * j) * 65 + r], tile[(seg * 16 + 2 * j + 1) * 65 + r]);
    uint4* d = (uint4*)(dst + (size_t)(nt * 64 + r) * 1024 + kt * 64 + seg * 16);
    d[0] = make_uint4(pk[0], pk[1], pk[2], pk[3]);
    d[1] = make_uint4(pk[4], pk[5], pk[6], pk[7]);
}

__device__ __forceinline__ void mod_item(const Params& p, int it, char* smem) {
    smem += opaque_zero();
    float* sc = (float*)smem;
    const int tid = opaque_tid();
    const int rg = it & 7, cb = (it >> 3) % 12, l = it / 96;
    __syncthreads();
    for (int idx = tid; idx < 17 * 1024; idx += 256) {
        const int r = idx >> 10, k = idx & 1023, row = rg * 17 + r;
        const float c = row < NB ? p.c_prompt[row * 1024 + k] : p.c_sample[(row - NB) * 1024 + k];
        sc[idx] = silu_f(c);
    }
    __syncthreads();
    const int col = cb * 256 + tid;
    float acc[17];
#pragma unroll
    for (int r = 0; r < 17; ++r) acc[r] = 0.f;
    const float* wp = p.w_ada + (size_t)l * 1024 * 3072 + col;
    for (int k = 0; k < 1024; k += 4) {
        const float w0 = wp[(size_t)(k + 0) * 3072], w1 = wp[(size_t)(k + 1) * 3072], w2 = wp[(size_t)(k + 2) * 3072], w3 = wp[(size_t)(k + 3) * 3072];
#pragma unroll
        for (int r = 0; r < 17; ++r) {
            const float4 s = *(const float4*)&sc[r * 1024 + k];
            acc[r] += s.x * w0 + s.y * w1 + s.z * w2 + s.w * w3;
        }
    }
    float* mod = (float*)(p.ws + OFF_MOD);
    const float bb = p.b_ada[l * 3072 + col];
#pragma unroll
    for (int r = 0; r < 17; ++r) mod[((size_t)l * NROWB + rg * 17 + r) * 3072 + col] = acc[r] + bb;
}

constexpr int N_TR_IN = (NPAD / 64) * 16;
constexpr int N_TR_SQ = 16 * 16;
constexpr int N_TR_LAYER = N_TR_IN + 3 * N_TR_SQ;
constexpr int N_P0_TR = DEPTH * N_TR_LAYER;
constexpr int N_P0_MOD = DEPTH * 12 * 8;

__device__ __forceinline__ void phase0(const Params& p, char* smem) {
    for (int it = blockIdx.x; it < N_P0_TR + N_P0_MOD; it += gridDim.x) {
        if (it < N_P0_TR) {
            const int l = it / N_TR_LAYER;
            int r = it % N_TR_LAYER;
            if (r < N_TR_IN) {
                transpose_item(p.w_in + (size_t)l * 1024 * PIN, PIN, true, (bf16_t*)(p.ws + OFF_WT_IN) + (size_t)l * NPAD * 1024, r & 15, r >> 4, smem);
            } else {
                r -= N_TR_IN;
                const int which = r / N_TR_SQ;
                r %= N_TR_SQ;
                const float* src = (which == 0 ? p.w_pa : which == 1 ? p.w_pb : p.w_o) + (size_t)l * 1024 * 1024;
                bf16_t* dst = (bf16_t*)(p.ws + (which == 0 ? OFF_WT_PA : which == 1 ? OFF_WT_PB : OFF_WT_O)) + (size_t)l * 1024 * 1024;
                transpose_item(src, 1024, false, dst, r & 15, r >> 4, smem);
            }
        } else {
            mod_item(p, it - N_P0_TR, smem);
        }
    }
}

__device__ __forceinline__ void phase_rows(const Params& p, int l) {
    const int tid = opaque_tid();
    const int lane = tid & 63;
    const int gw = blockIdx.x * 4 + (tid >> 6), nw = gridDim.x * 4;
    float* X = (float*)(p.ws + OFF_X);
    const float* TT = (const float*)(p.ws + OFF_TT);
    bf16_t* H = (bf16_t*)(p.ws + OFF_H);
    const float* mod = (const float*)(p.ws + OFF_MOD);
    for (int row = gw; row < T; row += nw) {
        float v[16];
        if (l == 0) {
            const float* src = row < TP ? p.x_prompt + (size_t)row * 1024 : p.x_sample + (size_t)(row - TP) * 1024;
#pragma unroll
            for (int j = 0; j < 4; ++j) {
                const float4 t = *(const float4*)(src + j * 256 + lane * 4);
                v[j * 4 + 0] = t.x; v[j * 4 + 1] = t.y; v[j * 4 + 2] = t.z; v[j * 4 + 3] = t.w;
            }
        } else {
            const float* src = TT + (size_t)row * 1024;
            float s = 0.f;
#pragma unroll
            for (int j = 0; j < 4; ++j) {
                const float4 t = *(const float4*)(src + j * 256 + lane * 4);
                v[j * 4 + 0] = t.x; v[j * 4 + 1] = t.y; v[j * 4 + 2] = t.z; v[j * 4 + 3] = t.w;
                s += t.x + t.y + t.z + t.w;
            }
            const float mean = wave_sum(s) * (1.f / 1024.f);
            float q = 0.f;
#pragma unroll
            for (int e = 0; e < 16; ++e) { v[e] -= mean; q += v[e] * v[e]; }
            const float rstd = rsqrtf(wave_sum(q) * (1.f / 1024.f) + LN_EPS);
            const float* g = p.ln_g + (l - 1) * 1024;
            const float* bb = p.ln_b + (l - 1) * 1024;
#pragma unroll
            for (int j = 0; j < 4; ++j) {
                const float4 gg = *(const float4*)(g + j * 256 + lane * 4);
                const float4 be = *(const float4*)(bb + j * 256 + lane * 4);
                v[j * 4 + 0] = v[j * 4 + 0] * rstd * gg.x + be.x;
                v[j * 4 + 1] = v[j * 4 + 1] * rstd * gg.y + be.y;
                v[j * 4 + 2] = v[j * 4 + 2] * rstd * gg.z + be.z;
                v[j * 4 + 3] = v[j * 4 + 3] * rstd * gg.w + be.w;
            }
        }
        if (l == DEPTH) {
            float* dst = row < TP ? p.out + O_Y_P + (size_t)row * 1024 : p.out + O_Y_S + (size_t)(row - TP) * 1024;
#pragma unroll
            for (int j = 0; j < 4; ++j) *(float4*)(dst + j * 256 + lane * 4) = make_float4(v[j * 4], v[j * 4 + 1], v[j * 4 + 2], v[j * 4 + 3]);
            continue;
        }
        if (lane == 0) *(float2*)((float*)(p.ws + OFF_STATS) + (size_t)row * 2) = make_float2(0.f, 0.f);
        {
            float* dst = X + (size_t)row * 1024;
            float s = 0.f;
#pragma unroll
            for (int j = 0; j < 4; ++j) {
                *(float4*)(dst + j * 256 + lane * 4) = make_float4(v[j * 4], v[j * 4 + 1], v[j * 4 + 2], v[j * 4 + 3]);
                s += v[j * 4] + v[j * 4 + 1] + v[j * 4 + 2] + v[j * 4 + 3];
            }
            const float mean = wave_sum(s) * (1.f / 1024.f);
            float q = 0.f;
#pragma unroll
            for (int e = 0; e < 16; ++e) { v[e] -= mean; q += v[e] * v[e]; }
            const float rstd = rsqrtf(wave_sum(q) * (1.f / 1024.f) + LN_EPS);
            const float* mrow = mod + ((size_t)l * NROWB + cond_row(row)) * 3072;
#pragma unroll
            for (int j = 0; j < 4; ++j) {
                const float4 sh = *(const float4*)(mrow + j * 256 + lane * 4);
                const float4 scl = *(const float4*)(mrow + 1024 + j * 256 + lane * 4);
                const float h0 = v[j * 4 + 0] * rstd * (1.f + scl.x) + sh.x;
                const float h1 = v[j * 4 + 1] * rstd * (1.f + scl.y) + sh.y;
                const float h2 = v[j * 4 + 2] * rstd * (1.f + scl.z) + sh.z;
                const float h3 = v[j * 4 + 3] * rstd * (1.f + scl.w) + sh.w;
                *(uint2*)(H + (size_t)row * 1024 + j * 256 + lane * 4) = make_uint2(pack2(h0, h1), pack2(h2, h3));
            }
        }
    }
}

__device__ __forceinline__ void phase_inproj(const Params& p, int l, char* smem) {
    const bf16_t* H = (const bf16_t*)(p.ws + OFF_H);
    const bf16_t* Wt = (const bf16_t*)(p.ws + OFF_WT_IN) + (size_t)l * NPAD * 1024;
    bf16_t* P = (bf16_t*)(p.ws + OFF_P);
    float* BETA = (float*)(p.ws + OFF_BETA);
    float* GLOG = (float*)(p.ws + OFF_GLOG);
    constexpr int nM = T / 128, nN = NPAD / 128, ntiles = nM * nN;
    for (int L = blockIdx.x; L < ntiles; L += gridDim.x) {
        const int tid = opaque_tid();
        const int lane = tid & 63, wid = tid >> 6, wr = wid >> 1, wc = wid & 1, fr = lane & 15, fq = lane >> 4;
        int tm, tn;
        tile_map(L, ntiles, nM, nN, tm, tn);
        f32x4 acc[4][4];
#pragma unroll
        for (int m = 0; m < 4; ++m)
#pragma unroll
            for (int n = 0; n < 4; ++n) acc[m][n] = (f32x4){0.f, 0.f, 0.f, 0.f};
        gemm_core<4>(H + (size_t)tm * 128 * 1024, Wt + (size_t)tn * 128 * 1024, 1024, acc, smem, tid);
        if (tn == 72) {
            if (wc == 0) {
#pragma unroll
                for (int m = 0; m < 4; ++m) {
                    const int row = tm * 128 + wr * 64 + m * 16 + fr;
#pragma unroll
                    for (int r = 0; r < 4; ++r) {
                        const float a = acc[m][0][r];
                        if (fq < 2) {
                            BETA[(size_t)row * 8 + fq * 4 + r] = sigmoid_f(a);
                        } else {
                            const int h = (fq - 2) * 4 + r;
                            GLOG[(size_t)row * 8 + h] = -__expf(p.a_log[l * 8 + h]) * softplus_f(a + p.dt_bias[l * 8 + h]);
                        }
                    }
                }
            }
        } else {
            const int kind = tn < 16 ? 0 : tn < 24 ? 1 : tn < 48 ? 2 : tn < 56 ? 1 : 3;
            char* st = smem + opaque_zero();
#pragma unroll
            for (int m = 0; m < 4; ++m) {
                const int rl = wr * 64 + m * 16 + fr;
#pragma unroll
                for (int n = 0; n < 4; ++n) {
                    const int cl = wc * 64 + n * 16 + fq * 4;
                    float a[4];
#pragma unroll
                    for (int r = 0; r < 4; ++r) {
                        const float x = acc[m][n][r];
                        a[r] = kind == 0 ? gelu_f(x) : kind == 1 ? silu_f(x) : kind == 2 ? x : sigmoid_f(x);
                    }
                    *(uint2*)(st + rl * 272 + cl * 2) = make_uint2(pack2(a[0], a[1]), pack2(a[2], a[3]));
                }
            }
            __syncthreads();
#pragma unroll
            for (int i = 0; i < 8; ++i) {
                const int rl = (tid >> 4) + 16 * i, sg = tid & 15;
                const u32x4 v = *(const u32x4*)(st + rl * 272 + sg * 16);
                *(u32x4*)(P + (size_t)(tm * 128 + rl) * PC + tn * 128 + sg * 8) = v;
                if (tn >= 8 && tn < 16) {
                    const float a0 = lo_bf(v[0]), a1 = hi_bf(v[0]), a2 = lo_bf(v[1]), a3 = hi_bf(v[1]), a4 = lo_bf(v[2]), a5 = hi_bf(v[2]), a6 = lo_bf(v[3]), a7 = hi_bf(v[3]);
                    float sm = ((a0 + a1) + (a2 + a3)) + ((a4 + a5) + (a6 + a7));
                    float sq = ((a0 * a0 + a1 * a1) + (a2 * a2 + a3 * a3)) + ((a4 * a4 + a5 * a5) + (a6 * a6 + a7 * a7));
#pragma unroll
                    for (int o = 1; o < 16; o <<= 1) { sm += __shfl_xor(sm, o); sq += __shfl_xor(sq, o); }
                    if (sg == 0) {
                        float* stp = (float*)(p.ws + OFF_STATS) + (size_t)(tm * 128 + rl) * 2;
                        atomicAdd(stp, sm);
                        atomicAdd(stp + 1, sq);
                    }
                }
            }
        }
    }
}

constexpr int T2_A = 256 * 64, T2_B = 128 * 64, T2_STAGE = T2_A + T2_B;
__device__ __forceinline__ void gemm_core256(const bf16_t* __restrict__ A, const bf16_t* __restrict__ B, const int K,
                                             f32x4 (&acc)[8][4], char* smem, const int tid) {
    const int lane = tid & 63, wid = tid >> 6, wr = wid >> 1, wc = wid & 1, fr = lane & 15, fq = lane >> 4;
    const int srow = tid >> 2, sseg = (tid & 3) ^ ((tid >> 3) & 3);
    const bf16_t* ag = A + (size_t)srow * K + sseg * 8;
    const bf16_t* bg = B + (size_t)srow * K + sseg * 8;
    const int sw = (fq ^ ((fr >> 1) & 3)) << 4;
    const int aoff = (wr * 128 + fr) * 64 + sw;
    const int boff = T2_A + (wc * 64 + fr) * 64 + sw;
    const int nk = K >> 5;
#define STAGE2(BUF, KT) do { char* d_ = smem + (BUF) * T2_STAGE + tid * 16; \
        _Pragma("unroll") for (int i = 0; i < 4; ++i) __builtin_amdgcn_global_load_lds((const unsigned*)(ag + (size_t)(64 * i) * K + (KT) * 32), (__attribute__((address_space(3))) unsigned*)(d_ + i * 4096), 16, 0, 0); \
        _Pragma("unroll") for (int i = 0; i < 2; ++i) __builtin_amdgcn_global_load_lds((const unsigned*)(bg + (size_t)(64 * i) * K + (KT) * 32), (__attribute__((address_space(3))) unsigned*)(d_ + T2_A + i * 4096), 16, 0, 0); } while (0)
    __syncthreads();
    STAGE2(0, 0);
    STAGE2(1, 1);
    asm volatile("s_waitcnt vmcnt(6)" ::: "memory");
    __builtin_amdgcn_s_barrier();
    asm volatile("" ::: "memory");
    int cb = 0, nb = 2;
    for (int kt = 0; kt < nk; ++kt) {
        if (kt + 2 < nk) STAGE2(nb, kt + 2);
        const char* cur = smem + cb * T2_STAGE;
        bf16x8 bfr[4], af[8];
#pragma unroll
        for (int n = 0; n < 4; ++n) bfr[n] = *(const bf16x8*)(cur + boff + n * 16 * 64);
#pragma unroll
        for (int m = 0; m < 8; ++m) af[m] = *(const bf16x8*)(cur + aoff + m * 16 * 64);
        __builtin_amdgcn_sched_barrier(0);
#pragma unroll
        for (int m = 0; m < 8; ++m)
#pragma unroll
            for (int n = 0; n < 4; ++n) acc[m][n] = mfma16(bfr[n], af[m], acc[m][n]);
        if (kt + 2 < nk) asm volatile("s_waitcnt vmcnt(6)" ::: "memory");
        else asm volatile("s_waitcnt vmcnt(0)" ::: "memory");
        __builtin_amdgcn_s_barrier();
        asm volatile("" ::: "memory");
        cb = cb == 2 ? 0 : cb + 1;
        nb = nb == 2 ? 0 : nb + 1;
    }
#undef STAGE2
    __syncthreads();
}

__device__ __forceinline__ void phase_inproj256(const Params& p, int l, char* smem) {
    const bf16_t* H = (const bf16_t*)(p.ws + OFF_H);
    const bf16_t* Wt = (const bf16_t*)(p.ws + OFF_WT_IN) + (size_t)l * NPAD * 1024;
    bf16_t* P = (bf16_t*)(p.ws + OFF_P);
    float* BETA = (float*)(p.ws + OFF_BETA);
    float* GLOG = (float*)(p.ws + OFF_GLOG);
    constexpr int nM = T / 256, nN = NPAD / 128, ntiles = nM * nN;
    for (int L = blockIdx.x; L < ntiles; L += gridDim.x) {
        const int tid = opaque_tid();
        const int lane = tid & 63, wid = tid >> 6, wr = wid >> 1, wc = wid & 1, fr = lane & 15, fq = lane >> 4;
        int tm, tn;
        tile_map<4>(L, ntiles, nM, nN, tm, tn);
        f32x4 acc[8][4];
#pragma unroll
        for (int m = 0; m < 8; ++m)
#pragma unroll
            for (int n = 0; n < 4; ++n) acc[m][n] = (f32x4){0.f, 0.f, 0.f, 0.f};
        gemm_core256(H + (size_t)tm * 256 * 1024, Wt + (size_t)tn * 128 * 1024, 1024, acc, smem, tid);
        if (tn == 72) {
            if (wc == 0) {
#pragma unroll
                for (int m = 0; m < 8; ++m) {
                    const int row = tm * 256 + wr * 128 + m * 16 + fr;
#pragma unroll
                    for (int r = 0; r < 4; ++r) {
                        const float a = acc[m][0][r];
                        if (fq < 2) {
                            BETA[(size_t)row * 8 + fq * 4 + r] = sigmoid_f(a);
                        } else {
                            const int h = (fq - 2) * 4 + r;
                            GLOG[(size_t)row * 8 + h] = -__expf(p.a_log[l * 8 + h]) * softplus_f(a + p.dt_bias[l * 8 + h]);
                        }
                    }
                }
            }
        } else {
            const int kind = tn < 16 ? 0 : tn < 24 ? 1 : tn < 48 ? 2 : tn < 56 ? 1 : 3;
            char* st = smem + opaque_zero();
#pragma unroll
            for (int m = 0; m < 8; ++m) {
                const int rl = wr * 128 + m * 16 + fr;
#pragma unroll
                for (int n = 0; n < 4; ++n) {
                    const int cl = wc * 64 + n * 16 + fq * 4;
                    float a[4];
#pragma unroll
                    for (int r = 0; r < 4; ++r) {
                        const float x = acc[m][n][r];
                        a[r] = kind == 0 ? gelu_f(x) : kind == 1 ? silu_f(x) : kind == 2 ? x : sigmoid_f(x);
                    }
                    *(uint2*)(st + rl * 272 + cl * 2) = make_uint2(pack2(a[0], a[1]), pack2(a[2], a[3]));
                }
            }
            __syncthreads();
#pragma unroll 4
            for (int i = 0; i < 16; ++i) {
                const int rl = (tid >> 4) + 16 * i, sg = tid & 15;
                const u32x4 v = *(const u32x4*)(st + rl * 272 + sg * 16);
                *(u32x4*)(P + (size_t)(tm * 256 + rl) * PC + tn * 128 + sg * 8) = v;
                if (tn >= 8 && tn < 16) {
                    const float a0 = lo_bf(v[0]), a1 = hi_bf(v[0]), a2 = lo_bf(v[1]), a3 = hi_bf(v[1]), a4 = lo_bf(v[2]), a5 = hi_bf(v[2]), a6 = lo_bf(v[3]), a7 = hi_bf(v[3]);
                    float sm = ((a0 + a1) + (a2 + a3)) + ((a4 + a5) + (a6 + a7));
                    float sq = ((a0 * a0 + a1 * a1) + (a2 * a2 + a3 * a3)) + ((a4 * a4 + a5 * a5) + (a6 * a6 + a7 * a7));
#pragma unroll
                    for (int o = 1; o < 16; o <<= 1) { sm += __shfl_xor(sm, o); sq += __shfl_xor(sq, o); }
                    if (sg == 0) {
                        float* stp = (float*)(p.ws + OFF_STATS) + (size_t)(tm * 256 + rl) * 2;
                        atomicAdd(stp, sm);
                        atomicAdd(stp + 1, sq);
                    }
                }
            }
        }
    }
}

__device__ __forceinline__ void phase_merge(const Params& p, int l, char* smem) {
    const bf16_t* YA = (const bf16_t*)(p.ws + OFF_YA);
    const bf16_t* YB = (const bf16_t*)(p.ws + OFF_YB);
    const bf16_t* Wa = (const bf16_t*)(p.ws + OFF_WT_PA) + (size_t)l * 1024 * 1024;
    const bf16_t* Wb = (const bf16_t*)(p.ws + OFF_WT_PB) + (size_t)l * 1024 * 1024;
    const bf16_t* P = (const bf16_t*)(p.ws + OFF_P);
    bf16_t* MM = (bf16_t*)(p.ws + OFF_MM);
    constexpr int RT = 96, MT = 3;
    constexpr int nM = T / RT, nN = 8, ntiles = nM * nN;
    for (int L = blockIdx.x; L < ntiles; L += gridDim.x) {
        const int tid = opaque_tid();
        const int lane = tid & 63, wid = tid >> 6, wr = wid >> 1, wc = wid & 1, fr = lane & 15, fq = lane >> 4;
        int tm, tn;
        tile_map(L, ntiles, nM, nN, tm, tn);
        f32x4 acc[MT][4];
#pragma unroll
        for (int m = 0; m < MT; ++m)
#pragma unroll
            for (int n = 0; n < 4; ++n) acc[m][n] = (f32x4){0.f, 0.f, 0.f, 0.f};
        gemm_core<MT>(YA + (size_t)tm * RT * 1024, Wa + (size_t)tn * 128 * 1024, 1024, acc, smem, tid);
        uint2* park = (uint2*)(p.ws + OFF_PARK) + (size_t)blockIdx.x * 4096 + tid;
        uint2 gv[MT][4];
#pragma unroll
        for (int m = 0; m < MT; ++m)
#pragma unroll
            for (int n = 0; n < 4; ++n)
                gv[m][n] = *(const uint2*)(P + (size_t)(tm * RT + wr * 16 * MT + m * 16 + fr) * PC + C_GA + tn * 128 + wc * 64 + n * 16 + fq * 4);
        __builtin_amdgcn_sched_barrier(0);
#pragma unroll
        for (int m = 0; m < MT; ++m)
#pragma unroll
            for (int n = 0; n < 4; ++n) {
                const uint2 g = gv[m][n];
                park[(m * 4 + n) * 256] = make_uint2(pack2(acc[m][n][0] * lo_bf(g.x), acc[m][n][1] * hi_bf(g.x)),
                                                     pack2(acc[m][n][2] * lo_bf(g.y), acc[m][n][3] * hi_bf(g.y)));
                acc[m][n] = (f32x4){0.f, 0.f, 0.f, 0.f};
            }
        __builtin_amdgcn_sched_barrier(0);
        gemm_core<MT>(YB + (size_t)tm * RT * 1024, Wb + (size_t)tn * 128 * 1024, 1024, acc, smem, tid);
        char* st = smem + opaque_zero();
        uint2 pv[MT][4];
#pragma unroll
        for (int m = 0; m < MT; ++m)
#pragma unroll
            for (int n = 0; n < 4; ++n) {
                gv[m][n] = *(const uint2*)(P + (size_t)(tm * RT + wr * 16 * MT + m * 16 + fr) * PC + C_GB + tn * 128 + wc * 64 + n * 16 + fq * 4);
                pv[m][n] = park[(m * 4 + n) * 256];
            }
        __builtin_amdgcn_sched_barrier(0);
#pragma unroll
        for (int m = 0; m < MT; ++m) {
            const int rl = wr * 16 * MT + m * 16 + fr;
#pragma unroll
            for (int n = 0; n < 4; ++n) {
                const int cl = wc * 64 + n * 16 + fq * 4;
                const uint2 g = gv[m][n];
                const uint2 pm = pv[m][n];
                const float a0 = lo_bf(pm.x) + acc[m][n][0] * lo_bf(g.x);
                const float a1 = hi_bf(pm.x) + acc[m][n][1] * hi_bf(g.x);
                const float a2 = lo_bf(pm.y) + acc[m][n][2] * lo_bf(g.y);
                const float a3 = hi_bf(pm.y) + acc[m][n][3] * hi_bf(g.y);
                *(uint2*)(st + rl * 272 + cl * 2) = make_uint2(pack2(a0, a1), pack2(a2, a3));
            }
            __builtin_amdgcn_sched_barrier(0);
        }
        __syncthreads();
#pragma unroll
        for (int i = 0; i < RT / 16; ++i) {
            const int rl = (tid >> 4) + 16 * i, sg = tid & 15;
            const u32x4 v = *(const u32x4*)(st + rl * 272 + sg * 16);
            *(u32x4*)(MM + (size_t)(tm * RT + rl) * 1024 + tn * 128 + sg * 8) = v;
        }
    }
}

__device__ __forceinline__ void phase_outproj(const Params& p, int l, char* smem) {
    const bf16_t* MM = (const bf16_t*)(p.ws + OFF_MM);
    const bf16_t* Wo = (const bf16_t*)(p.ws + OFF_WT_O) + (size_t)l * 1024 * 1024;
    const float* X = (const float*)(p.ws + OFF_X);
    float* TT = (float*)(p.ws + OFF_TT);
    const float* mod = (const float*)(p.ws + OFF_MOD);
    constexpr int RT = 96, MT = 3;
    constexpr int nM = T / RT, nN = 8, ntiles = nM * nN;
    for (int L = blockIdx.x; L < ntiles; L += gridDim.x) {
        const int tid = opaque_tid();
        const int lane = tid & 63, wid = tid >> 6, wr = wid >> 1, wc = wid & 1, fr = lane & 15, fq = lane >> 4;
        int tm, tn;
        tile_map(L, ntiles, nM, nN, tm, tn);
        f32x4 acc[MT][4];
#pragma unroll
        for (int m = 0; m < MT; ++m)
#pragma unroll
            for (int n = 0; n < 4; ++n) acc[m][n] = (f32x4){0.f, 0.f, 0.f, 0.f};
        gemm_core<MT>(MM + (size_t)tm * RT * 1024, Wo + (size_t)tn * 128 * 1024, 1024, acc, smem, tid);
        float* st = (float*)(smem + opaque_zero());
#pragma unroll
        for (int m = 0; m < MT; ++m)
#pragma unroll
            for (int n = 0; n < 4; ++n) *(f32x4*)(st + (wr * 16 * MT + m * 16 + fr) * 132 + wc * 64 + n * 16 + fq * 4) = acc[m][n];
        __syncthreads();
#pragma unroll
        for (int hb = 0; hb < 2; ++hb) {
            float4 xv[6], gv[6];
#pragma unroll
            for (int i = 0; i < 6; ++i) {
                const int rl = (tid >> 5) + 8 * (hb * 6 + i), c4 = (tid & 31) * 4;
                const int row = tm * RT + rl, col = tn * 128 + c4;
                xv[i] = *(const float4*)(X + (size_t)row * 1024 + col);
                gv[i] = *(const float4*)(mod + ((size_t)l * NROWB + cond_row(row)) * 3072 + 2048 + col);
            }
            __builtin_amdgcn_sched_barrier(0);
#pragma unroll
            for (int i = 0; i < 6; ++i) {
                const int rl = (tid >> 5) + 8 * (hb * 6 + i), c4 = (tid & 31) * 4;
                const int row = tm * RT + rl, col = tn * 128 + c4;
                const f32x4 a = *(const f32x4*)(st + rl * 132 + c4);
                const float4 x = xv[i], g = gv[i];
                *(float4*)(TT + (size_t)row * 1024 + col) = make_float4(ALPHA_DN * x.x + g.x * a[0], ALPHA_DN * x.y + g.y * a[1],
                                                                        ALPHA_DN * x.z + g.z * a[2], ALPHA_DN * x.w + g.w * a[3]);
            }
            __builtin_amdgcn_sched_barrier(0);
        }
    }
}

__device__ __forceinline__ void gmlp_prompt_item(const Params& p, int l, int it, char* smem) {
    smem += opaque_zero();
    const int tid = opaque_tid(), lane = tid & 63, wid = tid >> 6, wr = wid >> 1, wc = wid & 1, fr = lane & 15, fq = lane >> 4;
    const int h = it & 7, n = (it >> 3) & 15, b = it >> 7;
    const int tok0 = b * SEQ + n * 128;
    const bf16_t* P = (const bf16_t*)(p.ws + OFF_P);
    bf16_t* YA = (bf16_t*)(p.ws + OFF_YA);
    bf16_t* Wt = (bf16_t*)smem;
    bf16_t* VnT = Wt + 128 * 136;
    float* mu = (float*)(smem + 2 * 34816);
    float* rs = mu + 128;
    __syncthreads();
    {
        const int t = tid >> 1, half = tid & 1;
        const float* wsrc = p.w_s + ((size_t)(l * 8 + h) * 128 + t) * 128 + half * 64;
#pragma unroll
        for (int i = 0; i < 8; ++i) {
            const float4 w0 = *(const float4*)(wsrc + i * 8);
            const float4 w1 = *(const float4*)(wsrc + i * 8 + 4);
            const int s0 = half * 64 + i * 8;
            const float e0 = s0 + 0 <= t ? w0.x : 0.f, e1 = s0 + 1 <= t ? w0.y : 0.f, e2 = s0 + 2 <= t ? w0.z : 0.f, e3 = s0 + 3 <= t ? w0.w : 0.f;
            const float e4 = s0 + 4 <= t ? w1.x : 0.f, e5 = s0 + 5 <= t ? w1.y : 0.f, e6 = s0 + 6 <= t ? w1.z : 0.f, e7 = s0 + 7 <= t ? w1.w : 0.f;
            *(uint4*)(Wt + t * 136 + s0) = make_uint4(pack2(e0, e1), pack2(e2, e3), pack2(e4, e5), pack2(e6, e7));
        }
        if (half == 0) {
            const float2 sv = *(const float2*)((const float*)(p.ws + OFF_STATS) + (size_t)(tok0 + t) * 2);
            const float mean = sv.x * (1.f / 1024.f);
            const float var = fmaxf(sv.y * (1.f / 1024.f) - mean * mean, 0.f);
            mu[t] = mean;
            rs[t] = rsqrtf(var + LN_EPS);
        }
    }
    __syncthreads();
    {
        const int c = tid & 127, sg = tid >> 7;
        const float gam = p.lnv_g[l * 1024 + h * 128 + c], bet = p.lnv_b[l * 1024 + h * 128 + c];
        const bf16_t* src = P + (size_t)tok0 * PC + C_VA + h * 128 + c;
        float* cv = p.out + O_CV_P + ((size_t)(l * NB + b) * 128) * 1024 + h * 128 + c;
        bf16_t rw[64];
#pragma unroll
        for (int q = 0; q < 64; ++q) rw[q] = src[(size_t)(sg * 64 + q) * PC];
        __builtin_amdgcn_sched_barrier(0);
#pragma unroll
        for (int oct = 0; oct < 8; ++oct) {
            const int s0 = sg * 64 + oct * 8;
            float e[8];
#pragma unroll
            for (int j = 0; j < 8; ++j) {
                const float x = bf2f(rw[oct * 8 + j]);
                e[j] = (x - mu[s0 + j]) * rs[s0 + j] * gam + bet;
            }
            if (n == 15) {
#pragma unroll
                for (int j = 0; j < 8; ++j) cv[(size_t)(s0 + j) * 1024] = e[j];
            }
            *(uint4*)(VnT + c * 136 + s0) = make_uint4(pack2(e[0], e[1]), pack2(e[2], e[3]), pack2(e[4], e[5]), pack2(e[6], e[7]));
        }
    }
    __syncthreads();
    f32x4 acc[4][4];
#pragma unroll
    for (int m = 0; m < 4; ++m)
#pragma unroll
        for (int nn = 0; nn < 4; ++nn) acc[m][nn] = (f32x4){0.f, 0.f, 0.f, 0.f};
#pragma unroll
    for (int ks = 0; ks < 4; ++ks) {
        bf16x8 af[4], bfr[4];
#pragma unroll
        for (int m = 0; m < 4; ++m) af[m] = *(const bf16x8*)(Wt + (wr * 64 + m * 16 + fr) * 136 + ks * 32 + fq * 8);
#pragma unroll
        for (int nn = 0; nn < 4; ++nn) bfr[nn] = *(const bf16x8*)(VnT + (wc * 64 + nn * 16 + fr) * 136 + ks * 32 + fq * 8);
#pragma unroll
        for (int m = 0; m < 4; ++m)
#pragma unroll
            for (int nn = 0; nn < 4; ++nn) acc[m][nn] = mfma16(bfr[nn], af[m], acc[m][nn]);
    }
#pragma unroll
    for (int m = 0; m < 4; ++m) {
        const int t = wr * 64 + m * 16 + fr;
        const float bs = p.b_s[(l * 8 + h) * 128 + t];
        const bf16_t* prow = P + (size_t)(tok0 + t) * PC + h * 128;
#pragma unroll
        for (int nn = 0; nn < 4; ++nn) {
            const int c = wc * 64 + nn * 16 + fq * 4;
            const uint2 u = *(const uint2*)(prow + C_UA + c);
            const uint2 z = *(const uint2*)(prow + C_ZA + c);
            const float y0 = lo_bf(u.x) * (acc[m][nn][0] + bs) * lo_bf(z.x);
            const float y1 = hi_bf(u.x) * (acc[m][nn][1] + bs) * hi_bf(z.x);
            const float y2 = lo_bf(u.y) * (acc[m][nn][2] + bs) * lo_bf(z.y);
            const float y3 = hi_bf(u.y) * (acc[m][nn][3] + bs) * hi_bf(z.y);
            *(uint2*)(YA + (size_t)(tok0 + t) * 1024 + h * 128 + c) = make_uint2(pack2(y0, y1), pack2(y2, y3));
        }
    }
}

__device__ __forceinline__ void gmlp_sample_item(const Params& p, int l, int b, char* smem) {
    smem += opaque_zero();
    const int tid = opaque_tid(), lane = tid & 63, wid = tid >> 6;
    const int tok0 = TP + b * DSQ;
    const bf16_t* P = (const bf16_t*)(p.ws + OFF_P);
    bf16_t* YA = (bf16_t*)(p.ws + OFF_YA);
    float* red = (float*)smem;
    __syncthreads();
    const int c4 = tid * 4;
    float x[4][4];
    float s[4], ss[4];
#pragma unroll
    for (int t = 0; t < 4; ++t) {
        const uint2 u = *(const uint2*)(P + (size_t)(tok0 + t) * PC + C_VA + c4);
        x[t][0] = lo_bf(u.x); x[t][1] = hi_bf(u.x); x[t][2] = lo_bf(u.y); x[t][3] = hi_bf(u.y);
        s[t] = wave_sum(x[t][0] + x[t][1] + x[t][2] + x[t][3]);
        ss[t] = wave_sum(x[t][0] * x[t][0] + x[t][1] * x[t][1] + x[t][2] * x[t][2] + x[t][3] * x[t][3]);
    }
    if (lane == 0) {
#pragma unroll
        for (int t = 0; t < 4; ++t) { red[wid * 8 + t] = s[t]; red[wid * 8 + 4 + t] = ss[t]; }
    }
    __syncthreads();
    const float4 gam = *(const float4*)(p.lnv_g + l * 1024 + c4);
    const float4 bet = *(const float4*)(p.lnv_b + l * 1024 + c4);
    float vn[4][4];
#pragma unroll
    for (int t = 0; t < 4; ++t) {
        const float st = red[t] + red[8 + t] + red[16 + t] + red[24 + t];
        const float sst = red[4 + t] + red[12 + t] + red[20 + t] + red[28 + t];
        const float mean = st * (1.f / 1024.f);
        const float rstd = rsqrtf(fmaxf(sst * (1.f / 1024.f) - mean * mean, 0.f) + LN_EPS);
        vn[t][0] = (x[t][0] - mean) * rstd * gam.x + bet.x;
        vn[t][1] = (x[t][1] - mean) * rstd * gam.y + bet.y;
        vn[t][2] = (x[t][2] - mean) * rstd * gam.z + bet.z;
        vn[t][3] = (x[t][3] - mean) * rstd * gam.w + bet.w;
        *(float4*)(p.out + O_CV_S + ((size_t)(l * DBT + b) * DSQ + t) * 1024 + c4) = make_float4(vn[t][0], vn[t][1], vn[t][2], vn[t][3]);
    }
    const int h = c4 >> 7;
#pragma unroll
    for (int t = 0; t < 4; ++t) {
        const float bs = p.b_s[(l * 8 + h) * 128 + t];
        float a[4] = {bs, bs, bs, bs};
#pragma unroll
        for (int sidx = 0; sidx <= t; ++sidx) {
            const float w = p.w_s[((size_t)(l * 8 + h) * 128 + t) * 128 + sidx];
#pragma unroll
            for (int e = 0; e < 4; ++e) a[e] += w * vn[sidx][e];
        }
        const uint2 u = *(const uint2*)(P + (size_t)(tok0 + t) * PC + C_UA + c4);
        const uint2 z = *(const uint2*)(P + (size_t)(tok0 + t) * PC + C_ZA + c4);
        const float y0 = lo_bf(u.x) * a[0] * lo_bf(z.x), y1 = hi_bf(u.x) * a[1] * hi_bf(z.x);
        const float y2 = lo_bf(u.y) * a[2] * lo_bf(z.y), y3 = hi_bf(u.y) * a[3] * hi_bf(z.y);
        *(uint2*)(YA + (size_t)(tok0 + t) * 1024 + c4) = make_uint2(pack2(y0, y1), pack2(y2, y3));
    }
}

__device__ __forceinline__ void conv_state_item(const Params& p, int l, int it) {
    const bf16_t* P = (const bf16_t*)(p.ws + OFF_P);
    const bool pr = it < NB;
    const int b = pr ? it : it - NB;
    const int tokb = pr ? b * SEQ + SEQ - 3 : TP + b * DSQ + 1;
    float* dst = pr ? p.out + O_CONV_P + (size_t)(l * NB + b) * 3 * 3072 : p.out + O_CONV_S + (size_t)(l * DBT + b) * 3 * 3072;
    for (int idx = opaque_tid(); idx < 3 * 768; idx += 256) {
        const int j = idx / 768, c = (idx % 768) * 4;
        const uint2 u = *(const uint2*)(P + (size_t)(tokb + j) * PC + C_Q + c);
        *(float4*)(dst + j * 3072 + c) = make_float4(lo_bf(u.x), hi_bf(u.x), lo_bf(u.y), hi_bf(u.y));
    }
}

__device__ __forceinline__ void gdn_sample_item(const Params& p, int l, int it, char* smem) {
    smem += opaque_zero();
    const int tid = opaque_tid(), lane = tid & 63, wid = tid >> 6;
    const int b = it >> 3, h = it & 7;
    const int tok0 = TP + b * DSQ;
    const bf16_t* P = (const bf16_t*)(p.ws + OFF_P);
    const float* BETA = (const float*)(p.ws + OFF_BETA);
    const float* GLOG = (const float*)(p.ws + OFF_GLOG);
    bf16_t* YB = (bf16_t*)(p.ws + OFF_YB);
    float* qs = (float*)smem;
    float* ks = qs + 512;
    float* vs = ks + 512;
    float* red = vs + 512;
    float* part = red + 16;
    float* opart = part + 1024;
    float* red2 = opart + 1024;
    __syncthreads();
    const int j = tid & 127;
    const bool isk = tid >= 128;
    float y1[4], y2[4];
    {
        const int cq = (isk ? 1024 : 0) + h * 128 + j;
        const float* sc = p.state_conv + (size_t)(l * DBT + b) * 3 * 3072;
        const float* cw = p.conv_w + (size_t)l * 4 * 3072;
        float xr[7];
#pragma unroll
        for (int r = 0; r < 3; ++r) xr[r] = sc[r * 3072 + cq];
#pragma unroll
        for (int t = 0; t < 4; ++t) xr[3 + t] = bf2f(P[(size_t)(tok0 + t) * PC + C_Q + cq]);
        const float w0 = cw[cq], w1 = cw[3072 + cq], w2 = cw[2 * 3072 + cq], w3 = cw[3 * 3072 + cq];
#pragma unroll
        for (int t = 0; t < 4; ++t) y1[t] = silu_f(w0 * xr[t] + w1 * xr[t + 1] + w2 * xr[t + 2] + w3 * xr[t + 3]);
        if (!isk) {
            const int cv = 2048 + h * 128 + j;
#pragma unroll
            for (int r = 0; r < 3; ++r) xr[r] = sc[r * 3072 + cv];
#pragma unroll
            for (int t = 0; t < 4; ++t) xr[3 + t] = bf2f(P[(size_t)(tok0 + t) * PC + C_Q + cv]);
            const float v0 = cw[cv], v1 = cw[3072 + cv], v2 = cw[2 * 3072 + cv], v3 = cw[3 * 3072 + cv];
#pragma unroll
            for (int t = 0; t < 4; ++t) y2[t] = silu_f(v0 * xr[t] + v1 * xr[t + 1] + v2 * xr[t + 2] + v3 * xr[t + 3]);
        }
    }
#pragma unroll
    for (int t = 0; t < 4; ++t) {
        const float s = wave_sum(y1[t] * y1[t]);
        if (lane == 0) red[wid * 4 + t] = s;
    }
    __syncthreads();
#pragma unroll
    for (int t = 0; t < 4; ++t) {
        const float tot = isk ? red[8 + t] + red[12 + t] : red[t] + red[4 + t];
        const float rn = rsqrtf(tot + NORM_EPS);
        if (isk) ks[t * 128 + j] = y1[t] * rn;
        else { qs[t * 128 + j] = y1[t] * rn * 0.08838834764831845f; vs[t * 128 + j] = y2[t]; }
    }
    __syncthreads();
    const int vcol = j, kh = tid >> 7;
    float S[64];
    const float* s0 = p.state_ssm + ((size_t)(l * DBT + b) * 8 + h) * 16384 + (size_t)(kh * 64) * 128 + vcol;
#pragma unroll
    for (int kk = 0; kk < 64; ++kk) S[kk] = s0[kk * 128];
#pragma unroll
    for (int t = 0; t < 4; ++t) {
        const float a = __expf(GLOG[(size_t)(tok0 + t) * 8 + h]);
        const float bt = BETA[(size_t)(tok0 + t) * 8 + h];
        float r0 = 0.f, r1 = 0.f;
#pragma unroll
        for (int kk = 0; kk < 64; kk += 4) {
            const float4 kv = *(const float4*)&ks[t * 128 + kh * 64 + kk];
            r0 += S[kk] * kv.x + S[kk + 2] * kv.z;
            r1 += S[kk + 1] * kv.y + S[kk + 3] * kv.w;
        }
        part[(t * 2 + kh) * 128 + vcol] = r0 + r1;
        __syncthreads();
        const float dlt = bt * (vs[t * 128 + vcol] - a * (part[(t * 2) * 128 + vcol] + part[(t * 2 + 1) * 128 + vcol]));
        float o0 = 0.f, o1 = 0.f;
#pragma unroll
        for (int kk = 0; kk < 64; kk += 4) {
            const float4 kv = *(const float4*)&ks[t * 128 + kh * 64 + kk];
            const float4 qv = *(const float4*)&qs[t * 128 + kh * 64 + kk];
            S[kk] = a * S[kk] + kv.x * dlt;
            S[kk + 1] = a * S[kk + 1] + kv.y * dlt;
            S[kk + 2] = a * S[kk + 2] + kv.z * dlt;
            S[kk + 3] = a * S[kk + 3] + kv.w * dlt;
            o0 += S[kk] * qv.x + S[kk + 2] * qv.z;
            o1 += S[kk + 1] * qv.y + S[kk + 3] * qv.w;
        }
        opart[(t * 2 + kh) * 128 + vcol] = o0 + o1;
    }
    float* sout = p.out + O_SSM_S + ((size_t)(l * DBT + b) * 8 + h) * 16384 + (size_t)(kh * 64) * 128 + vcol;
#pragma unroll
    for (int kk = 0; kk < 64; ++kk) sout[kk * 128] = S[kk];
    __syncthreads();
    float o[4];
    if (tid < 128) {
#pragma unroll
        for (int t = 0; t < 4; ++t) {
            o[t] = opart[(t * 2) * 128 + vcol] + opart[(t * 2 + 1) * 128 + vcol];
            const float s = wave_sum(o[t] * o[t]);
            if (lane == 0) red2[wid * 4 + t] = s;
        }
    }
    __syncthreads();
    if (tid < 128) {
        const float gn = p.onorm_g[l * 128 + vcol];
#pragma unroll
        for (int t = 0; t < 4; ++t) {
            const float rinv = rsqrtf((red2[t] + red2[4 + t]) * (1.f / 128.f) + NORM_EPS);
            const float zs = bf2f(P[(size_t)(tok0 + t) * PC + C_ZB + h * 128 + vcol]);
            YB[(size_t)(tok0 + t) * 1024 + h * 128 + vcol] = f2bf(o[t] * rinv * gn * zs);
        }
    }
}

__device__ __forceinline__ void gdn_prep_item(const Params& p, int l, int it, char* smem) {
    smem += opaque_zero();
    const int tid = opaque_tid(), lane = tid & 63, wid = tid >> 6, fr = lane & 15, fq = lane >> 4;
    const int n = it & 31, h = (it >> 5) & 7, b = it >> 8;
    const int tok0 = b * SEQ + n * 64;
    const bf16_t* P = (const bf16_t*)(p.ws + OFF_P);
    const float* BETA = (const float*)(p.ws + OFF_BETA);
    const float* GLOG = (const float*)(p.ws + OFF_GLOG);
    float* Ug = (float*)(p.ws + OFF_U) + (size_t)it * 8192;
    bf16_t* Wg = (bf16_t*)(p.ws + OFF_WG) + (size_t)it * 8192;
    bf16_t* QGg = (bf16_t*)(p.ws + OFF_QG) + (size_t)it * 8192;
    bf16_t* KDTg = (bf16_t*)(p.ws + OFF_KDT) + (size_t)it * 8192;
    bf16_t* QKg = (bf16_t*)(p.ws + OFF_QK) + (size_t)it * 4096;
    float* EGg = (float*)(p.ws + OFF_EG);
    bf16_t* Qs = (bf16_t*)smem;
    bf16_t* Ks = Qs + 64 * 136;
    bf16_t* Kbs = Ks + 64 * 136;
    float* Am = (float*)(smem + 3 * 17408);
    float* gcs = Am + 64 * 68;
    float* betas = gcs + 64;
    float* red = betas + 64;
    __syncthreads();
    const int j = tid & 127;
    const bool isk = tid >= 128;
    float val[64];
    char* R1 = smem + 2 * 17408;
    char* R2 = smem + 3 * 17408;
    {
        const bf16_t* pb = P + ((ptrdiff_t)tok0 - 3) * PC + C_Q + h * 128;
        u32x4 tv[9];
#pragma unroll
        for (int it9 = 0; it9 < 9; ++it9) {
            const int c = tid + 256 * it9;
            const int cc = c < 67 * 32 ? c : 67 * 32 - 1;
            const int r = cc >> 5, sg = cc & 31;
            const bool ok = n > 0 || r >= 3;
            const u32x4 v = *(const u32x4*)(pb + (ptrdiff_t)(ok ? r : 3) * PC + (sg >> 4) * 1024 + (sg & 15) * 8);
            tv[it9] = ok ? v : (u32x4){0u, 0u, 0u, 0u};
        }
        __builtin_amdgcn_sched_barrier(0);
        if (tid < 64) {
            float g = GLOG[(size_t)(tok0 + tid) * 8 + h];
    #pragma unroll
            for (int o = 1; o < 64; o <<= 1) {
                const float t = __shfl_up(g, o);
                if (lane >= o) g += t;
            }
            gcs[tid] = g;
            betas[tid] = BETA[(size_t)(tok0 + tid) * 8 + h];
        }
        __builtin_amdgcn_sched_barrier(0);
#pragma unroll
        for (int it9 = 0; it9 < 9; ++it9) {
            const int c = tid + 256 * it9;
            if (c < 67 * 32) *(u32x4*)(R1 + (c >> 5) * 512 + (c & 31) * 16) = tv[it9];
        }
    }
    __syncthreads();
    {
        const int cq = (isk ? 1024 : 0) + h * 128 + j;
        const float* cw = p.conv_w + (size_t)l * 4 * 3072;
        const float w0 = cw[cq], w1 = cw[3072 + cq], w2 = cw[2 * 3072 + cq], w3 = cw[3 * 3072 + cq];
        const bf16_t* col = (const bf16_t*)(R1 + (isk ? 256 : 0)) + j;
        float x3 = bf2f(col[0]), x2 = bf2f(col[256]), x1 = bf2f(col[512]);
#pragma unroll
        for (int i = 0; i < 64; ++i) {
            const float x0 = bf2f(col[(i + 3) * 256]);
            val[i] = silu_f(w0 * x3 + w1 * x2 + w2 * x1 + w3 * x0);
            x3 = x2; x2 = x1; x1 = x0;
            if ((i & 15) == 15) __builtin_amdgcn_sched_barrier(0);
        }
    }
#pragma unroll
    for (int i = 0; i < 64; ++i) {
        const float s = wave_sum(val[i] * val[i]);
        if (lane == 0) red[wid * 64 + i] = s;
        if ((i & 7) == 7) __builtin_amdgcn_sched_barrier(0);
    }
    __syncthreads();
    const float glast = gcs[63];
    {
        const bf16_t* pb = P + ((ptrdiff_t)tok0 - 3) * PC + C_Q + 2048 + h * 128;
        u32x4 tv[5];
#pragma unroll
        for (int it5 = 0; it5 < 5; ++it5) {
            const int c = tid + 256 * it5;
            const int cc = c < 67 * 16 ? c : 67 * 16 - 1;
            const int r = cc >> 4, sg = cc & 15;
            const bool ok = n > 0 || r >= 3;
            const u32x4 v = *(const u32x4*)(pb + (ptrdiff_t)(ok ? r : 3) * PC + sg * 8);
            tv[it5] = ok ? v : (u32x4){0u, 0u, 0u, 0u};
        }
        __builtin_amdgcn_sched_barrier(0);
#pragma unroll
        for (int it5 = 0; it5 < 5; ++it5) {
            const int c = tid + 256 * it5;
            if (c < 67 * 16) *(u32x4*)(R2 + (c >> 4) * 256 + (c & 15) * 16) = tv[it5];
        }
    }
    if (!isk) {
#pragma unroll
        for (int i = 0; i < 64; ++i) {
            const float rn = rsqrtf(red[i] + red[64 + i] + NORM_EPS);
            const float qv = val[i] * rn * 0.08838834764831845f;
            Qs[i * 136 + j] = f2bf(qv);
            QGg[i * 128 + perm32(j)] = f2bf(qv * __expf(gcs[i]));
            if ((i & 7) == 7) __builtin_amdgcn_sched_barrier(0);
        }
    } else {
        unsigned pk[32];
#pragma unroll
        for (int i = 0; i < 64; ++i) {
            const float rn = rsqrtf(red[128 + i] + red[192 + i] + NORM_EPS);
            const float kv = val[i] * rn;
            const float gi = gcs[i], bi = betas[i];
            Ks[i * 136 + j] = f2bf(kv);
            Kbs[i * 136 + j] = f2bf(kv * bi);
            const bf16_t kd = f2bf(kv * __expf(glast - gi));
            if (i & 1) pk[perm32(i) >> 1] |= ((unsigned)kd) << 16; else pk[perm32(i) >> 1] = kd;
            val[i] = kv * bi * __expf(gi);
            if ((i & 7) == 7) __builtin_amdgcn_sched_barrier(0);
        }
#pragma unroll
        for (int i = 0; i < 8; ++i) *(uint4*)(KDTg + j * 64 + i * 8) = make_uint4(pk[i * 4], pk[i * 4 + 1], pk[i * 4 + 2], pk[i * 4 + 3]);
    }
    __syncthreads();
    if (!isk) {
        const int cv = 2048 + h * 128 + j;
        const float* cw = p.conv_w + (size_t)l * 4 * 3072;
        const float w0 = cw[cv], w1 = cw[3072 + cv], w2 = cw[2 * 3072 + cv], w3 = cw[3 * 3072 + cv];
        const bf16_t* col = (const bf16_t*)R2 + j;
        float x3 = bf2f(col[0]), x2 = bf2f(col[128]), x1 = bf2f(col[256]);
#pragma unroll
        for (int i = 0; i < 64; ++i) {
            const float x0 = bf2f(col[(i + 3) * 128]);
            val[i] = silu_f(w0 * x3 + w1 * x2 + w2 * x1 + w3 * x0) * betas[i];
            x3 = x2; x2 = x1; x1 = x0;
            if ((i & 15) == 15) __builtin_amdgcn_sched_barrier(0);
        }
    }
    __syncthreads();
    {
        f32x4 aA[4], aQ[4];
#pragma unroll
        for (int nt = 0; nt < 4; ++nt) { aA[nt] = (f32x4){0.f, 0.f, 0.f, 0.f}; aQ[nt] = (f32x4){0.f, 0.f, 0.f, 0.f}; }
#pragma unroll
        for (int ksi = 0; ksi < 4; ++ksi) {
            const bf16x8 fa = *(const bf16x8*)(Kbs + (wid * 16 + fr) * 136 + ksi * 32 + fq * 8);
            const bf16x8 fqv = *(const bf16x8*)(Qs + (wid * 16 + fr) * 136 + ksi * 32 + fq * 8);
#pragma unroll
            for (int nt = 0; nt < 4; ++nt) {
                const bf16x8 fb = *(const bf16x8*)(Ks + (nt * 16 + fr) * 136 + ksi * 32 + fq * 8);
                aA[nt] = mfma16(fa, fb, aA[nt]);
                aQ[nt] = mfma16(fqv, fb, aQ[nt]);
            }
        }
#pragma unroll
        for (int nt = 0; nt < 4; ++nt) {
            const int jc = nt * 16 + fr;
            const float gj = gcs[jc];
#pragma unroll
            for (int r = 0; r < 4; ++r) {
                const int i = wid * 16 + fq * 4 + r;
                const float dec = jc <= i ? __expf(gcs[i] - gj) : 0.f;
                Am[i * 68 + jc] = jc < i ? aA[nt][r] * dec : 0.f;
                QKg[i * 64 + perm32(jc)] = f2bf(aQ[nt][r] * dec);
            }
        }
    }
    __syncthreads();
#pragma unroll
    for (int i = 1; i < 64; ++i) {
        float s0 = 0.f, s1 = 0.f, s2 = 0.f, s3 = 0.f;
#pragma unroll
        for (int j4 = 0; j4 < (i + 3) / 4; ++j4) {
            const float4 a = *(const float4*)&Am[i * 68 + j4 * 4];
            s0 += a.x * val[j4 * 4];
            s1 += a.y * val[j4 * 4 + 1];
            s2 += a.z * val[j4 * 4 + 2];
            s3 += a.w * val[j4 * 4 + 3];
        }
        val[i] -= (s0 + s1) + (s2 + s3);
        if ((i & 3) == 3) __builtin_amdgcn_sched_barrier(0);
    }
    if (!isk) {
#pragma unroll
        for (int i = 0; i < 64; i += 4)
            *(float4*)(Ug + (((i >> 4) * 8 + (j >> 4)) * 64 + ((i >> 2) & 3) * 16 + (j & 15)) * 4) = make_float4(val[i], val[i + 1], val[i + 2], val[i + 3]);
    } else {
        const int pj = perm32(j);
#pragma unroll
        for (int i = 0; i < 64; ++i) Wg[i * 128 + pj] = f2bf(val[i]);
    }
    if (tid == 0) EGg[it] = __expf(glast);
}

__device__ __forceinline__ void gdn_scan_item(const Params& p, int l, int bh, char* smem) {
    smem += opaque_zero();
    const int tid0 = opaque_tid();
    const int b = bh >> 3, h = bh & 7;
    constexpr int WBY = 64 * 272, BUFB = WBY + 128 * 128;
    const float* EGg = (const float*)(p.ws + OFF_EG);
    f32x4 S[8][2];
#pragma unroll
    for (int mt = 0; mt < 8; ++mt) { S[mt][0] = (f32x4){0.f, 0.f, 0.f, 0.f}; S[mt][1] = (f32x4){0.f, 0.f, 0.f, 0.f}; }
    u32x4 stg[8];
    f32x4 ucur[4][2];
    {
        const size_t item = (size_t)bh * 32;
        const bf16_t* Wp = (const bf16_t*)(p.ws + OFF_WG) + item * 8192;
        const bf16_t* KDTp = (const bf16_t*)(p.ws + OFF_KDT) + item * 8192;
        const float* Up = (const float*)(p.ws + OFF_U) + item * 8192;
        const int lane = tid0 & 63, w = tid0 >> 6, fr = lane & 15, fq = lane >> 4;
#pragma unroll
        for (int i = 0; i < 4; ++i) {
            stg[i] = ldg_b<u32x4>(Wp, 16u * (unsigned)(tid0 + 256 * i));
            stg[4 + i] = ldg_b<u32x4>(KDTp, 16u * (unsigned)(tid0 + 256 * i));
        }
#pragma unroll
        for (int mt = 0; mt < 4; ++mt)
#pragma unroll
            for (int nt = 0; nt < 2; ++nt) ucur[mt][nt] = ldg_b<f32x4>(Up, 16u * (unsigned)((mt * 8 + w * 2 + nt) * 64 + lane));
        __syncthreads();
#pragma unroll
        for (int i = 0; i < 4; ++i) {
            const int c = tid0 + 256 * i;
            *(u32x4*)(smem + (c >> 4) * 272 + (c & 15) * 16) = stg[i];
            *(u32x4*)(smem + WBY + (c >> 3) * 128 + ((((c & 7) ^ ((c >> 3) & 7))) << 4)) = stg[4 + i];
        }
        __syncthreads();
    }
    for (int n = 0; n < 32; ++n) {
        int tid = tid0;
        asm volatile("" : "+v"(tid));
        const int lane = tid & 63, w = tid >> 6, fr = lane & 15, fq = lane >> 4;
        const char* cur = smem + (n & 1) * BUFB;
        const size_t item = (size_t)bh * 32 + n;
        const float eg = EGg[item];
        bf16_t* SBp = (bf16_t*)(p.ws + OFF_SB) + item * 16384;
        bf16_t* VNp = (bf16_t*)(p.ws + OFF_VN) + item * 8192;
        if (n + 1 < 32) {
            const bf16_t* Wp = (const bf16_t*)(p.ws + OFF_WG) + (item + 1) * 8192;
            const bf16_t* KDTp = (const bf16_t*)(p.ws + OFF_KDT) + (item + 1) * 8192;
#pragma unroll
            for (int i = 0; i < 4; ++i) {
                stg[i] = ldg_b<u32x4>(Wp, 16u * (unsigned)(tid + 256 * i));
                stg[4 + i] = ldg_b<u32x4>(KDTp, 16u * (unsigned)(tid + 256 * i));
            }
        }
        bf16x8 sf[4][2];
#pragma unroll
        for (int pp = 0; pp < 4; ++pp)
#pragma unroll
            for (int nt = 0; nt < 2; ++nt) {
                u32x4 t;
                t[0] = pack2(S[2 * pp][nt][0], S[2 * pp][nt][1]);
                t[1] = pack2(S[2 * pp][nt][2], S[2 * pp][nt][3]);
                t[2] = pack2(S[2 * pp + 1][nt][0], S[2 * pp + 1][nt][1]);
                t[3] = pack2(S[2 * pp + 1][nt][2], S[2 * pp + 1][nt][3]);
                stg_b<u32x4>(SBp, 16u * (unsigned)((pp * 8 + w * 2 + nt) * 64 + lane), t);
                sf[pp][nt] = (bf16x8)t;
            }
        bf16x8 vf[2][2];
#pragma unroll
        for (int q = 0; q < 2; ++q) {
            u32x4 t0, t1;
#pragma unroll
            for (int hh = 0; hh < 2; ++hh) {
                const int mt = 2 * q + hh;
                f32x4 a0 = (f32x4){0.f, 0.f, 0.f, 0.f}, a1 = a0;
#pragma unroll
                for (int pp = 0; pp < 4; ++pp) {
                    const bf16x8 wf = *(const bf16x8*)(cur + (mt * 16 + fr) * 272 + pp * 64 + fq * 16);
                    a0 = mfma16(wf, sf[pp][0], a0);
                    a1 = mfma16(wf, sf[pp][1], a1);
                }
                const f32x4 v0 = ucur[mt][0] - a0, v1 = ucur[mt][1] - a1;
                t0[2 * hh] = pack2(v0[0], v0[1]); t0[2 * hh + 1] = pack2(v0[2], v0[3]);
                t1[2 * hh] = pack2(v1[0], v1[1]); t1[2 * hh + 1] = pack2(v1[2], v1[3]);
            }
            stg_b<u32x4>(VNp, 16u * (unsigned)((q * 8 + w * 2) * 64 + lane), t0);
            stg_b<u32x4>(VNp, 16u * (unsigned)((q * 8 + w * 2 + 1) * 64 + lane), t1);
            vf[q][0] = (bf16x8)t0;
            vf[q][1] = (bf16x8)t1;
        }
        if (n + 1 < 32) {
            const float* Up = (const float*)(p.ws + OFF_U) + (item + 1) * 8192;
#pragma unroll
            for (int mt = 0; mt < 4; ++mt)
#pragma unroll
                for (int nt = 0; nt < 2; ++nt) ucur[mt][nt] = ldg_b<f32x4>(Up, 16u * (unsigned)((mt * 8 + w * 2 + nt) * 64 + lane));
        }
#pragma unroll
        for (int mt = 0; mt < 8; ++mt) {
            S[mt][0] *= eg;
            S[mt][1] *= eg;
#pragma unroll
            for (int q = 0; q < 2; ++q) {
                const bf16x8 kf = *(const bf16x8*)(cur + WBY + (mt * 16 + fr) * 128 + (((q * 4 + fq) ^ (fr & 7)) << 4));
                S[mt][0] = mfma16(kf, vf[q][0], S[mt][0]);
                S[mt][1] = mfma16(kf, vf[q][1], S[mt][1]);
            }
        }
        if (n + 1 < 32) {
            char* nxt = smem + ((n + 1) & 1) * BUFB;
#pragma unroll
            for (int i = 0; i < 4; ++i) {
                const int c = tid + 256 * i;
                *(u32x4*)(nxt + (c >> 4) * 272 + (c & 15) * 16) = stg[i];
                *(u32x4*)(nxt + WBY + (c >> 3) * 128 + ((((c & 7) ^ ((c >> 3) & 7))) << 4)) = stg[4 + i];
            }
        }
        __syncthreads();
    }
    const int lane = tid0 & 63, w = tid0 >> 6, fr = lane & 15, fq = lane >> 4;
    float* so = p.out + O_SSM_P + ((size_t)(l * NB + b) * 8 + h) * 16384;
#pragma unroll
    for (int mt = 0; mt < 8; ++mt)
#pragma unroll
        for (int nt = 0; nt < 2; ++nt)
#pragma unroll
            for (int r = 0; r < 4; ++r) so[(mt * 16 + fq * 4 + r) * 128 + w * 32 + nt * 16 + fr] = S[mt][nt][r];
}

__device__ __forceinline__ void gdn_out_item(const Params& p, int l, int it) {
    const int tid = opaque_tid(), lane = tid & 63, w = tid >> 6, fr = lane & 15, fq = lane >> 4;
    const int n = it & 31, h = (it >> 5) & 7, b = it >> 8;
    const bf16_t* QGp = (const bf16_t*)(p.ws + OFF_QG) + (size_t)it * 8192;
    const bf16_t* QKp = (const bf16_t*)(p.ws + OFF_QK) + (size_t)it * 4096;
    const bf16_t* SBp = (const bf16_t*)(p.ws + OFF_SB) + (size_t)it * 16384;
    const bf16_t* VNp = (const bf16_t*)(p.ws + OFF_VN) + (size_t)it * 8192;
    const bf16_t* P = (const bf16_t*)(p.ws + OFF_P);
    bf16_t* YB = (bf16_t*)(p.ws + OFF_YB);
    bf16x8 qg[4], qk[2];
#pragma unroll
    for (int pp = 0; pp < 4; ++pp) qg[pp] = ldg_b<bf16x8>(QGp, 2u * (unsigned)((w * 16 + fr) * 128 + pp * 32 + fq * 8));
#pragma unroll
    for (int q = 0; q < 2; ++q) qk[q] = ldg_b<bf16x8>(QKp, 2u * (unsigned)((w * 16 + fr) * 64 + q * 32 + fq * 8));
    f32x4 acc[8];
    float ss = 0.f;
    const size_t tok = (size_t)b * SEQ + n * 64 + w * 16 + fr;
    uint2 zz[8];
#pragma unroll
    for (int nt = 0; nt < 8; ++nt) zz[nt] = *(const uint2*)(P + tok * PC + C_ZB + h * 128 + nt * 16 + fq * 4);
#pragma unroll
    for (int g = 0; g < 2; ++g) {
        bf16x8 sb[4][4], vn[4][2];
#pragma unroll
        for (int t = 0; t < 4; ++t) {
#pragma unroll
            for (int pp = 0; pp < 4; ++pp) sb[t][pp] = ldg_b<bf16x8>(SBp, 16u * (unsigned)((pp * 8 + g * 4 + t) * 64 + lane));
#pragma unroll
            for (int q = 0; q < 2; ++q) vn[t][q] = ldg_b<bf16x8>(VNp, 16u * (unsigned)((q * 8 + g * 4 + t) * 64 + lane));
        }
        __builtin_amdgcn_sched_barrier(0);
#pragma unroll
        for (int t = 0; t < 4; ++t) {
            f32x4 a = (f32x4){0.f, 0.f, 0.f, 0.f};
#pragma unroll
            for (int pp = 0; pp < 4; ++pp) a = mfma16(sb[t][pp], qg[pp], a);
#pragma unroll
            for (int q = 0; q < 2; ++q) a = mfma16(vn[t][q], qk[q], a);
            acc[g * 4 + t] = a;
            ss += a[0] * a[0] + a[1] * a[1] + a[2] * a[2] + a[3] * a[3];
        }
        __builtin_amdgcn_sched_barrier(0);
    }
    ss += __shfl_xor(ss, 16);
    ss += __shfl_xor(ss, 32);
    const float rinv = rsqrtf(ss * (1.f / 128.f) + NORM_EPS);
#pragma unroll
    for (int nt = 0; nt < 8; ++nt) {
        const int v0 = nt * 16 + fq * 4;
        const float4 g = *(const float4*)(p.onorm_g + l * 128 + v0);
        const uint2 z = zz[nt];
        const float y0 = acc[nt][0] * rinv * g.x * lo_bf(z.x), y1 = acc[nt][1] * rinv * g.y * hi_bf(z.x);
        const float y2 = acc[nt][2] * rinv * g.z * lo_bf(z.y), y3 = acc[nt][3] * rinv * g.w * hi_bf(z.y);
        *(uint2*)(YB + tok * 1024 + h * 128 + v0) = make_uint2(pack2(y0, y1), pack2(y2, y3));
    }
}

constexpr int N_GMLP_P = NB * 16 * 8;
constexpr int N_GDN_S = DBT * 8;
constexpr int N_GMLP_S = DBT;
constexpr int N_CONV = NB + DBT;
constexpr int N_OTHER = N_GMLP_P + N_GDN_S + N_GMLP_S + N_CONV;

__device__ __forceinline__ void other_item(const Params& p, int l, int it, char* smem) {
    if (it < N_GMLP_P) gmlp_prompt_item(p, l, it, smem);
    else if (it < N_GMLP_P + N_GDN_S) gdn_sample_item(p, l, it - N_GMLP_P, smem);
    else if (it < N_GMLP_P + N_GDN_S + N_GMLP_S) gmlp_sample_item(p, l, it - N_GMLP_P - N_GDN_S, smem);
    else conv_state_item(p, l, it - N_GMLP_P - N_GDN_S - N_GMLP_S);
}

__device__ __forceinline__ void phase_mixb(const Params& p, int l, char* smem) {
    const int G = gridDim.x;
    if (G >= 128) {
        if (blockIdx.x < 64) gdn_scan_item(p, l, blockIdx.x, smem);
        else for (int it = blockIdx.x - 64; it < N_OTHER; it += G - 64) other_item(p, l, it, smem);
    } else {
        for (int it = blockIdx.x; it < 64; it += G) gdn_scan_item(p, l, it, smem);
        for (int it = blockIdx.x; it < N_OTHER; it += G) other_item(p, l, it, smem);
    }
}

#define FRESH(q) const Params& q = p
#define XB_TMO      128
#define XB_XCNT(j)  (256  + 64 * (j))
#define XB_XSUB(j)  (1280 + 64 * (j))
#define XB_XGEN(j)  (2304 + 64 * (j))
#define XB_TOP      3328
#define XB_TOPGEN   3392
#define XCD_BAR_WORDS 3456
#define XB_SPIN_CAP (1u << 22)
#define LAS __attribute__((address_space(3)))
__device__ __forceinline__ unsigned xb_ld(unsigned* p) { return __hip_atomic_load(p, __ATOMIC_RELAXED, __HIP_MEMORY_SCOPE_AGENT); }
__device__ __forceinline__ unsigned xb_add(unsigned* p, unsigned v) { return __hip_atomic_fetch_add(p, v, __ATOMIC_RELAXED, __HIP_MEMORY_SCOPE_AGENT); }
__device__ __forceinline__ unsigned xb_xcc_id() { return (unsigned)__builtin_amdgcn_s_getreg((3 << 11) | 20) & 0xFu; }
#define XB_SPIN(cond, bar) do { unsigned _sp = 0; while (cond) { __builtin_amdgcn_s_sleep(1); \
    if ((++_sp & 255u) == 0u) { if (xb_ld(&(bar)[XB_TMO])) break; if (_sp > XB_SPIN_CAP) { atomicAdd(&(bar)[XB_TMO], 1u); break; } } } } while (0)
struct XcdBarrier { unsigned* bar; unsigned x; volatile LAS unsigned* st; };
__device__ __forceinline__ XcdBarrier xcd_barrier_post(unsigned* bar, volatile LAS unsigned* st) {
    XcdBarrier b; b.bar = bar; b.x = xb_xcc_id(); b.st = st;
    if (threadIdx.x == 0) (void)xb_add(&bar[XB_XCNT(b.x)], 1u);
    return b;
}
__device__ __forceinline__ void xcd_barrier_complete(unsigned* bar, unsigned x, unsigned& nloc, unsigned& nx) {
    const unsigned G = gridDim.x * gridDim.y * gridDim.z;
    unsigned sum, cnt, mine, sp = 0u;
    for (;;) {
        sum = 0u; cnt = 0u; mine = 0u;
#pragma unroll
        for (unsigned j = 0; j < 16; ++j) { const unsigned c = xb_ld(&bar[XB_XCNT(j)]); sum += c; cnt += (c > 0u) ? 1u : 0u; mine = (j == x) ? c : mine; }
        if (sum == G) break;
        __builtin_amdgcn_s_sleep(1);
        if ((++sp & 255u) == 0u) { if (xb_ld(&bar[XB_TMO])) break; if (sp > XB_SPIN_CAP) { atomicAdd(&bar[XB_TMO], 1u); break; } }
    }
    nloc = mine > 0u ? mine : 1u; nx = cnt > 0u ? cnt : 1u;
}
__device__ __forceinline__ void xcd_barrier(const XcdBarrier& b) {
    asm volatile("s_waitcnt vmcnt(0)" ::: "memory");
    __syncthreads();
    if (threadIdx.x == 0) {
        unsigned* bar = b.bar;
        __builtin_amdgcn_s_waitcnt(0);
        unsigned nloc = b.st[0], nx = b.st[1];
        if (nloc == 0u) { xcd_barrier_complete(bar, b.x, nloc, nx); b.st[0] = nloc; b.st[1] = nx; }
        const unsigned old = xb_add(&bar[XB_XSUB(b.x)], 1u);
        const unsigned gen = old / nloc;
        if (old + 1u == (gen + 1u) * nloc) {
            __builtin_amdgcn_fence(__ATOMIC_RELEASE, "agent");
            asm volatile("s_waitcnt vmcnt(0)" ::: "memory");
            const unsigned og = xb_add(&bar[XB_TOP], 1u);
            const unsigned tg = og / nx;
            if (og + 1u == (tg + 1u) * nx) xb_add(&bar[XB_TOPGEN], 1u);
            else XB_SPIN(xb_ld(&bar[XB_TOPGEN]) == tg, bar);
            __builtin_amdgcn_fence(__ATOMIC_ACQUIRE, "agent");
            xb_add(&bar[XB_XGEN(b.x)], 1u);
            asm volatile("s_waitcnt vmcnt(0)" ::: "memory");
        } else {
            XB_SPIN(xb_ld(&bar[XB_XGEN(b.x)]) == gen, bar);
            __builtin_amdgcn_fence(__ATOMIC_ACQUIRE, "agent");
            asm volatile("s_waitcnt vmcnt(0)" ::: "memory");
        }
    }
    __syncthreads();
}

__global__ void __launch_bounds__(256, 2) fwd_megakernel(Params p) {
    extern __shared__ __attribute__((aligned(16))) char smem[];
    __shared__ uint4 xb_words;
    cg::grid_group grid = cg::this_grid();
    unsigned* bar = (unsigned*)(p.ws + OFF_BAR);
    if (blockIdx.x == 0) for (int i = threadIdx.x; i < XCD_BAR_WORDS; i += 256) __hip_atomic_store(bar + i, 0u, __ATOMIC_RELAXED, __HIP_MEMORY_SCOPE_AGENT);
    if (threadIdx.x == 0) xb_words = make_uint4(0u, 0u, 0u, 0u);
    { FRESH(q); phase0(q, smem); }
    grid.sync();
    const XcdBarrier xb = xcd_barrier_post(bar, (volatile LAS unsigned*)&xb_words);
#define GBAR() xcd_barrier(xb)
    for (int l = 0; l < DEPTH; ++l) {
        { FRESH(q); phase_rows(q, l); }
        GBAR();
        { FRESH(q); phase_inproj256(q, l, smem); }
        GBAR();
        { FRESH(q); for (int it = blockIdx.x; it < NCHK; it += gridDim.x) gdn_prep_item(q, l, it, smem); }
        GBAR();
        { FRESH(q); phase_mixb(q, l, smem); }
        GBAR();
        { FRESH(q); for (int it = blockIdx.x; it < NCHK; it += gridDim.x) gdn_out_item(q, l, it); }
        GBAR();
        { FRESH(q); phase_merge(q, l, smem); }
        GBAR();
        { FRESH(q); phase_outproj(q, l, smem); }
        GBAR();
    }
    { FRESH(q); phase_rows(q, DEPTH); }
}

extern "C" void kernel_launch(void* const* d_in, const int* in_sizes, int n_in, void* d_out, int out_size, void* d_ws, size_t ws_size,
                              hipStream_t stream) {
    static int grid_blocks = 0;
    if (!grid_blocks) {
        int dev = 0, cus = 0, per_cu = 0;
        hipGetDevice(&dev);
        hipDeviceGetAttribute(&cus, hipDeviceAttributeMultiprocessorCount, dev);
        hipFuncSetAttribute((const void*)fwd_megakernel, hipFuncAttributeMaxDynamicSharedMemorySize, SMEM_BYTES);
        hipOccupancyMaxActiveBlocksPerMultiprocessor(&per_cu, fwd_megakernel, 256, SMEM_BYTES);
        if (per_cu > 2) per_cu = 2;
        if (per_cu < 1) per_cu = 1;
        grid_blocks = cus * per_cu;
    }
    if (ws_size < WS_NEED) {
        fprintf(stderr, "workspace too small: %zu < %zu\n", ws_size, (size_t)WS_NEED);
        return;
    }
    Params p{};
    const float** f = (const float**)&p;
    for (int i = 0; i < 22; ++i) f[i] = (const float*)d_in[i];
    p.out = (float*)d_out;
    p.ws = (char*)d_ws;
    void* args[] = {&p};
    hipError_t e = hipLaunchCooperativeKernel((const void*)fwd_megakernel, dim3(grid_blocks), dim3(256), args, SMEM_BYTES, stream);
    if (e != hipSuccess) fprintf(stderr, "cooperative launch failed: %s (grid %d)\n", hipGetErrorString(e), grid_blocks);
}
```

```cpp
#include <hip/hip_runtime.h>
#include <hip/hip_cooperative_groups.h>
#include <cstdio>
namespace cg = cooperative_groups;

typedef unsigned short bf16_t;
typedef short bf16x8 __attribute__((ext_vector_type(8)));
typedef float f32x4 __attribute__((ext_vector_type(4)));
typedef unsigned u32x4 __attribute__((ext_vector_type(4)));

constexpr int D = 1024;
constexpr int NB = 8, SEQ = 2048, DEPTH = 4, DBT = 128, DSQ = 4;
constexpr int TP = NB * SEQ;
constexpr int TS = DBT * DSQ;
constexpr int T = TP + TS;
constexpr int PIN = 9232;
constexpr int PC = 9216;
constexpr int NPAD = 9344;
constexpr int NROWB = NB + DBT;
constexpr float ALPHA_DN = 1.681792830507429f;
constexpr float LN_EPS = 1e-5f, NORM_EPS = 1e-6f;
constexpr int C_UA = 0, C_VA = 1024, C_ZA = 2048, C_Q = 3072, C_ZB = 6144, C_GA = 7168, C_GB = 8192;

constexpr size_t O_Y_P = 0, O_Y_S = 16777216, O_CONV_P = 17301504, O_SSM_P = 17596416, O_CV_P = 21790720,
                 O_CONV_S = 25985024, O_SSM_S = 30703616, O_CV_S = 97812480;

constexpr size_t SZ_WT_IN = (size_t)DEPTH * NPAD * 1024 * 2;
constexpr size_t SZ_WT_SQ = (size_t)DEPTH * 1024 * 1024 * 2;
constexpr size_t OFF_WT_IN = 0;
constexpr size_t OFF_WT_PA = OFF_WT_IN + SZ_WT_IN;
constexpr size_t OFF_WT_PB = OFF_WT_PA + SZ_WT_SQ;
constexpr size_t OFF_WT_O = OFF_WT_PB + SZ_WT_SQ;
constexpr size_t OFF_MOD = OFF_WT_O + SZ_WT_SQ;
constexpr size_t OFF_X = OFF_MOD + (size_t)DEPTH * NROWB * 3072 * 4;
constexpr size_t OFF_TT = OFF_X + (size_t)T * 1024 * 4;
constexpr size_t OFF_H = OFF_TT + (size_t)T * 1024 * 4;
constexpr size_t OFF_YA = OFF_H + (size_t)T * 1024 * 2;
constexpr size_t OFF_YB = OFF_YA + (size_t)T * 1024 * 2;
constexpr size_t OFF_MM = OFF_YB + (size_t)T * 1024 * 2;
constexpr size_t OFF_P = OFF_MM + (size_t)T * 1024 * 2;
constexpr size_t OFF_BETA = OFF_P + (size_t)T * PC * 2;
constexpr size_t OFF_GLOG = OFF_BETA + (size_t)T * 8 * 4;
constexpr int NCHK = 2048;
constexpr size_t OFF_U = OFF_GLOG + (size_t)T * 8 * 4;
constexpr size_t OFF_WG = OFF_U + (size_t)NCHK * 8192 * 4;
constexpr size_t OFF_QG = OFF_WG + (size_t)NCHK * 8192 * 2;
constexpr size_t OFF_KDT = OFF_QG + (size_t)NCHK * 8192 * 2;
constexpr size_t OFF_QK = OFF_KDT + (size_t)NCHK * 8192 * 2;
constexpr size_t OFF_EG = OFF_QK + (size_t)NCHK * 4096 * 2;
constexpr size_t OFF_SB = OFF_EG + (size_t)NCHK * 4;
constexpr size_t OFF_VN = OFF_SB + (size_t)NCHK * 16384 * 2;
constexpr size_t OFF_PARK = OFF_VN + (size_t)NCHK * 8192 * 2;
constexpr size_t OFF_STATS = OFF_PARK + (size_t)1024 * 32768;
constexpr size_t OFF_BAR = OFF_STATS + (size_t)T * 2 * 4;
constexpr size_t WS_NEED = OFF_BAR + 16384;

constexpr int SMEM_BYTES = 73728;
constexpr int TILE_BYTES = 128 * 128;

struct Params {
    const float *x_prompt, *x_sample, *state_conv, *state_ssm, *c_prompt, *c_sample, *w_ada, *b_ada, *w_in, *w_s, *b_s,
        *lnv_g, *lnv_b, *conv_w, *a_log, *dt_bias, *onorm_g, *w_pa, *w_pb, *w_o, *ln_g, *ln_b;
    float* out;
    char* ws;
};

__device__ __forceinline__ unsigned pack2(float a, float b) {
    unsigned r;
    asm("v_cvt_pk_bf16_f32 %0, %1, %2" : "=v"(r) : "v"(a), "v"(b));
    return r;
}
__device__ __forceinline__ bf16_t f2bf(float f) { return (bf16_t)(pack2(f, 0.f) & 0xffffu); }
__device__ __forceinline__ float bf2f(bf16_t h) { return __uint_as_float(((unsigned)h) << 16); }
__device__ __forceinline__ float lo_bf(unsigned u) { return __uint_as_float(u << 16); }
__device__ __forceinline__ float hi_bf(unsigned u) { return __uint_as_float(u & 0xffff0000u); }
__device__ __forceinline__ float sigmoid_f(float x) { return __builtin_amdgcn_rcpf(1.f + __builtin_amdgcn_exp2f(-1.4426950408889634f * x)); }
__device__ __forceinline__ float silu_f(float x) { return x * sigmoid_f(x); }
__device__ __forceinline__ float gelu_f(float x) {
    const float y2 = x * (1.5957691216057308f + 0.0713548162726f * x * x);
    return x * __builtin_amdgcn_rcpf(1.f + __builtin_amdgcn_exp2f(-1.4426950408889634f * y2));
}
__device__ __forceinline__ float softplus_f(float x) { return fmaxf(x, 0.f) + log1pf(__expf(-fabsf(x))); }
__device__ __forceinline__ float wave_sum(float v) {
#pragma unroll
    for (int o = 32; o >= 1; o >>= 1) v += __shfl_xor(v, o);
    return v;
}
__device__ __forceinline__ f32x4 mfma16(bf16x8 a, bf16x8 b, f32x4 c) { return __builtin_amdgcn_mfma_f32_16x16x32_bf16(a, b, c, 0, 0, 0); }
template <class Tp> __device__ __forceinline__ Tp ldg_b(const void* base, unsigned boff) { return *(const Tp*)((const char*)base + boff); }
template <class Tp> __device__ __forceinline__ void stg_b(void* base, unsigned boff, Tp v) { *(Tp*)((char*)base + boff) = v; }
__host__ __device__ constexpr int perm32(int k) { return (k & ~31) | (((k >> 2) & 3) << 3) | (((k >> 4) & 1) << 2) | (k & 3); }
__device__ __forceinline__ int opaque_tid() { int t = threadIdx.x; asm volatile("" : "+v"(t)); return t; }
__device__ __forceinline__ int opaque_zero() { int z = 0; asm volatile("" : "+v"(z)); return z; }
__device__ __forceinline__ int cond_row(int row) { return row < TP ? (row >> 11) : (NB + ((row - TP) >> 2)); }

template <int WGM = 8>
__device__ __forceinline__ void tile_map(int L, int ntiles, int nM, int nN, int& tm, int& tn) {
    const int q = ntiles / 8, r = ntiles % 8, xcd = L % 8, off = L / 8;
    const int g = (xcd < r ? xcd * (q + 1) : r * (q + 1) + (xcd - r) * q) + off;
    const int nig = WGM * nN, gid = g / nig, fm = gid * WGM, gsz = (nM - fm) < WGM ? (nM - fm) : WGM;
    tm = fm + (g % nig) % gsz;
    tn = (g % nig) / gsz;
}

template <int MT>
__device__ __forceinline__ void gemm_core(const bf16_t* __restrict__ A, const bf16_t* __restrict__ B, const int K,
                                          f32x4 (&acc)[MT][4], char* smem, const int tid) {
    const int lane = tid & 63, wid = tid >> 6, wr = wid >> 1, wc = wid & 1;
    const int srow = tid >> 3, sseg = (tid & 7) ^ ((tid >> 3) & 7);
    const bf16_t* ag = A + (size_t)srow * K + sseg * 8;
    const bf16_t* bg = B + (size_t)srow * K + sseg * 8;
    const int nk = K >> 6;
#define STAGE(BUF, KT) do { char* d_ = smem + (BUF) * 2 * TILE_BYTES + tid * 16; \
        _Pragma("unroll") for (int i = 0; i < MT; ++i) __builtin_amdgcn_global_load_lds((const unsigned*)(ag + (size_t)(32 * i) * K + (KT) * 64), (__attribute__((address_space(3))) unsigned*)(d_ + i * 4096), 16, 0, 0); \
        _Pragma("unroll") for (int i = 0; i < 4; ++i) __builtin_amdgcn_global_load_lds((const unsigned*)(bg + (size_t)(32 * i) * K + (KT) * 64), (__attribute__((address_space(3))) unsigned*)(d_ + TILE_BYTES + i * 4096), 16, 0, 0); } while (0)
#define COMPUTE(BUF) do { const char* cur = smem + (BUF) * 2 * TILE_BYTES; _Pragma("unroll") for (int kk = 0; kk < 2; ++kk) { \
        bf16x8 af[MT], bfr[4]; const int ko = kk ? kx1 : kx0; \
        _Pragma("unroll") for (int m = 0; m < MT; ++m) af[m] = *(const bf16x8*)(cur + aoff + m * 16 * 128 + ko); \
        _Pragma("unroll") for (int n = 0; n < 4; ++n) bfr[n] = *(const bf16x8*)(cur + boff + n * 16 * 128 + ko); \
        _Pragma("unroll") for (int m = 0; m < MT; ++m) _Pragma("unroll") for (int n = 0; n < 4; ++n) acc[m][n] = mfma16(bfr[n], af[m], acc[m][n]); } } while (0)
    const int fr = lane & 15, fq = lane >> 4;
    const int aoff = (wr * 16 * MT + fr) * 128;
    const int boff = TILE_BYTES + (wc * 64 + fr) * 128;
    const int kx0 = (fq ^ (fr & 7)) << 4, kx1 = ((4 + fq) ^ (fr & 7)) << 4;
    __syncthreads();
    STAGE(0, 0);
    asm volatile("s_waitcnt vmcnt(0)" ::: "memory");
    __syncthreads();
    for (int kt = 0; kt < nk; ++kt) {
        if (kt + 1 < nk) STAGE((kt + 1) & 1, kt + 1);
        COMPUTE(kt & 1);
        asm volatile("s_waitcnt vmcnt(0)" ::: "memory");
        __syncthreads();
    }
#undef STAGE
#undef COMPUTE
}

__device__ __forceinline__ int win_src_col(int np) {
    if (np < 7168) return np;
    if (np < 9216) return np + 16;
    if (np < 9232) return np - 9216 + 7168;
    return -1;
}
__device__ __forceinline__ void transpose_item(const float* __restrict__ src, int ld, bool is_win, bf16_t* __restrict__ dst, int kt, int nt, char* smem) {
    smem += opaque_zero();
    float* tile = (float*)smem;
    const int tid = opaque_tid();
    __syncthreads();
    const int nn = tid & 63, kq = tid >> 6;
    const int np = nt * 64 + nn;
    const int oc = is_win ? win_src_col(np) : np;
#pragma unroll
    for (int i = 0; i < 16; ++i) {
        const int kk = kq + 4 * i;
        tile[kk * 65 + nn] = oc >= 0 ? src[(size_t)(kt * 64 + kk) * ld + oc] : 0.f;
    }
    __syncthreads();
    const int r = tid >> 2, seg = tid & 3;
    unsigned pk[8];
#pragma unroll
    for (int j = 0; j < 8; ++j) pk[j] = pack2(tile[(seg * 16 + 2 * j) * 65 + r], tile[(seg * 16 + 2 * j + 1) * 65 + r]);
    uint4* d = (uint4*)(dst + (size_t)(nt * 64 + r) * 1024 + kt * 64 + seg * 16);
    d[0] = make_uint4(pk[0], pk[1], pk[2], pk[3]);
    d[1] = make_uint4(pk[4], pk[5], pk[6], pk[7]);
}

__device__ __forceinline__ void mod_item(const Params& p, int it, char* smem) {
    smem += opaque_zero();
    float* sc = (float*)smem;
    const int tid = opaque_tid();
    const int rg = it & 7, cb = (it >> 3) % 12, l = it / 96;
    __syncthreads();
    for (int idx = tid; idx < 17 * 1024; idx += 256) {
        const int r = idx >> 10, k = idx & 1023, row = rg * 17 + r;
        const float c = row < NB ? p.c_prompt[row * 1024 + k] : p.c_sample[(row - NB) * 1024 + k];
        sc[idx] = silu_f(c);
    }
    __syncthreads();
    const int col = cb * 256 + tid;
    float acc[17];
#pragma unroll
    for (int r = 0; r < 17; ++r) acc[r] = 0.f;
    const float* wp = p.w_ada + (size_t)l * 1024 * 3072 + col;
    for (int k = 0; k < 1024; k += 4) {
        const float w0 = wp[(size_t)(k + 0) * 3072], w1 = wp[(size_t)(k + 1) * 3072], w2 = wp[(size_t)(k + 2) * 3072], w3 = wp[(size_t)(k + 3) * 3072];
#pragma unroll
        for (int r = 0; r < 17; ++r) {
            const float4 s = *(const float4*)&sc[r * 1024 + k];
            acc[r] += s.x * w0 + s.y * w1 + s.z * w2 + s.w * w3;
        }
    }
    float* mod = (float*)(p.ws + OFF_MOD);
    const float bb = p.b_ada[l * 3072 + col];
#pragma unroll
    for (int r = 0; r < 17; ++r) mod[((size_t)l * NROWB + rg * 17 + r) * 3072 + col] = acc[r] + bb;
}

constexpr int N_TR_IN = (NPAD / 64) * 16;
constexpr int N_TR_SQ = 16 * 16;
constexpr int N_TR_LAYER = N_TR_IN + 3 * N_TR_SQ;
constexpr int N_P0_TR = DEPTH * N_TR_LAYER;
constexpr int N_P0_MOD = DEPTH * 12 * 8;

__device__ __forceinline__ void phase0(const Params& p, char* smem) {
    for (int it = blockIdx.x; it < N_P0_TR + N_P0_MOD; it += gridDim.x) {
        if (it < N_P0_TR) {
            const int l = it / N_TR_LAYER;
            int r = it % N_TR_LAYER;
            if (r < N_TR_IN) {
                transpose_item(p.w_in + (size_t)l * 1024 * PIN, PIN, true, (bf16_t*)(p.ws + OFF_WT_IN) + (size_t)l * NPAD * 1024, r & 15, r >> 4, smem);
            } else {
                r -= N_TR_IN;
                const int which = r / N_TR_SQ;
                r %= N_TR_SQ;
                const float* src = (which == 0 ? p.w_pa : which == 1 ? p.w_pb : p.w_o) + (size_t)l * 1024 * 1024;
                bf16_t* dst = (bf16_t*)(p.ws + (which == 0 ? OFF_WT_PA : which == 1 ? OFF_WT_PB : OFF_WT_O)) + (size_t)l * 1024 * 1024;
                transpose_item(src, 1024, false, dst, r & 15, r >> 4, smem);
            }
        } else {
            mod_item(p, it - N_P0_TR, smem);
        }
    }
}

__device__ __forceinline__ void phase_rows(const Params& p, int l) {
    const int tid = opaque_tid();
    const int lane = tid & 63;
    const int gw = blockIdx.x * 4 + (tid >> 6), nw = gridDim.x * 4;
    float* X = (float*)(p.ws + OFF_X);
    const float* TT = (const float*)(p.ws + OFF_TT);
    bf16_t* H = (bf16_t*)(p.ws + OFF_H);
    const float* mod = (const float*)(p.ws + OFF_MOD);
    for (int row = gw; row < T; row += nw) {
        float v[16];
        if (l == 0) {
            const float* src = row < TP ? p.x_prompt + (size_t)row * 1024 : p.x_sample + (size_t)(row - TP) * 1024;
#pragma unroll
            for (int j = 0; j < 4; ++j) {
                const float4 t = *(const float4*)(src + j * 256 + lane * 4);
                v[j * 4 + 0] = t.x; v[j * 4 + 1] = t.y; v[j * 4 + 2] = t.z; v[j * 4 + 3] = t.w;
            }
        } else {
            const float* src = TT + (size_t)row * 1024;
            float s = 0.f;
#pragma unroll
            for (int j = 0; j < 4; ++j) {
                const float4 t = *(const float4*)(src + j * 256 + lane * 4);
                v[j * 4 + 0] = t.x; v[j * 4 + 1] = t.y; v[j * 4 + 2] = t.z; v[j * 4 + 3] = t.w;
                s += t.x + t.y + t.z + t.w;
            }
            const float mean = wave_sum(s) * (1.f / 1024.f);
            float q = 0.f;
#pragma unroll
            for (int e = 0; e < 16; ++e) { v[e] -= mean; q += v[e] * v[e]; }
            const float rstd = rsqrtf(wave_sum(q) * (1.f / 1024.f) + LN_EPS);
            const float* g = p.ln_g + (l - 1) * 1024;
            const float* bb = p.ln_b + (l - 1) * 1024;
#pragma unroll
            for (int j = 0; j < 4; ++j) {
                const float4 gg = *(const float4*)(g + j * 256 + lane * 4);
                const float4 be = *(const float4*)(bb + j * 256 + lane * 4);
                v[j * 4 + 0] = v[j * 4 + 0] * rstd * gg.x + be.x;
                v[j * 4 + 1] = v[j * 4 + 1] * rstd * gg.y + be.y;
                v[j * 4 + 2] = v[j * 4 + 2] * rstd * gg.z + be.z;
                v[j * 4 + 3] = v[j * 4 + 3] * rstd * gg.w + be.w;
            }
        }
        if (l == DEPTH) {
            float* dst = row < TP ? p.out + O_Y_P + (size_t)row * 1024 : p.out + O_Y_S + (size_t)(row - TP) * 1024;
#pragma unroll
            for (int j = 0; j < 4; ++j) *(float4*)(dst + j * 256 + lane * 4) = make_float4(v[j * 4], v[j * 4 + 1], v[j * 4 + 2], v[j * 4 + 3]);
            continue;
        }
        if (lane == 0) *(float2*)((float*)(p.ws + OFF_STATS) + (size_t)row * 2) = make_float2(0.f, 0.f);
        {
            float* dst = X + (size_t)row * 1024;
            float s = 0.f;
#pragma unroll
            for (int j = 0; j < 4; ++j) {
                *(float4*)(dst + j * 256 + lane * 4) = make_float4(v[j * 4], v[j * 4 + 1], v[j * 4 + 2], v[j * 4 + 3]);
                s += v[j * 4] + v[j * 4 + 1] + v[j * 4 + 2] + v[j * 4 + 3];
            }
            const float mean = wave_sum(s) * (1.f / 1024.f);
            float q = 0.f;
#pragma unroll
            for (int e = 0; e < 16; ++e) { v[e] -= mean; q += v[e] * v[e]; }
            const float rstd = rsqrtf(wave_sum(q) * (1.f / 1024.f) + LN_EPS);
            const float* mrow = mod + ((size_t)l * NROWB + cond_row(row)) * 3072;
#pragma unroll
            for (int j = 0; j < 4; ++j) {
                const float4 sh = *(const float4*)(mrow + j * 256 + lane * 4);
                const float4 scl = *(const float4*)(mrow + 1024 + j * 256 + lane * 4);
                const float h0 = v[j * 4 + 0] * rstd * (1.f + scl.x) + sh.x;
                const float h1 = v[j * 4 + 1] * rstd * (1.f + scl.y) + sh.y;
                const float h2 = v[j * 4 + 2] * rstd * (1.f + scl.z) + sh.z;
                const float h3 = v[j * 4 + 3] * rstd * (1.f + scl.w) + sh.w;
                *(uint2*)(H + (size_t)row * 1024 + j * 256 + lane * 4) = make_uint2(pack2(h0, h1), pack2(h2, h3));
            }
        }
    }
}

__device__ __forceinline__ void phase_inproj(const Params& p, int l, char* smem) {
    const bf16_t* H = (const bf16_t*)(p.ws + OFF_H);
    const bf16_t* Wt = (const bf16_t*)(p.ws + OFF_WT_IN) + (size_t)l * NPAD * 1024;
    bf16_t* P = (bf16_t*)(p.ws + OFF_P);
    float* BETA = (float*)(p.ws + OFF_BETA);
    float* GLOG = (float*)(p.ws + OFF_GLOG);
    constexpr int nM = T / 128, nN = NPAD / 128, ntiles = nM * nN;
    for (int L = blockIdx.x; L < ntiles; L += gridDim.x) {
        const int tid = opaque_tid();
        const int lane = tid & 63, wid = tid >> 6, wr = wid >> 1, wc = wid & 1, fr = lane & 15, fq = lane >> 4;
        int tm, tn;
        tile_map(L, ntiles, nM, nN, tm, tn);
        f32x4 acc[4][4];
#pragma unroll
        for (int m = 0; m < 4; ++m)
#pragma unroll
            for (int n = 0; n < 4; ++n) acc[m][n] = (f32x4){0.f, 0.f, 0.f, 0.f};
        gemm_core<4>(H + (size_t)tm * 128 * 1024, Wt + (size_t)tn * 128 * 1024, 1024, acc, smem, tid);
        if (tn == 72) {
            if (wc == 0) {
#pragma unroll
                for (int m = 0; m < 4; ++m) {
                    const int row = tm * 128 + wr * 64 + m * 16 + fr;
#pragma unroll
                    for (int r = 0; r < 4; ++r) {
                        const float a = acc[m][0][r];
                        if (fq < 2) {
                            BETA[(size_t)row * 8 + fq * 4 + r] = sigmoid_f(a);
                        } else {
                            const int h = (fq - 2) * 4 + r;
                            GLOG[(size_t)row * 8 + h] = -__expf(p.a_log[l * 8 + h]) * softplus_f(a + p.dt_bias[l * 8 + h]);
                        }
                    }
                }
            }
        } else {
            const int kind = tn < 16 ? 0 : tn < 24 ? 1 : tn < 48 ? 2 : tn < 56 ? 1 : 3;
            char* st = smem + opaque_zero();
#pragma unroll
            for (int m = 0; m < 4; ++m) {
                const int rl = wr * 64 + m * 16 + fr;
#pragma unroll
                for (int n = 0; n < 4; ++n) {
                    const int cl = wc * 64 + n * 16 + fq * 4;
                    float a[4];
#pragma unroll
                    for (int r = 0; r < 4; ++r) {
                        const float x = acc[m][n][r];
                        a[r] = kind == 0 ? gelu_f(x) : kind == 1 ? silu_f(x) : kind == 2 ? x : sigmoid_f(x);
                    }
                    *(uint2*)(st + rl * 272 + cl * 2) = make_uint2(pack2(a[0], a[1]), pack2(a[2], a[3]));
                }
            }
            __syncthreads();
#pragma unroll
            for (int i = 0; i < 8; ++i) {
                const int rl = (tid >> 4) + 16 * i, sg = tid & 15;
                const u32x4 v = *(const u32x4*)(st + rl * 272 + sg * 16);
                *(u32x4*)(P + (size_t)(tm * 128 + rl) * PC + tn * 128 + sg * 8) = v;
                if (tn >= 8 && tn < 16) {
                    const float a0 = lo_bf(v[0]), a1 = hi_bf(v[0]), a2 = lo_bf(v[1]), a3 = hi_bf(v[1]), a4 = lo_bf(v[2]), a5 = hi_bf(v[2]), a6 = lo_bf(v[3]), a7 = hi_bf(v[3]);
                    float sm = ((a0 + a1) + (a2 + a3)) + ((a4 + a5) + (a6 + a7));
                    float sq = ((a0 * a0 + a1 * a1) + (a2 * a2 + a3 * a3)) + ((a4 * a4 + a5 * a5) + (a6 * a6 + a7 * a7));
#pragma unroll
                    for (int o = 1; o < 16; o <<= 1) { sm += __shfl_xor(sm, o); sq += __shfl_xor(sq, o); }
                    if (sg == 0) {
                        float* stp = (float*)(p.ws + OFF_STATS) + (size_t)(tm * 128 + rl) * 2;
                        atomicAdd(stp, sm);
                        atomicAdd(stp + 1, sq);
                    }
                }
            }
        }
    }
}

constexpr int T2_A = 256 * 64, T2_B = 128 * 64, T2_STAGE = T2_A + T2_B;
__device__ __forceinline__ void gemm_core256(const bf16_t* __restrict__ A, const bf16_t* __restrict__ B, const int K,
                                             f32x4 (&acc)[8][4], char* smem, const int tid) {
    const int lane = tid & 63, wid = tid >> 6, wr = wid >> 1, wc = wid & 1, fr = lane & 15, fq = lane >> 4;
    const int srow = tid >> 2, sseg = (tid & 3) ^ ((tid >> 3) & 3);
    const bf16_t* ag = A + (size_t)srow * K + sseg * 8;
    const bf16_t* bg = B + (size_t)srow * K + sseg * 8;
    const int sw = (fq ^ ((fr >> 1) & 3)) << 4;
    const int aoff = (wr * 128 + fr) * 64 + sw;
    const int boff = T2_A + (wc * 64 + fr) * 64 + sw;
    const int nk = K >> 5;
#define STAGE2(BUF, KT) do { char* d_ = smem + (BUF) * T2_STAGE + tid * 16; \
        _Pragma("unroll") for (int i = 0; i < 4; ++i) __builtin_amdgcn_global_load_lds((const unsigned*)(ag + (size_t)(64 * i) * K + (KT) * 32), (__attribute__((address_space(3))) unsigned*)(d_ + i * 4096), 16, 0, 0); \
        _Pragma("unroll") for (int i = 0; i < 2; ++i) __builtin_amdgcn_global_load_lds((const unsigned*)(bg + (size_t)(64 * i) * K + (KT) * 32), (__attribute__((address_space(3))) unsigned*)(d_ + T2_A + i * 4096), 16, 0, 0); } while (0)
    __syncthreads();
    STAGE2(0, 0);
    STAGE2(1, 1);
    asm volatile("s_waitcnt vmcnt(6)" ::: "memory");
    __builtin_amdgcn_s_barrier();
    asm volatile("" ::: "memory");
    int cb = 0, nb = 2;
    for (int kt = 0; kt < nk; ++kt) {
        if (kt + 2 < nk) STAGE2(nb, kt + 2);
        const char* cur = smem + cb * T2_STAGE;
        bf16x8 bfr[4], af[8];
#pragma unroll
        for (int n = 0; n < 4; ++n) bfr[n] = *(const bf16x8*)(cur + boff + n * 16 * 64);
#pragma unroll
        for (int m = 0; m < 8; ++m) af[m] = *(const bf16x8*)(cur + aoff + m * 16 * 64);
        __builtin_amdgcn_sched_barrier(0);
#pragma unroll
        for (int m = 0; m < 8; ++m)
#pragma unroll
            for (int n = 0; n < 4; ++n) acc[m][n] = mfma16(bfr[n], af[m], acc[m][n]);
        if (kt + 2 < nk) asm volatile("s_waitcnt vmcnt(6)" ::: "memory");
        else asm volatile("s_waitcnt vmcnt(0)" ::: "memory");
        __builtin_amdgcn_s_barrier();
        asm volatile("" ::: "memory");
        cb = cb == 2 ? 0 : cb + 1;
        nb = nb == 2 ? 0 : nb + 1;
    }
#undef STAGE2
    __syncthreads();
}

__device__ __forceinline__ void phase_inproj256(const Params& p, int l, char* smem) {
    const bf16_t* H = (const bf16_t*)(p.ws + OFF_H);
    const bf16_t* Wt = (const bf16_t*)(p.ws + OFF_WT_IN) + (size_t)l * NPAD * 1024;
    bf16_t* P = (bf16_t*)(p.ws + OFF_P);
    float* BETA = (float*)(p.ws + OFF_BETA);
    float* GLOG = (float*)(p.ws + OFF_GLOG);
    constexpr int nM = T / 256, nN = NPAD / 128, ntiles = nM * nN;
    for (int L = blockIdx.x; L < ntiles; L += gridDim.x) {
        const int tid = opaque_tid();
        const int lane = tid & 63, wid = tid >> 6, wr = wid >> 1, wc = wid & 1, fr = lane & 15, fq = lane >> 4;
        int tm, tn;
        tile_map<4>(L, ntiles, nM, nN, tm, tn);
        f32x4 acc[8][4];
#pragma unroll
        for (int m = 0; m < 8; ++m)
#pragma unroll
            for (int n = 0; n < 4; ++n) acc[m][n] = (f32x4){0.f, 0.f, 0.f, 0.f};
        gemm_core256(H + (size_t)tm * 256 * 1024, Wt + (size_t)tn * 128 * 1024, 1024, acc, smem, tid);
        if (tn == 72) {
            if (wc == 0) {
#pragma unroll
                for (int m = 0; m < 8; ++m) {
                    const int row = tm * 256 + wr * 128 + m * 16 + fr;
#pragma unroll
                    for (int r = 0; r < 4; ++r) {
                        const float a = acc[m][0][r];
                        if (fq < 2) {
                            BETA[(size_t)row * 8 + fq * 4 + r] = sigmoid_f(a);
                        } else {
                            const int h = (fq - 2) * 4 + r;
                            GLOG[(size_t)row * 8 + h] = -__expf(p.a_log[l * 8 + h]) * softplus_f(a + p.dt_bias[l * 8 + h]);
                        }
                    }
                }
            }
        } else {
            const int kind = tn < 16 ? 0 : tn < 24 ? 1 : tn < 48 ? 2 : tn < 56 ? 1 : 3;
            char* st = smem + opaque_zero();
#pragma unroll
            for (int m = 0; m < 8; ++m) {
                const int rl = wr * 128 + m * 16 + fr;
#pragma unroll
                for (int n = 0; n < 4; ++n) {
                    const int cl = wc * 64 + n * 16 + fq * 4;
                    float a[4];
#pragma unroll
                    for (int r = 0; r < 4; ++r) {
                        const float x = acc[m][n][r];
                        a[r] = kind == 0 ? gelu_f(x) : kind == 1 ? silu_f(x) : kind == 2 ? x : sigmoid_f(x);
                    }
                    *(uint2*)(st + rl * 272 + cl * 2) = make_uint2(pack2(a[0], a[1]), pack2(a[2], a[3]));
                }
            }
            __syncthreads();
#pragma unroll 4
            for (int i = 0; i < 16; ++i) {
                const int rl = (tid >> 4) + 16 * i, sg = tid & 15;
                const u32x4 v = *(const u32x4*)(st + rl * 272 + sg * 16);
                *(u32x4*)(P + (size_t)(tm * 256 + rl) * PC + tn * 128 + sg * 8) = v;
                if (tn >= 8 && tn < 16) {
                    const float a0 = lo_bf(v[0]), a1 = hi_bf(v[0]), a2 = lo_bf(v[1]), a3 = hi_bf(v[1]), a4 = lo_bf(v[2]), a5 = hi_bf(v[2]), a6 = lo_bf(v[3]), a7 = hi_bf(v[3]);
                    float sm = ((a0 + a1) + (a2 + a3)) + ((a4 + a5) + (a6 + a7));
                    float sq = ((a0 * a0 + a1 * a1) + (a2 * a2 + a3 * a3)) + ((a4 * a4 + a5 * a5) + (a6 * a6 + a7 * a7));
#pragma unroll
                    for (int o = 1; o < 16; o <<= 1) { sm += __shfl_xor(sm, o); sq += __shfl_xor(sq, o); }
                    if (sg == 0) {
                        float* stp = (float*)(p.ws + OFF_STATS) + (size_t)(tm * 256 + rl) * 2;
                        atomicAdd(stp, sm);
                        atomicAdd(stp + 1, sq);
                    }
                }
            }
        }
    }
}

__device__ __forceinline__ void phase_merge(const Params& p, int l, char* smem) {
    const bf16_t* YA = (const bf16_t*)(p.ws + OFF_YA);
    const bf16_t* YB = (const bf16_t*)(p.ws + OFF_YB);
    const bf16_t* Wa = (const bf16_t*)(p.ws + OFF_WT_PA) + (size_t)l * 1024 * 1024;
    const bf16_t* Wb = (const bf16_t*)(p.ws + OFF_WT_PB) + (size_t)l * 1024 * 1024;
    const bf16_t* P = (const bf16_t*)(p.ws + OFF_P);
    bf16_t* MM = (bf16_t*)(p.ws + OFF_MM);
    constexpr int RT = 96, MT = 3;
    constexpr int nM = T / RT, nN = 8, ntiles = nM * nN;
    for (int L = blockIdx.x; L < ntiles; L += gridDim.x) {
        const int tid = opaque_tid();
        const int lane = tid & 63, wid = tid >> 6, wr = wid >> 1, wc = wid & 1, fr = lane & 15, fq = lane >> 4;
        int tm, tn;
        tile_map(L, ntiles, nM, nN, tm, tn);
        f32x4 acc[MT][4];
#pragma unroll
        for (int m = 0; m < MT; ++m)
#pragma unroll
            for (int n = 0; n < 4; ++n) acc[m][n] = (f32x4){0.f, 0.f, 0.f, 0.f};
        gemm_core<MT>(YA + (size_t)tm * RT * 1024, Wa + (size_t)tn * 128 * 1024, 1024, acc, smem, tid);
        uint2* park = (uint2*)(p.ws + OFF_PARK) + (size_t)blockIdx.x * 4096 + tid;
        uint2 gv[MT][4];
#pragma unroll
        for (int m = 0; m < MT; ++m)
#pragma unroll
            for (int n = 0; n < 4; ++n)
                gv[m][n] = *(const uint2*)(P + (size_t)(tm * RT + wr * 16 * MT + m * 16 + fr) * PC + C_GA + tn * 128 + wc * 64 + n * 16 + fq * 4);
        __builtin_amdgcn_sched_barrier(0);
#pragma unroll
        for (int m = 0; m < MT; ++m)
#pragma unroll
            for (int n = 0; n < 4; ++n) {
                const uint2 g = gv[m][n];
                park[(m * 4 + n) * 256] = make_uint2(pack2(acc[m][n][0] * lo_bf(g.x), acc[m][n][1] * hi_bf(g.x)),
                                                     pack2(acc[m][n][2] * lo_bf(g.y), acc[m][n][3] * hi_bf(g.y)));
                acc[m][n] = (f32x4){0.f, 0.f, 0.f, 0.f};
            }
        __builtin_amdgcn_sched_barrier(0);
        gemm_core<MT>(YB + (size_t)tm * RT * 1024, Wb + (size_t)tn * 128 * 1024, 1024, acc, smem, tid);
        char* st = smem + opaque_zero();
        uint2 pv[MT][4];
#pragma unroll
        for (int m = 0; m < MT; ++m)
#pragma unroll
            for (int n = 0; n < 4; ++n) {
                gv[m][n] = *(const uint2*)(P + (size_t)(tm * RT + wr * 16 * MT + m * 16 + fr) * PC + C_GB + tn * 128 + wc * 64 + n * 16 + fq * 4);
                pv[m][n] = park[(m * 4 + n) * 256];
            }
        __builtin_amdgcn_sched_barrier(0);
#pragma unroll
        for (int m = 0; m < MT; ++m) {
            const int rl = wr * 16 * MT + m * 16 + fr;
#pragma unroll
            for (int n = 0; n < 4; ++n) {
                const int cl = wc * 64 + n * 16 + fq * 4;
                const uint2 g = gv[m][n];
                const uint2 pm = pv[m][n];
                const float a0 = lo_bf(pm.x) + acc[m][n][0] * lo_bf(g.x);
                const float a1 = hi_bf(pm.x) + acc[m][n][1] * hi_bf(g.x);
                const float a2 = lo_bf(pm.y) + acc[m][n][2] * lo_bf(g.y);
                const float a3 = hi_bf(pm.y) + acc[m][n][3] * hi_bf(g.y);
                *(uint2*)(st + rl * 272 + cl * 2) = make_uint2(pack2(a0, a1), pack2(a2, a3));
            }
            __builtin_amdgcn_sched_barrier(0);
        }
        __syncthreads();
#pragma unroll
        for (int i = 0; i < RT / 16; ++i) {
            const int rl = (tid >> 4) + 16 * i, sg = tid & 15;
            const u32x4 v = *(const u32x4*)(st + rl * 272 + sg * 16);
            *(u32x4*)(MM + (size_t)(tm * RT + rl) * 1024 + tn * 128 + sg * 8) = v;
        }
    }
}

__device__ __forceinline__ void phase_outproj(const Params& p, int l, char* smem) {
    const bf16_t* MM = (const bf16_t*)(p.ws + OFF_MM);
    const bf16_t* Wo = (const bf16_t*)(p.ws + OFF_WT_O) + (size_t)l * 1024 * 1024;
    const float* X = (const float*)(p.ws + OFF_X);
    float* TT = (float*)(p.ws + OFF_TT);
    const float* mod = (const float*)(p.ws + OFF_MOD);
    constexpr int RT = 96, MT = 3;
    constexpr int nM = T / RT, nN = 8, ntiles = nM * nN;
    for (int L = blockIdx.x; L < ntiles; L += gridDim.x) {
        const int tid = opaque_tid();
        const int lane = tid & 63, wid = tid >> 6, wr = wid >> 1, wc = wid & 1, fr = lane & 15, fq = lane >> 4;
        int tm, tn;
        tile_map(L, ntiles, nM, nN, tm, tn);
        f32x4 acc[MT][4];
#pragma unroll
        for (int m = 0; m < MT; ++m)
#pragma unroll
            for (int n = 0; n < 4; ++n) acc[m][n] = (f32x4){0.f, 0.f, 0.f, 0.f};
        gemm_core<MT>(MM + (size_t)tm * RT * 1024, Wo + (size_t)tn * 128 * 1024, 1024, acc, smem, tid);
        float* st = (float*)(smem + opaque_zero());
#pragma unroll
        for (int m = 0; m < MT; ++m)
#pragma unroll
            for (int n = 0; n < 4; ++n) *(f32x4*)(st + (wr * 16 * MT + m * 16 + fr) * 132 + wc * 64 + n * 16 + fq * 4) = acc[m][n];
        __syncthreads();
#pragma unroll
        for (int hb = 0; hb < 2; ++hb) {
            float4 xv[6], gv[6];
#pragma unroll
            for (int i = 0; i < 6; ++i) {
                const int rl = (tid >> 5) + 8 * (hb * 6 + i), c4 = (tid & 31) * 4;
                const int row = tm * RT + rl, col = tn * 128 + c4;
                xv[i] = *(const float4*)(X + (size_t)row * 1024 + col);
                gv[i] = *(const float4*)(mod + ((size_t)l * NROWB + cond_row(row)) * 3072 + 2048 + col);
            }
            __builtin_amdgcn_sched_barrier(0);
#pragma unroll
            for (int i = 0; i < 6; ++i) {
                const int rl = (tid >> 5) + 8 * (hb * 6 + i), c4 = (tid & 31) * 4;
                const int row = tm * RT + rl, col = tn * 128 + c4;
                const f32x4 a = *(const f32x4*)(st + rl * 132 + c4);
                const float4 x = xv[i], g = gv[i];
                *(float4*)(TT + (size_t)row * 1024 + col) = make_float4(ALPHA_DN * x.x + g.x * a[0], ALPHA_DN * x.y + g.y * a[1],
                                                                        ALPHA_DN * x.z + g.z * a[2], ALPHA_DN * x.w + g.w * a[3]);
            }
            __builtin_amdgcn_sched_barrier(0);
        }
    }
}

__device__ __forceinline__ void gmlp_prompt_item(const Params& p, int l, int it, char* smem) {
    smem += opaque_zero();
    const int tid = opaque_tid(), lane = tid & 63, wid = tid >> 6, wr = wid >> 1, wc = wid & 1, fr = lane & 15, fq = lane >> 4;
    const int h = it & 7, n = (it >> 3) & 15, b = it >> 7;
    const int tok0 = b * SEQ + n * 128;
    const bf16_t* P = (const bf16_t*)(p.ws + OFF_P);
    bf16_t* YA = (bf16_t*)(p.ws + OFF_YA);
    bf16_t* Wt = (bf16_t*)smem;
    bf16_t* VnT = Wt + 128 * 136;
    float* mu = (float*)(smem + 2 * 34816);
    float* rs = mu + 128;
    __syncthreads();
    {
        const int t = tid >> 1, half = tid & 1;
        const float* wsrc = p.w_s + ((size_t)(l * 8 + h) * 128 + t) * 128 + half * 64;
#pragma unroll
        for (int i = 0; i < 8; ++i) {
            const float4 w0 = *(const float4*)(wsrc + i * 8);
            const float4 w1 = *(const float4*)(wsrc + i * 8 + 4);
            const int s0 = half * 64 + i * 8;
            const float e0 = s0 + 0 <= t ? w0.x : 0.f, e1 = s0 + 1 <= t ? w0.y : 0.f, e2 = s0 + 2 <= t ? w0.z : 0.f, e3 = s0 + 3 <= t ? w0.w : 0.f;
            const float e4 = s0 + 4 <= t ? w1.x : 0.f, e5 = s0 + 5 <= t ? w1.y : 0.f, e6 = s0 + 6 <= t ? w1.z : 0.f, e7 = s0 + 7 <= t ? w1.w : 0.f;
            *(uint4*)(Wt + t * 136 + s0) = make_uint4(pack2(e0, e1), pack2(e2, e3), pack2(e4, e5), pack2(e6, e7));
        }
        if (half == 0) {
            const float2 sv = *(const float2*)((const float*)(p.ws + OFF_STATS) + (size_t)(tok0 + t) * 2);
            const float mean = sv.x * (1.f / 1024.f);
            const float var = fmaxf(sv.y * (1.f / 1024.f) - mean * mean, 0.f);
            mu[t] = mean;
            rs[t] = rsqrtf(var + LN_EPS);
        }
    }
    __syncthreads();
    {
        const int c = tid & 127, sg = tid >> 7;
        const float gam = p.lnv_g[l * 1024 + h * 128 + c], bet = p.lnv_b[l * 1024 + h * 128 + c];
        const bf16_t* src = P + (size_t)tok0 * PC + C_VA + h * 128 + c;
        float* cv = p.out + O_CV_P + ((size_t)(l * NB + b) * 128) * 1024 + h * 128 + c;
        bf16_t rw[64];
#pragma unroll
        for (int q = 0; q < 64; ++q) rw[q] = src[(size_t)(sg * 64 + q) * PC];
        __builtin_amdgcn_sched_barrier(0);
#pragma unroll
        for (int oct = 0; oct < 8; ++oct) {
            const int s0 = sg * 64 + oct * 8;
            float e[8];
#pragma unroll
            for (int j = 0; j < 8; ++j) {
                const float x = bf2f(rw[oct * 8 + j]);
                e[j] = (x - mu[s0 + j]) * rs[s0 + j] * gam + bet;
            }
            if (n == 15) {
#pragma unroll
                for (int j = 0; j < 8; ++j) cv[(size_t)(s0 + j) * 1024] = e[j];
            }
            *(uint4*)(VnT + c * 136 + s0) = make_uint4(pack2(e[0], e[1]), pack2(e[2], e[3]), pack2(e[4], e[5]), pack2(e[6], e[7]));
        }
    }
    __syncthreads();
    f32x4 acc[4][4];
#pragma unroll
    for (int m = 0; m < 4; ++m)
#pragma unroll
        for (int nn = 0; nn < 4; ++nn) acc[m][nn] = (f32x4){0.f, 0.f, 0.f, 0.f};
#pragma unroll
    for (int ks = 0; ks < 4; ++ks) {
        bf16x8 af[4], bfr[4];
#pragma unroll
        for (int m = 0; m < 4; ++m) af[m] = *(const bf16x8*)(Wt + (wr * 64 + m * 16 + fr) * 136 + ks * 32 + fq * 8);
#pragma unroll
        for (int nn = 0; nn < 4; ++nn) bfr[nn] = *(const bf16x8*)(VnT + (wc * 64 + nn * 16 + fr) * 136 + ks * 32 + fq * 8);
#pragma unroll
        for (int m = 0; m < 4; ++m)
#pragma unroll
            for (int nn = 0; nn < 4; ++nn) acc[m][nn] = mfma16(bfr[nn], af[m], acc[m][nn]);
    }
    uint2 uu[4][4], zq[4][4];
#pragma unroll
    for (int m = 0; m < 4; ++m) {
        const bf16_t* prow = P + (size_t)(tok0 + wr * 64 + m * 16 + fr) * PC + h * 128;
#pragma unroll
        for (int nn = 0; nn < 4; ++nn) {
            const int c = wc * 64 + nn * 16 + fq * 4;
            uu[m][nn] = *(const uint2*)(prow + C_UA + c);
            zq[m][nn] = *(const uint2*)(prow + C_ZA + c);
        }
    }
    __builtin_amdgcn_sched_barrier(0);
#pragma unroll
    for (int m = 0; m < 4; ++m) {
        const int t = wr * 64 + m * 16 + fr;
        const float bs = p.b_s[(l * 8 + h) * 128 + t];
#pragma unroll
        for (int nn = 0; nn < 4; ++nn) {
            const int c = wc * 64 + nn * 16 + fq * 4;
            const uint2 u = uu[m][nn], z = zq[m][nn];
            const float y0 = lo_bf(u.x) * (acc[m][nn][0] + bs) * lo_bf(z.x);
            const float y1 = hi_bf(u.x) * (acc[m][nn][1] + bs) * hi_bf(z.x);
            const float y2 = lo_bf(u.y) * (acc[m][nn][2] + bs) * lo_bf(z.y);
            const float y3 = hi_bf(u.y) * (acc[m][nn][3] + bs) * hi_bf(z.y);
            *(uint2*)(YA + (size_t)(tok0 + t) * 1024 + h * 128 + c) = make_uint2(pack2(y0, y1), pack2(y2, y3));
        }
    }
}

__device__ __forceinline__ void gmlp_sample_item(const Params& p, int l, int b, char* smem) {
    smem += opaque_zero();
    const int tid = opaque_tid(), lane = tid & 63, wid = tid >> 6;
    const int tok0 = TP + b * DSQ;
    const bf16_t* P = (const bf16_t*)(p.ws + OFF_P);
    bf16_t* YA = (bf16_t*)(p.ws + OFF_YA);
    float* red = (float*)smem;
    __syncthreads();
    const int c4 = tid * 4;
    float x[4][4];
    float s[4], ss[4];
#pragma unroll
    for (int t = 0; t < 4; ++t) {
        const uint2 u = *(const uint2*)(P + (size_t)(tok0 + t) * PC + C_VA + c4);
        x[t][0] = lo_bf(u.x); x[t][1] = hi_bf(u.x); x[t][2] = lo_bf(u.y); x[t][3] = hi_bf(u.y);
        s[t] = wave_sum(x[t][0] + x[t][1] + x[t][2] + x[t][3]);
        ss[t] = wave_sum(x[t][0] * x[t][0] + x[t][1] * x[t][1] + x[t][2] * x[t][2] + x[t][3] * x[t][3]);
    }
    if (lane == 0) {
#pragma unroll
        for (int t = 0; t < 4; ++t) { red[wid * 8 + t] = s[t]; red[wid * 8 + 4 + t] = ss[t]; }
    }
    __syncthreads();
    const float4 gam = *(const float4*)(p.lnv_g + l * 1024 + c4);
    const float4 bet = *(const float4*)(p.lnv_b + l * 1024 + c4);
    float vn[4][4];
#pragma unroll
    for (int t = 0; t < 4; ++t) {
        const float st = red[t] + red[8 + t] + red[16 + t] + red[24 + t];
        const float sst = red[4 + t] + red[12 + t] + red[20 + t] + red[28 + t];
        const float mean = st * (1.f / 1024.f);
        const float rstd = rsqrtf(fmaxf(sst * (1.f / 1024.f) - mean * mean, 0.f) + LN_EPS);
        vn[t][0] = (x[t][0] - mean) * rstd * gam.x + bet.x;
        vn[t][1] = (x[t][1] - mean) * rstd * gam.y + bet.y;
        vn[t][2] = (x[t][2] - mean) * rstd * gam.z + bet.z;
        vn[t][3] = (x[t][3] - mean) * rstd * gam.w + bet.w;
        *(float4*)(p.out + O_CV_S + ((size_t)(l * DBT + b) * DSQ + t) * 1024 + c4) = make_float4(vn[t][0], vn[t][1], vn[t][2], vn[t][3]);
    }
    const int h = c4 >> 7;
#pragma unroll
    for (int t = 0; t < 4; ++t) {
        const float bs = p.b_s[(l * 8 + h) * 128 + t];
        float a[4] = {bs, bs, bs, bs};
#pragma unroll
        for (int sidx = 0; sidx <= t; ++sidx) {
            const float w = p.w_s[((size_t)(l * 8 + h) * 128 + t) * 128 + sidx];
#pragma unroll
            for (int e = 0; e < 4; ++e) a[e] += w * vn[sidx][e];
        }
        const uint2 u = *(const uint2*)(P + (size_t)(tok0 + t) * PC + C_UA + c4);
        const uint2 z = *(const uint2*)(P + (size_t)(tok0 + t) * PC + C_ZA + c4);
        const float y0 = lo_bf(u.x) * a[0] * lo_bf(z.x), y1 = hi_bf(u.x) * a[1] * hi_bf(z.x);
        const float y2 = lo_bf(u.y) * a[2] * lo_bf(z.y), y3 = hi_bf(u.y) * a[3] * hi_bf(z.y);
        *(uint2*)(YA + (size_t)(tok0 + t) * 1024 + c4) = make_uint2(pack2(y0, y1), pack2(y2, y3));
    }
}

__device__ __forceinline__ void conv_state_item(const Params& p, int l, int it) {
    const bf16_t* P = (const bf16_t*)(p.ws + OFF_P);
    const bool pr = it < NB;
    const int b = pr ? it : it - NB;
    const int tokb = pr ? b * SEQ + SEQ - 3 : TP + b * DSQ + 1;
    float* dst = pr ? p.out + O_CONV_P + (size_t)(l * NB + b) * 3 * 3072 : p.out + O_CONV_S + (size_t)(l * DBT + b) * 3 * 3072;
    for (int idx = opaque_tid(); idx < 3 * 768; idx += 256) {
        const int j = idx / 768, c = (idx % 768) * 4;
        const uint2 u = *(const uint2*)(P + (size_t)(tokb + j) * PC + C_Q + c);
        *(float4*)(dst + j * 3072 + c) = make_float4(lo_bf(u.x), hi_bf(u.x), lo_bf(u.y), hi_bf(u.y));
    }
}

__device__ __forceinline__ void gdn_sample_item(const Params& p, int l, int it, char* smem) {
    smem += opaque_zero();
    const int tid = opaque_tid(), lane = tid & 63, wid = tid >> 6;
    const int b = it >> 3, h = it & 7;
    const int tok0 = TP + b * DSQ;
    const bf16_t* P = (const bf16_t*)(p.ws + OFF_P);
    const float* BETA = (const float*)(p.ws + OFF_BETA);
    const float* GLOG = (const float*)(p.ws + OFF_GLOG);
    bf16_t* YB = (bf16_t*)(p.ws + OFF_YB);
    float* qs = (float*)smem;
    float* ks = qs + 512;
    float* vs = ks + 512;
    float* red = vs + 512;
    float* part = red + 16;
    float* opart = part + 1024;
    float* red2 = opart + 1024;
    __syncthreads();
    const int j = tid & 127;
    const bool isk = tid >= 128;
    float y1[4], y2[4];
    {
        const int cq = (isk ? 1024 : 0) + h * 128 + j;
        const float* sc = p.state_conv + (size_t)(l * DBT + b) * 3 * 3072;
        const float* cw = p.conv_w + (size_t)l * 4 * 3072;
        float xr[7];
#pragma unroll
        for (int r = 0; r < 3; ++r) xr[r] = sc[r * 3072 + cq];
#pragma unroll
        for (int t = 0; t < 4; ++t) xr[3 + t] = bf2f(P[(size_t)(tok0 + t) * PC + C_Q + cq]);
        const float w0 = cw[cq], w1 = cw[3072 + cq], w2 = cw[2 * 3072 + cq], w3 = cw[3 * 3072 + cq];
#pragma unroll
        for (int t = 0; t < 4; ++t) y1[t] = silu_f(w0 * xr[t] + w1 * xr[t + 1] + w2 * xr[t + 2] + w3 * xr[t + 3]);
        if (!isk) {
            const int cv = 2048 + h * 128 + j;
#pragma unroll
            for (int r = 0; r < 3; ++r) xr[r] = sc[r * 3072 + cv];
#pragma unroll
            for (int t = 0; t < 4; ++t) xr[3 + t] = bf2f(P[(size_t)(tok0 + t) * PC + C_Q + cv]);
            const float v0 = cw[cv], v1 = cw[3072 + cv], v2 = cw[2 * 3072 + cv], v3 = cw[3 * 3072 + cv];
#pragma unroll
            for (int t = 0; t < 4; ++t) y2[t] = silu_f(v0 * xr[t] + v1 * xr[t + 1] + v2 * xr[t + 2] + v3 * xr[t + 3]);
        }
    }
#pragma unroll
    for (int t = 0; t < 4; ++t) {
        const float s = wave_sum(y1[t] * y1[t]);
        if (lane == 0) red[wid * 4 + t] = s;
    }
    __syncthreads();
#pragma unroll
    for (int t = 0; t < 4; ++t) {
        const float tot = isk ? red[8 + t] + red[12 + t] : red[t] + red[4 + t];
        const float rn = rsqrtf(tot + NORM_EPS);
        if (isk) ks[t * 128 + j] = y1[t] * rn;
        else { qs[t * 128 + j] = y1[t] * rn * 0.08838834764831845f; vs[t * 128 + j] = y2[t]; }
    }
    __syncthreads();
    const int vcol = j, kh = tid >> 7;
    float S[64];
    const float* s0 = p.state_ssm + ((size_t)(l * DBT + b) * 8 + h) * 16384 + (size_t)(kh * 64) * 128 + vcol;
#pragma unroll
    for (int kk = 0; kk < 64; ++kk) S[kk] = s0[kk * 128];
#pragma unroll
    for (int t = 0; t < 4; ++t) {
        const float a = __expf(GLOG[(size_t)(tok0 + t) * 8 + h]);
        const float bt = BETA[(size_t)(tok0 + t) * 8 + h];
        float r0 = 0.f, r1 = 0.f;
#pragma unroll
        for (int kk = 0; kk < 64; kk += 4) {
            const float4 kv = *(const float4*)&ks[t * 128 + kh * 64 + kk];
            r0 += S[kk] * kv.x + S[kk + 2] * kv.z;
            r1 += S[kk + 1] * kv.y + S[kk + 3] * kv.w;
        }
        part[(t * 2 + kh) * 128 + vcol] = r0 + r1;
        __syncthreads();
        const float dlt = bt * (vs[t * 128 + vcol] - a * (part[(t * 2) * 128 + vcol] + part[(t * 2 + 1) * 128 + vcol]));
        float o0 = 0.f, o1 = 0.f;
#pragma unroll
        for (int kk = 0; kk < 64; kk += 4) {
            const float4 kv = *(const float4*)&ks[t * 128 + kh * 64 + kk];
            const float4 qv = *(const float4*)&qs[t * 128 + kh * 64 + kk];
            S[kk] = a * S[kk] + kv.x * dlt;
            S[kk + 1] = a * S[kk + 1] + kv.y * dlt;
            S[kk + 2] = a * S[kk + 2] + kv.z * dlt;
            S[kk + 3] = a * S[kk + 3] + kv.w * dlt;
            o0 += S[kk] * qv.x + S[kk + 2] * qv.z;
            o1 += S[kk + 1] * qv.y + S[kk + 3] * qv.w;
        }
        opart[(t * 2 + kh) * 128 + vcol] = o0 + o1;
    }
    float* sout = p.out + O_SSM_S + ((size_t)(l * DBT + b) * 8 + h) * 16384 + (size_t)(kh * 64) * 128 + vcol;
#pragma unroll
    for (int kk = 0; kk < 64; ++kk) sout[kk * 128] = S[kk];
    __syncthreads();
    float o[4];
    if (tid < 128) {
#pragma unroll
        for (int t = 0; t < 4; ++t) {
            o[t] = opart[(t * 2) * 128 + vcol] + opart[(t * 2 + 1) * 128 + vcol];
            const float s = wave_sum(o[t] * o[t]);
            if (lane == 0) red2[wid * 4 + t] = s;
        }
    }
    __syncthreads();
    if (tid < 128) {
        const float gn = p.onorm_g[l * 128 + vcol];
#pragma unroll
        for (int t = 0; t < 4; ++t) {
            const float rinv = rsqrtf((red2[t] + red2[4 + t]) * (1.f / 128.f) + NORM_EPS);
            const float zs = bf2f(P[(size_t)(tok0 + t) * PC + C_ZB + h * 128 + vcol]);
            YB[(size_t)(tok0 + t) * 1024 + h * 128 + vcol] = f2bf(o[t] * rinv * gn * zs);
        }
    }
}

__device__ __forceinline__ void gdn_prep_item(const Params& p, int l, int it, char* smem) {
    smem += opaque_zero();
    const int tid = opaque_tid(), lane = tid & 63, wid = tid >> 6, fr = lane & 15, fq = lane >> 4;
    const int n = it & 31, h = (it >> 5) & 7, b = it >> 8;
    const int tok0 = b * SEQ + n * 64;
    const bf16_t* P = (const bf16_t*)(p.ws + OFF_P);
    const float* BETA = (const float*)(p.ws + OFF_BETA);
    const float* GLOG = (const float*)(p.ws + OFF_GLOG);
    float* Ug = (float*)(p.ws + OFF_U) + (size_t)it * 8192;
    bf16_t* Wg = (bf16_t*)(p.ws + OFF_WG) + (size_t)it * 8192;
    bf16_t* QGg = (bf16_t*)(p.ws + OFF_QG) + (size_t)it * 8192;
    bf16_t* KDTg = (bf16_t*)(p.ws + OFF_KDT) + (size_t)it * 8192;
    bf16_t* QKg = (bf16_t*)(p.ws + OFF_QK) + (size_t)it * 4096;
    float* EGg = (float*)(p.ws + OFF_EG);
    bf16_t* Qs = (bf16_t*)smem;
    bf16_t* Ks = Qs + 64 * 136;
    bf16_t* Kbs = Ks + 64 * 136;
    float* Am = (float*)(smem + 3 * 17408);
    float* gcs = Am + 64 * 68;
    float* betas = gcs + 64;
    float* red = betas + 64;
    __syncthreads();
    const int j = tid & 127;
    const bool isk = tid >= 128;
    float val[64];
    char* R1 = smem + 2 * 17408;
    char* R2 = smem + 3 * 17408;
    {
        const bf16_t* pb = P + ((ptrdiff_t)tok0 - 3) * PC + C_Q + h * 128;
        u32x4 tv[9];
#pragma unroll
        for (int it9 = 0; it9 < 9; ++it9) {
            const int c = tid + 256 * it9;
            const int cc = c < 67 * 32 ? c : 67 * 32 - 1;
            const int r = cc >> 5, sg = cc & 31;
            const bool ok = n > 0 || r >= 3;
            const u32x4 v = *(const u32x4*)(pb + (ptrdiff_t)(ok ? r : 3) * PC + (sg >> 4) * 1024 + (sg & 15) * 8);
            tv[it9] = ok ? v : (u32x4){0u, 0u, 0u, 0u};
        }
        __builtin_amdgcn_sched_barrier(0);
        if (tid < 64) {
            float g = GLOG[(size_t)(tok0 + tid) * 8 + h];
    #pragma unroll
            for (int o = 1; o < 64; o <<= 1) {
                const float t = __shfl_up(g, o);
                if (lane >= o) g += t;
            }
            gcs[tid] = g;
            betas[tid] = BETA[(size_t)(tok0 + tid) * 8 + h];
        }
        __builtin_amdgcn_sched_barrier(0);
#pragma unroll
        for (int it9 = 0; it9 < 9; ++it9) {
            const int c = tid + 256 * it9;
            if (c < 67 * 32) *(u32x4*)(R1 + (c >> 5) * 512 + (c & 31) * 16) = tv[it9];
        }
    }
    __syncthreads();
    {
        const int cq = (isk ? 1024 : 0) + h * 128 + j;
        const float* cw = p.conv_w + (size_t)l * 4 * 3072;
        const float w0 = cw[cq], w1 = cw[3072 + cq], w2 = cw[2 * 3072 + cq], w3 = cw[3 * 3072 + cq];
        const bf16_t* col = (const bf16_t*)(R1 + (isk ? 256 : 0)) + j;
        float x3 = bf2f(col[0]), x2 = bf2f(col[256]), x1 = bf2f(col[512]);
#pragma unroll
        for (int i = 0; i < 64; ++i) {
            const float x0 = bf2f(col[(i + 3) * 256]);
            val[i] = silu_f(w0 * x3 + w1 * x2 + w2 * x1 + w3 * x0);
            x3 = x2; x2 = x1; x1 = x0;
            if ((i & 15) == 15) __builtin_amdgcn_sched_barrier(0);
        }
    }
#pragma unroll
    for (int i = 0; i < 64; ++i) {
        const float s = wave_sum(val[i] * val[i]);
        if (lane == 0) red[wid * 64 + i] = s;
        if ((i & 7) == 7) __builtin_amdgcn_sched_barrier(0);
    }
    __syncthreads();
    const float glast = gcs[63];
    {
        const bf16_t* pb = P + ((ptrdiff_t)tok0 - 3) * PC + C_Q + 2048 + h * 128;
        u32x4 tv[5];
#pragma unroll
        for (int it5 = 0; it5 < 5; ++it5) {
            const int c = tid + 256 * it5;
            const int cc = c < 67 * 16 ? c : 67 * 16 - 1;
            const int r = cc >> 4, sg = cc & 15;
            const bool ok = n > 0 || r >= 3;
            const u32x4 v = *(const u32x4*)(pb + (ptrdiff_t)(ok ? r : 3) * PC + sg * 8);
            tv[it5] = ok ? v : (u32x4){0u, 0u, 0u, 0u};
        }
        __builtin_amdgcn_sched_barrier(0);
#pragma unroll
        for (int it5 = 0; it5 < 5; ++it5) {
            const int c = tid + 256 * it5;
            if (c < 67 * 16) *(u32x4*)(R2 + (c >> 4) * 256 + (c & 15) * 16) = tv[it5];
        }
    }
    if (!isk) {
#pragma unroll
        for (int i = 0; i < 64; ++i) {
            const float rn = rsqrtf(red[i] + red[64 + i] + NORM_EPS);
            const float qv = val[i] * rn * 0.08838834764831845f;
            Qs[i * 136 + j] = f2bf(qv);
            QGg[i * 128 + perm32(j)] = f2bf(qv * __expf(gcs[i]));
            if ((i & 7) == 7) __builtin_amdgcn_sched_barrier(0);
        }
    } else {
        unsigned pk[32];
#pragma unroll
        for (int i = 0; i < 64; ++i) {
            const float rn = rsqrtf(red[128 + i] + red[192 + i] + NORM_EPS);
            const float kv = val[i] * rn;
            const float gi = gcs[i], bi = betas[i];
            Ks[i * 136 + j] = f2bf(kv);
            Kbs[i * 136 + j] = f2bf(kv * bi);
            const bf16_t kd = f2bf(kv * __expf(glast - gi));
            if (i & 1) pk[perm32(i) >> 1] |= ((unsigned)kd) << 16; else pk[perm32(i) >> 1] = kd;
            val[i] = kv * bi * __expf(gi);
            if ((i & 7) == 7) __builtin_amdgcn_sched_barrier(0);
        }
#pragma unroll
        for (int i = 0; i < 8; ++i) *(uint4*)(KDTg + j * 64 + i * 8) = make_uint4(pk[i * 4], pk[i * 4 + 1], pk[i * 4 + 2], pk[i * 4 + 3]);
    }
    __syncthreads();
    if (!isk) {
        const int cv = 2048 + h * 128 + j;
        const float* cw = p.conv_w + (size_t)l * 4 * 3072;
        const float w0 = cw[cv], w1 = cw[3072 + cv], w2 = cw[2 * 3072 + cv], w3 = cw[3 * 3072 + cv];
        const bf16_t* col = (const bf16_t*)R2 + j;
        float x3 = bf2f(col[0]), x2 = bf2f(col[128]), x1 = bf2f(col[256]);
#pragma unroll
        for (int i = 0; i < 64; ++i) {
            const float x0 = bf2f(col[(i + 3) * 128]);
            val[i] = silu_f(w0 * x3 + w1 * x2 + w2 * x1 + w3 * x0) * betas[i];
            x3 = x2; x2 = x1; x1 = x0;
            if ((i & 15) == 15) __builtin_amdgcn_sched_barrier(0);
        }
    }
    __syncthreads();
    {
        f32x4 aA[4], aQ[4];
#pragma unroll
        for (int nt = 0; nt < 4; ++nt) { aA[nt] = (f32x4){0.f, 0.f, 0.f, 0.f}; aQ[nt] = (f32x4){0.f, 0.f, 0.f, 0.f}; }
#pragma unroll
        for (int ksi = 0; ksi < 4; ++ksi) {
            const bf16x8 fa = *(const bf16x8*)(Kbs + (wid * 16 + fr) * 136 + ksi * 32 + fq * 8);
            const bf16x8 fqv = *(const bf16x8*)(Qs + (wid * 16 + fr) * 136 + ksi * 32 + fq * 8);
#pragma unroll
            for (int nt = 0; nt < 4; ++nt) {
                const bf16x8 fb = *(const bf16x8*)(Ks + (nt * 16 + fr) * 136 + ksi * 32 + fq * 8);
                aA[nt] = mfma16(fa, fb, aA[nt]);
                aQ[nt] = mfma16(fqv, fb, aQ[nt]);
            }
        }
#pragma unroll
        for (int nt = 0; nt < 4; ++nt) {
            const int jc = nt * 16 + fr;
            const float gj = gcs[jc];
#pragma unroll
            for (int r = 0; r < 4; ++r) {
                const int i = wid * 16 + fq * 4 + r;
                const float dec = jc <= i ? __expf(gcs[i] - gj) : 0.f;
                Am[i * 68 + jc] = jc < i ? aA[nt][r] * dec : 0.f;
                QKg[i * 64 + perm32(jc)] = f2bf(aQ[nt][r] * dec);
            }
        }
    }
    __syncthreads();
#pragma unroll
    for (int i = 1; i < 64; ++i) {
        float s0 = 0.f, s1 = 0.f, s2 = 0.f, s3 = 0.f;
#pragma unroll
        for (int j4 = 0; j4 < (i + 3) / 4; ++j4) {
            const float4 a = *(const float4*)&Am[i * 68 + j4 * 4];
            s0 += a.x * val[j4 * 4];
            s1 += a.y * val[j4 * 4 + 1];
            s2 += a.z * val[j4 * 4 + 2];
            s3 += a.w * val[j4 * 4 + 3];
        }
        val[i] -= (s0 + s1) + (s2 + s3);
        if ((i & 3) == 3) __builtin_amdgcn_sched_barrier(0);
    }
    if (!isk) {
#pragma unroll
        for (int i = 0; i < 64; i += 4)
            *(float4*)(Ug + (((i >> 4) * 8 + (j >> 4)) * 64 + ((i >> 2) & 3) * 16 + (j & 15)) * 4) = make_float4(val[i], val[i + 1], val[i + 2], val[i + 3]);
    } else {
        const int pj = perm32(j);
#pragma unroll
        for (int i = 0; i < 64; ++i) Wg[i * 128 + pj] = f2bf(val[i]);
    }
    if (tid == 0) EGg[it] = __expf(glast);
}

__device__ __forceinline__ void gdn_scan_item(const Params& p, int l, int bh, char* smem) {
    smem += opaque_zero();
    const int tid0 = opaque_tid();
    const int b = bh >> 3, h = bh & 7;
    constexpr int WBY = 64 * 272, BUFB = WBY + 128 * 128;
    const float* EGg = (const float*)(p.ws + OFF_EG);
    f32x4 S[8][2];
#pragma unroll
    for (int mt = 0; mt < 8; ++mt) { S[mt][0] = (f32x4){0.f, 0.f, 0.f, 0.f}; S[mt][1] = (f32x4){0.f, 0.f, 0.f, 0.f}; }
    u32x4 stg[8];
    f32x4 ucur[4][2];
    {
        const size_t item = (size_t)bh * 32;
        const bf16_t* Wp = (const bf16_t*)(p.ws + OFF_WG) + item * 8192;
        const bf16_t* KDTp = (const bf16_t*)(p.ws + OFF_KDT) + item * 8192;
        const float* Up = (const float*)(p.ws + OFF_U) + item * 8192;
        const int lane = tid0 & 63, w = tid0 >> 6, fr = lane & 15, fq = lane >> 4;
#pragma unroll
        for (int i = 0; i < 4; ++i) {
            stg[i] = ldg_b<u32x4>(Wp, 16u * (unsigned)(tid0 + 256 * i));
            stg[4 + i] = ldg_b<u32x4>(KDTp, 16u * (unsigned)(tid0 + 256 * i));
        }
#pragma unroll
        for (int mt = 0; mt < 4; ++mt)
#pragma unroll
            for (int nt = 0; nt < 2; ++nt) ucur[mt][nt] = ldg_b<f32x4>(Up, 16u * (unsigned)((mt * 8 + w * 2 + nt) * 64 + lane));
        __syncthreads();
#pragma unroll
        for (int i = 0; i < 4; ++i) {
            const int c = tid0 + 256 * i;
            *(u32x4*)(smem + (c >> 4) * 272 + (c & 15) * 16) = stg[i];
            *(u32x4*)(smem + WBY + (c >> 3) * 128 + ((((c & 7) ^ ((c >> 3) & 7))) << 4)) = stg[4 + i];
        }
        __syncthreads();
    }
    for (int n = 0; n < 32; ++n) {
        int tid = tid0;
        asm volatile("" : "+v"(tid));
        const int lane = tid & 63, w = tid >> 6, fr = lane & 15, fq = lane >> 4;
        const char* cur = smem + (n & 1) * BUFB;
        const size_t item = (size_t)bh * 32 + n;
        const float eg = EGg[item];
        bf16_t* SBp = (bf16_t*)(p.ws + OFF_SB) + item * 16384;
        bf16_t* VNp = (bf16_t*)(p.ws + OFF_VN) + item * 8192;
        if (n + 1 < 32) {
            const bf16_t* Wp = (const bf16_t*)(p.ws + OFF_WG) + (item + 1) * 8192;
            const bf16_t* KDTp = (const bf16_t*)(p.ws + OFF_KDT) + (item + 1) * 8192;
#pragma unroll
            for (int i = 0; i < 4; ++i) {
                stg[i] = ldg_b<u32x4>(Wp, 16u * (unsigned)(tid + 256 * i));
                stg[4 + i] = ldg_b<u32x4>(KDTp, 16u * (unsigned)(tid + 256 * i));
            }
        }
        bf16x8 sf[4][2];
#pragma unroll
        for (int pp = 0; pp < 4; ++pp)
#pragma unroll
            for (int nt = 0; nt < 2; ++nt) {
                u32x4 t;
                t[0] = pack2(S[2 * pp][nt][0], S[2 * pp][nt][1]);
                t[1] = pack2(S[2 * pp][nt][2], S[2 * pp][nt][3]);
                t[2] = pack2(S[2 * pp + 1][nt][0], S[2 * pp + 1][nt][1]);
                t[3] = pack2(S[2 * pp + 1][nt][2], S[2 * pp + 1][nt][3]);
                stg_b<u32x4>(SBp, 16u * (unsigned)((pp * 8 + w * 2 + nt) * 64 + lane), t);
                sf[pp][nt] = (bf16x8)t;
            }
        bf16x8 vf[2][2];
#pragma unroll
        for (int q = 0; q < 2; ++q) {
            u32x4 t0, t1;
#pragma unroll
            for (int hh = 0; hh < 2; ++hh) {
                const int mt = 2 * q + hh;
                f32x4 a0 = (f32x4){0.f, 0.f, 0.f, 0.f}, a1 = a0;
#pragma unroll
                for (int pp = 0; pp < 4; ++pp) {
                    const bf16x8 wf = *(const bf16x8*)(cur + (mt * 16 + fr) * 272 + pp * 64 + fq * 16);
                    a0 = mfma16(wf, sf[pp][0], a0);
                    a1 = mfma16(wf, sf[pp][1], a1);
                }
                const f32x4 v0 = ucur[mt][0] - a0, v1 = ucur[mt][1] - a1;
                t0[2 * hh] = pack2(v0[0], v0[1]); t0[2 * hh + 1] = pack2(v0[2], v0[3]);
                t1[2 * hh] = pack2(v1[0], v1[1]); t1[2 * hh + 1] = pack2(v1[2], v1[3]);
            }
            stg_b<u32x4>(VNp, 16u * (unsigned)((q * 8 + w * 2) * 64 + lane), t0);
            stg_b<u32x4>(VNp, 16u * (unsigned)((q * 8 + w * 2 + 1) * 64 + lane), t1);
            vf[q][0] = (bf16x8)t0;
            vf[q][1] = (bf16x8)t1;
        }
        if (n + 1 < 32) {
            const float* Up = (const float*)(p.ws + OFF_U) + (item + 1) * 8192;
#pragma unroll
            for (int mt = 0; mt < 4; ++mt)
#pragma unroll
                for (int nt = 0; nt < 2; ++nt) ucur[mt][nt] = ldg_b<f32x4>(Up, 16u * (unsigned)((mt * 8 + w * 2 + nt) * 64 + lane));
        }
#pragma unroll
        for (int mt = 0; mt < 8; ++mt) {
            S[mt][0] *= eg;
            S[mt][1] *= eg;
#pragma unroll
            for (int q = 0; q < 2; ++q) {
                const bf16x8 kf = *(const bf16x8*)(cur + WBY + (mt * 16 + fr) * 128 + (((q * 4 + fq) ^ (fr & 7)) << 4));
                S[mt][0] = mfma16(kf, vf[q][0], S[mt][0]);
                S[mt][1] = mfma16(kf, vf[q][1], S[mt][1]);
            }
        }
        if (n + 1 < 32) {
            char* nxt = smem + ((n + 1) & 1) * BUFB;
#pragma unroll
            for (int i = 0; i < 4; ++i) {
                const int c = tid + 256 * i;
                *(u32x4*)(nxt + (c >> 4) * 272 + (c & 15) * 16) = stg[i];
                *(u32x4*)(nxt + WBY + (c >> 3) * 128 + ((((c & 7) ^ ((c >> 3) & 7))) << 4)) = stg[4 + i];
            }
        }
        __syncthreads();
    }
    const int lane = tid0 & 63, w = tid0 >> 6, fr = lane & 15, fq = lane >> 4;
    float* so = p.out + O_SSM_P + ((size_t)(l * NB + b) * 8 + h) * 16384;
#pragma unroll
    for (int mt = 0; mt < 8; ++mt)
#pragma unroll
        for (int nt = 0; nt < 2; ++nt)
#pragma unroll
            for (int r = 0; r < 4; ++r) so[(mt * 16 + fq * 4 + r) * 128 + w * 32 + nt * 16 + fr] = S[mt][nt][r];
}

__device__ __forceinline__ void gdn_out_item(const Params& p, int l, int it) {
    const int tid = opaque_tid(), lane = tid & 63, w = tid >> 6, fr = lane & 15, fq = lane >> 4;
    const int n = it & 31, h = (it >> 5) & 7, b = it >> 8;
    const bf16_t* QGp = (const bf16_t*)(p.ws + OFF_QG) + (size_t)it * 8192;
    const bf16_t* QKp = (const bf16_t*)(p.ws + OFF_QK) + (size_t)it * 4096;
    const bf16_t* SBp = (const bf16_t*)(p.ws + OFF_SB) + (size_t)it * 16384;
    const bf16_t* VNp = (const bf16_t*)(p.ws + OFF_VN) + (size_t)it * 8192;
    const bf16_t* P = (const bf16_t*)(p.ws + OFF_P);
    bf16_t* YB = (bf16_t*)(p.ws + OFF_YB);
    bf16x8 qg[4], qk[2];
#pragma unroll
    for (int pp = 0; pp < 4; ++pp) qg[pp] = ldg_b<bf16x8>(QGp, 2u * (unsigned)((w * 16 + fr) * 128 + pp * 32 + fq * 8));
#pragma unroll
    for (int q = 0; q < 2; ++q) qk[q] = ldg_b<bf16x8>(QKp, 2u * (unsigned)((w * 16 + fr) * 64 + q * 32 + fq * 8));
    f32x4 acc[8];
    float ss = 0.f;
    const size_t tok = (size_t)b * SEQ + n * 64 + w * 16 + fr;
    uint2 zz[8];
#pragma unroll
    for (int nt = 0; nt < 8; ++nt) zz[nt] = *(const uint2*)(P + tok * PC + C_ZB + h * 128 + nt * 16 + fq * 4);
#pragma unroll
    for (int g = 0; g < 2; ++g) {
        bf16x8 sb[4][4], vn[4][2];
#pragma unroll
        for (int t = 0; t < 4; ++t) {
#pragma unroll
            for (int pp = 0; pp < 4; ++pp) sb[t][pp] = ldg_b<bf16x8>(SBp, 16u * (unsigned)((pp * 8 + g * 4 + t) * 64 + lane));
#pragma unroll
            for (int q = 0; q < 2; ++q) vn[t][q] = ldg_b<bf16x8>(VNp, 16u * (unsigned)((q * 8 + g * 4 + t) * 64 + lane));
        }
        __builtin_amdgcn_sched_barrier(0);
#pragma unroll
        for (int t = 0; t < 4; ++t) {
            f32x4 a = (f32x4){0.f, 0.f, 0.f, 0.f};
#pragma unroll
            for (int pp = 0; pp < 4; ++pp) a = mfma16(sb[t][pp], qg[pp], a);
#pragma unroll
            for (int q = 0; q < 2; ++q) a = mfma16(vn[t][q], qk[q], a);
            acc[g * 4 + t] = a;
            ss += a[0] * a[0] + a[1] * a[1] + a[2] * a[2] + a[3] * a[3];
        }
        __builtin_amdgcn_sched_barrier(0);
    }
    ss += __shfl_xor(ss, 16);
    ss += __shfl_xor(ss, 32);
    const float rinv = rsqrtf(ss * (1.f / 128.f) + NORM_EPS);
#pragma unroll
    for (int nt = 0; nt < 8; ++nt) {
        const int v0 = nt * 16 + fq * 4;
        const float4 g = *(const float4*)(p.onorm_g + l * 128 + v0);
        const uint2 z = zz[nt];
        const float y0 = acc[nt][0] * rinv * g.x * lo_bf(z.x), y1 = acc[nt][1] * rinv * g.y * hi_bf(z.x);
        const float y2 = acc[nt][2] * rinv * g.z * lo_bf(z.y), y3 = acc[nt][3] * rinv * g.w * hi_bf(z.y);
        *(uint2*)(YB + tok * 1024 + h * 128 + v0) = make_uint2(pack2(y0, y1), pack2(y2, y3));
    }
}

constexpr int N_GMLP_P = NB * 16 * 8;
constexpr int N_GDN_S = DBT * 8;
constexpr int N_GMLP_S = DBT;
constexpr int N_CONV = NB + DBT;
constexpr int N_OTHER = N_GMLP_P + N_GDN_S + N_GMLP_S + N_CONV;

__device__ __forceinline__ void other_item(const Params& p, int l, int it, char* smem) {
    if (it < N_GMLP_P) gmlp_prompt_item(p, l, it, smem);
    else if (it < N_GMLP_P + N_GDN_S) gdn_sample_item(p, l, it - N_GMLP_P, smem);
    else if (it < N_GMLP_P + N_GDN_S + N_GMLP_S) gmlp_sample_item(p, l, it - N_GMLP_P - N_GDN_S, smem);
    else conv_state_item(p, l, it - N_GMLP_P - N_GDN_S - N_GMLP_S);
}

__device__ __forceinline__ void phase_mixb(const Params& p, int l, char* smem) {
    const int G = gridDim.x;
    if (G >= 128) {
        if (blockIdx.x < 64) gdn_scan_item(p, l, blockIdx.x, smem);
        else for (int it = blockIdx.x - 64; it < N_OTHER; it += G - 64) other_item(p, l, it, smem);
    } else {
        for (int it = blockIdx.x; it < 64; it += G) gdn_scan_item(p, l, it, smem);
        for (int it = blockIdx.x; it < N_OTHER; it += G) other_item(p, l, it, smem);
    }
}

#define FRESH(q) const Params& q = p
#define XB_TMO      128
#define XB_XCNT(j)  (256  + 64 * (j))
#define XB_XSUB(j)  (1280 + 64 * (j))
#define XB_XGEN(j)  (2304 + 64 * (j))
#define XB_TOP      3328
#define XB_TOPGEN   3392
#define XCD_BAR_WORDS 3456
#define XB_SPIN_CAP (1u << 22)
#define LAS __attribute__((address_space(3)))
__device__ __forceinline__ unsigned xb_ld(unsigned* p) { return __hip_atomic_load(p, __ATOMIC_RELAXED, __HIP_MEMORY_SCOPE_AGENT); }
__device__ __forceinline__ unsigned xb_add(unsigned* p, unsigned v) { return __hip_atomic_fetch_add(p, v, __ATOMIC_RELAXED, __HIP_MEMORY_SCOPE_AGENT); }
__device__ __forceinline__ unsigned xb_xcc_id() { return (unsigned)__builtin_amdgcn_s_getreg((3 << 11) | 20) & 0xFu; }
#define XB_SPIN(cond, bar) do { unsigned _sp = 0; while (cond) { __builtin_amdgcn_s_sleep(1); \
    if ((++_sp & 255u) == 0u) { if (xb_ld(&(bar)[XB_TMO])) break; if (_sp > XB_SPIN_CAP) { atomicAdd(&(bar)[XB_TMO], 1u); break; } } } } while (0)
struct XcdBarrier { unsigned* bar; unsigned x; volatile LAS unsigned* st; };
__device__ __forceinline__ XcdBarrier xcd_barrier_post(unsigned* bar, volatile LAS unsigned* st) {
    XcdBarrier b; b.bar = bar; b.x = xb_xcc_id(); b.st = st;
    if (threadIdx.x == 0) (void)xb_add(&bar[XB_XCNT(b.x)], 1u);
    return b;
}
__device__ __forceinline__ void xcd_barrier_complete(unsigned* bar, unsigned x, unsigned& nloc, unsigned& nx) {
    const unsigned G = gridDim.x * gridDim.y * gridDim.z;
    unsigned sum, cnt, mine, sp = 0u;
    for (;;) {
        sum = 0u; cnt = 0u; mine = 0u;
#pragma unroll
        for (unsigned j = 0; j < 16; ++j) { const unsigned c = xb_ld(&bar[XB_XCNT(j)]); sum += c; cnt += (c > 0u) ? 1u : 0u; mine = (j == x) ? c : mine; }
        if (sum == G) break;
        __builtin_amdgcn_s_sleep(1);
        if ((++sp & 255u) == 0u) { if (xb_ld(&bar[XB_TMO])) break; if (sp > XB_SPIN_CAP) { atomicAdd(&bar[XB_TMO], 1u); break; } }
    }
    nloc = mine > 0u ? mine : 1u; nx = cnt > 0u ? cnt : 1u;
}
__device__ __forceinline__ void xcd_barrier(const XcdBarrier& b) {
    asm volatile("s_waitcnt vmcnt(0)" ::: "memory");
    __syncthreads();
    if (threadIdx.x == 0) {
        unsigned* bar = b.bar;
        __builtin_amdgcn_s_waitcnt(0);
        unsigned nloc = b.st[0], nx = b.st[1];
        if (nloc == 0u) { xcd_barrier_complete(bar, b.x, nloc, nx); b.st[0] = nloc; b.st[1] = nx; }
        const unsigned old = xb_add(&bar[XB_XSUB(b.x)], 1u);
        const unsigned gen = old / nloc;
        if (old + 1u == (gen + 1u) * nloc) {
            __builtin_amdgcn_fence(__ATOMIC_RELEASE, "agent");
            asm volatile("s_waitcnt vmcnt(0)" ::: "memory");
            const unsigned og = xb_add(&bar[XB_TOP], 1u);
            const unsigned tg = og / nx;
            if (og + 1u == (tg + 1u) * nx) xb_add(&bar[XB_TOPGEN], 1u);
            else XB_SPIN(xb_ld(&bar[XB_TOPGEN]) == tg, bar);
            __builtin_amdgcn_fence(__ATOMIC_ACQUIRE, "agent");
            xb_add(&bar[XB_XGEN(b.x)], 1u);
            asm volatile("s_waitcnt vmcnt(0)" ::: "memory");
        } else {
            XB_SPIN(xb_ld(&bar[XB_XGEN(b.x)]) == gen, bar);
            __builtin_amdgcn_fence(__ATOMIC_ACQUIRE, "agent");
            asm volatile("s_waitcnt vmcnt(0)" ::: "memory");
        }
    }
    __syncthreads();
}

__global__ void __launch_bounds__(256, 2) fwd_megakernel(Params p) {
    extern __shared__ __attribute__((aligned(16))) char smem[];
    __shared__ uint4 xb_words;
    cg::grid_group grid = cg::this_grid();
    unsigned* bar = (unsigned*)(p.ws + OFF_BAR);
    if (blockIdx.x == 0) for (int i = threadIdx.x; i < XCD_BAR_WORDS; i += 256) __hip_atomic_store(bar + i, 0u, __ATOMIC_RELAXED, __HIP_MEMORY_SCOPE_AGENT);
    if (threadIdx.x == 0) xb_words = make_uint4(0u, 0u, 0u, 0u);
    { FRESH(q); phase0(q, smem); }
    grid.sync();
    const XcdBarrier xb = xcd_barrier_post(bar, (volatile LAS unsigned*)&xb_words);
#define GBAR() xcd_barrier(xb)
    for (int l = 0; l < DEPTH; ++l) {
        { FRESH(q); phase_rows(q, l); }
        GBAR();
        { FRESH(q); phase_inproj256(q, l, smem); }
        GBAR();
        { FRESH(q); for (int it = blockIdx.x; it < NCHK; it += gridDim.x) gdn_prep_item(q, l, it, smem); }
        GBAR();
        { FRESH(q); phase_mixb(q, l, smem); }
        GBAR();
        { FRESH(q); for (int it = blockIdx.x; it < NCHK; it += gridDim.x) gdn_out_item(q, l, it); }
        GBAR();
        { FRESH(q); phase_merge(q, l, smem); }
        GBAR();
        { FRESH(q); phase_outproj(q, l, smem); }
        GBAR();
    }
    { FRESH(q); phase_rows(q, DEPTH); }
}

extern "C" void kernel_launch(void* const* d_in, const int* in_sizes, int n_in, void* d_out, int out_size, void* d_ws, size_t ws_size,
                              hipStream_t stream) {
    static int grid_blocks = 0;
    if (!grid_blocks) {
        int dev = 0, cus = 0, per_cu = 0;
        hipGetDevice(&dev);
        hipDeviceGetAttribute(&cus, hipDeviceAttributeMultiprocessorCount, dev);
        hipFuncSetAttribute((const void*)fwd_megakernel, hipFuncAttributeMaxDynamicSharedMemorySize, SMEM_BYTES);
        hipOccupancyMaxActiveBlocksPerMultiprocessor(&per_cu, fwd_megakernel, 256, SMEM_BYTES);
        if (per_cu > 2) per_cu = 2;
        if (per_cu < 1) per_cu = 1;
        grid_blocks = cus * per_cu;
    }
    if (ws_size < WS_NEED) {
        fprintf(stderr, "workspace too small: %zu < %zu\n", ws_size, (size_t)WS_NEED);
        return;
    }
    Params p{};
    const float** f = (const float**)&p;
    for (int i = 0; i < 22; ++i) f[i] = (const float*)d_in[i];
    p.out = (float*)d_out;
    p.ws = (char*)d_ws;
    void* args[] = {&p};
    hipError_t e = hipLaunchCooperativeKernel((const void*)fwd_megakernel, dim3(grid_blocks), dim3(256), args, SMEM_BYTES, stream);
    if (e != hipSuccess) fprintf(stderr, "cooperative launch failed: %s (grid %d)\n", hipGetErrorString(e), grid_blocks);
}
```
